# Optimizing an MI355X kernel written in HIP

```python
import math
import jax, jax.numpy as jnp
from jax import lax
import numpy as np

D_MODEL = 1024
BATCH = 4
SEQ = 8192
DEPTH = 1

D_MIX = D_MODEL
CONV_CH = D_MIX // 2
CONV_W = 3
N_HEADS = 8
HEAD_DIM = (D_MIX - CONV_CH) // N_HEADS
N_KV = 2
GQA = N_HEADS // N_KV
CMP_BLOCK = 32
CMP_STRIDE = 16
CMP_HIDDEN = 2 * HEAD_DIM
SEL_BLOCK = 64
N_SEL = 16
WINDOW = 512
Q_BLOCK = 128
ATTN_SCALE = HEAD_DIM ** -0.5
FORCE_SCORE = 1e4
NEG_INF = -1e30
N_GROUPS = 4
EXP_PER_GROUP = 8
N_EXPERTS = N_GROUPS * EXP_PER_GROUP
TOP_K = 2
D_EXPERT = D_MODEL // 2
MOE_CHUNK = 256
D_PLE = 256
ALPHA = (2 * DEPTH) ** 0.25
BETA = (8 * DEPTH) ** -0.25
LN_EPS = 1e-5

SPLIT_SIZES = (CONV_CH, CONV_CH, CONV_CH,
               N_HEADS * HEAD_DIM,
               N_KV * HEAD_DIM, N_KV * HEAD_DIM,
               N_KV * HEAD_DIM, N_KV * HEAD_DIM,
               N_KV * HEAD_DIM, N_KV * HEAD_DIM,
               3 * N_HEADS)
D_IN_PROJ = sum(SPLIT_SIZES)
SPLIT_POINTS = tuple(int(v) for v in np.cumsum(SPLIT_SIZES)[:-1])

kernel_name = "hybrid_conv_nsa_hmoe_deepnorm"


def layer_norm(x, g, b):
    xf = x.astype(jnp.float32)
    mu = jnp.mean(xf, axis=-1, keepdims=True)
    var = jnp.mean(jnp.square(xf - mu), axis=-1, keepdims=True)
    y = (xf - mu) * lax.rsqrt(var + LN_EPS) * g.astype(jnp.float32) + b.astype(jnp.float32)
    return y.astype(x.dtype)


def masked_softmax(s, mask):
    s = jnp.where(mask, s.astype(jnp.float32), NEG_INF)
    pr = jax.nn.softmax(s, axis=-1)
    return jnp.where(mask, pr, 0.0)


def causal_dwconv(u, w):
    return lax.conv_general_dilated(
        u, w[:, None, :].astype(u.dtype), window_strides=(1,),
        padding=[(CONV_W - 1, 0)], dimension_numbers=("NWC", "WIO", "NWC"),
        feature_group_count=u.shape[-1])


def compress_blocks(kv, pe, w1, w2):
    bsz, s = kv.shape[:2]
    n_cmp = (s - CMP_BLOCK) // CMP_STRIDE + 1
    idx = jnp.arange(n_cmp)[:, None] * CMP_STRIDE + jnp.arange(CMP_BLOCK)[None, :]
    blk = kv[:, idx] + pe[None, None, :, None, :]
    flat = blk.transpose(0, 1, 3, 2, 4).reshape(bsz, n_cmp, N_KV, CMP_BLOCK * HEAD_DIM)
    return jax.nn.gelu(flat @ w1) @ w2


def nsa_attention(q, kc, vc, ks, vs, kw, vw, gates,
                  pe_ck, w1_ck, w2_ck, pe_cv, w1_cv, w2_cv):
    bsz, s = q.shape[:2]
    q = q.reshape(bsz, s, N_KV, GQA, HEAD_DIM)
    kc, vc, ks, vs, kw, vw = [a.reshape(bsz, s, N_KV, HEAD_DIM) for a in (kc, vc, ks, vs, kw, vw)]
    k_cmp = compress_blocks(kc, pe_ck, w1_ck, w2_ck)
    v_cmp = compress_blocks(vc, pe_cv, w1_cv, w2_cv)
    n_cmp = k_cmp.shape[1]
    n_sel = s // SEL_BLOCK
    n_top = min(N_SEL, n_sel)
    cmp_start = jnp.arange(n_cmp) * CMP_STRIDE
    cmp_end = cmp_start + CMP_BLOCK - 1
    sel_start = jnp.arange(n_sel) * SEL_BLOCK
    cover = ((cmp_start[:, None] < sel_start[None, :] + SEL_BLOCK) &
             (cmp_start[:, None] + CMP_BLOCK > sel_start[None, :])).astype(jnp.float32)
    ks_b = ks.reshape(bsz, n_sel, SEL_BLOCK, N_KV, HEAD_DIM).transpose(0, 3, 1, 2, 4)
    vs_b = vs.reshape(bsz, n_sel, SEL_BLOCK, N_KV, HEAD_DIM).transpose(0, 3, 1, 2, 4)
    kw_p = jnp.pad(kw, ((0, 0), (WINDOW, 0), (0, 0), (0, 0)))
    vw_p = jnp.pad(vw, ((0, 0), (WINDOW, 0), (0, 0), (0, 0)))
    g = jax.nn.sigmoid(gates.astype(jnp.float32)).reshape(bsz, s, N_KV, GQA, 3)
    b_ix = jnp.arange(bsz)[:, None, None, None]
    h_ix = jnp.arange(N_KV)[None, None, :, None]
    blk_ids = jnp.arange(n_sel)
    tok_in_blk = jnp.arange(SEL_BLOCK)

    def one_block(c):
        q0 = c * Q_BLOCK
        qc = lax.dynamic_slice_in_dim(q, q0, Q_BLOCK, 1)
        gc = lax.dynamic_slice_in_dim(g, q0, Q_BLOCK, 1)
        t = q0 + jnp.arange(Q_BLOCK)
        sc = jnp.einsum('bqkgd,bnkd->bqkgn', qc, k_cmp) * ATTN_SCALE
        mask_c = (cmp_end[None, :] <= t[:, None])[None, :, None, None, :]
        p_cmp = masked_softmax(sc, mask_c)
        o_cmp = jnp.einsum('bqkgn,bnkd->bqkgd', p_cmp.astype(v_cmp.dtype), v_cmp)
        imp = jnp.einsum('bqkgn,nj->bqkj', p_cmp, cover)
        jt = (t // SEL_BLOCK)[None, :, None, None]
        forced = (blk_ids == 0) | (blk_ids == jt) | (blk_ids == jt - 1)
        score = jnp.where(blk_ids > jt, -1.0, jnp.where(forced, FORCE_SCORE, imp))
        top_v, top_i = lax.top_k(score, n_top)
        k_g = ks_b[b_ix, h_ix, top_i].reshape(bsz, Q_BLOCK, N_KV, n_top * SEL_BLOCK, HEAD_DIM)
        v_g = vs_b[b_ix, h_ix, top_i].reshape(bsz, Q_BLOCK, N_KV, n_top * SEL_BLOCK, HEAD_DIM)
        pos = top_i[..., None] * SEL_BLOCK + tok_in_blk
        mask_s = (top_v >= 0)[..., None] & (pos <= t[None, :, None, None, None])
        mask_s = mask_s.reshape(bsz, Q_BLOCK, N_KV, n_top * SEL_BLOCK)[:, :, :, None, :]
        ss = jnp.einsum('bqkgd,bqkmd->bqkgm', qc, k_g) * ATTN_SCALE
        p_sel = masked_softmax(ss, mask_s)
        o_sel = jnp.einsum('bqkgm,bqkmd->bqkgd', p_sel.astype(v_g.dtype), v_g)
        kwc = lax.dynamic_slice_in_dim(kw_p, q0, WINDOW + Q_BLOCK, 1)
        vwc = lax.dynamic_slice_in_dim(vw_p, q0, WINDOW + Q_BLOCK, 1)
        spos = q0 - WINDOW + jnp.arange(WINDOW + Q_BLOCK)
        dist = t[:, None] - spos[None, :]
        mask_w = ((dist >= 0) & (dist < WINDOW) & (spos[None, :] >= 0))[None, :, None, None, :]
        sw = jnp.einsum('bqkgd,bmkd->bqkgm', qc, kwc) * ATTN_SCALE
        p_win = masked_softmax(sw, mask_w)
        o_win = jnp.einsum('bqkgm,bmkd->bqkgd', p_win.astype(vwc.dtype), vwc)
        o = gc[..., 0:1] * o_cmp + gc[..., 1:2] * o_sel + gc[..., 2:3] * o_win
        return o.reshape(bsz, Q_BLOCK, N_HEADS * HEAD_DIM).astype(q.dtype)

    out = lax.map(one_block, jnp.arange(s // Q_BLOCK))
    return out.transpose(1, 0, 2, 3).reshape(bsz, s, N_HEADS * HEAD_DIM)


def hybrid_mixer(h, w_in, w_conv, pe_ck, w1_ck, w2_ck, pe_cv, w1_cv, w2_cv, w_out):
    z = h @ w_in
    cb, cc, ch, q, kc, vc, ks, vs, kw, vw, gates = jnp.split(z, SPLIT_POINTS, axis=-1)
    y_conv = cb * causal_dwconv(cc * ch, w_conv)
    y_nsa = nsa_attention(q, kc, vc, ks, vs, kw, vw, gates,
                          pe_ck, w1_ck, w2_ck, pe_cv, w1_cv, w2_cv)
    return jnp.concatenate([y_conv, y_nsa.astype(y_conv.dtype)], axis=-1) @ w_out


def hier_moe(x, w_rg, b_rg, w_re, b_re, w_e_in, w_e_out):
    bsz, s, d = x.shape
    n_tok = bsz * s
    xt = x.reshape(n_tok, d)
    gprob = jax.nn.softmax((xt @ w_rg + b_rg).astype(jnp.float32), axis=-1)
    gsel = jnp.argmax(gprob, axis=-1)
    gp = jnp.max(gprob, axis=-1)
    elog = (xt @ w_re + b_re).astype(jnp.float32).reshape(n_tok, N_GROUPS, EXP_PER_GROUP)
    elog = jnp.einsum('tge,tg->te', elog, jax.nn.one_hot(gsel, N_GROUPS, dtype=jnp.float32))
    top_p, top_i = lax.top_k(jax.nn.softmax(elog, axis=-1), TOP_K)
    top_p = top_p / jnp.sum(top_p, axis=-1, keepdims=True)
    wts = (gp[:, None] * top_p).reshape(-1)
    eid = (gsel[:, None] * EXP_PER_GROUP + top_i).reshape(-1)
    tok = jnp.repeat(jnp.arange(n_tok), TOP_K)
    n_asg = n_tok * TOP_K
    order = jnp.argsort(eid)
    eid_s, tok_s, w_s = eid[order], tok[order], wts[order]
    counts = jnp.bincount(eid, length=N_EXPERTS)
    starts = jnp.cumsum(counts) - counts
    pcounts = (counts + MOE_CHUNK - 1) // MOE_CHUNK * MOE_CHUNK
    pends = jnp.cumsum(pcounts)
    pstarts = pends - pcounts
    dest = pstarts[eid_s] + (jnp.arange(n_asg) - starts[eid_s])
    n_chunk = -(-n_asg // MOE_CHUNK) + N_EXPERTS
    n_rows = n_chunk * MOE_CHUNK
    tok_buf = jnp.zeros((n_rows,), jnp.int32).at[dest].set(tok_s.astype(jnp.int32))
    w_buf = jnp.zeros((n_rows,), jnp.float32).at[dest].set(w_s)
    chunk_exp = jnp.clip(jnp.searchsorted(pends, jnp.arange(n_chunk) * MOE_CHUNK, side='right'),
                         0, N_EXPERTS - 1)

    def run_chunk(args):
        tok_c, e_c = args
        gate, up = jnp.split(xt[tok_c] @ w_e_in[e_c], 2, axis=-1)
        return (jax.nn.silu(gate) * up) @ w_e_out[e_c]

    out = lax.map(run_chunk, (tok_buf.reshape(n_chunk, MOE_CHUNK), chunk_exp))
    y = jax.ops.segment_sum(out.reshape(n_rows, d) * w_buf[:, None], tok_buf, num_segments=n_tok)
    return y.reshape(bsz, s, d).astype(x.dtype)


def setup_inputs(seed: int = 0) -> dict:
    key = jax.random.key(seed)
    ks = jax.random.split(key, 32)
    nrm = lambda k, shape, scale: jax.random.normal(k, shape, jnp.float32) * scale
    L = DEPTH
    return {
        "x": nrm(ks[0], (BATCH, SEQ, D_MODEL), 1.0),
        "p": nrm(ks[1], (L, BATCH, SEQ, D_PLE), 1.0),
        "w_in": nrm(ks[2], (L, D_MODEL, D_IN_PROJ), D_MODEL ** -0.5),
        "w_conv": nrm(ks[3], (L, CONV_W, CONV_CH), CONV_W ** -0.5),
        "pe_ck": nrm(ks[4], (L, CMP_BLOCK, HEAD_DIM), 0.02),
        "w1_ck": nrm(ks[5], (L, CMP_BLOCK * HEAD_DIM, CMP_HIDDEN), (CMP_BLOCK * HEAD_DIM) ** -0.5),
        "w2_ck": nrm(ks[6], (L, CMP_HIDDEN, HEAD_DIM), CMP_HIDDEN ** -0.5),
        "pe_cv": nrm(ks[7], (L, CMP_BLOCK, HEAD_DIM), 0.02),
        "w1_cv": nrm(ks[8], (L, CMP_BLOCK * HEAD_DIM, CMP_HIDDEN), (CMP_BLOCK * HEAD_DIM) ** -0.5),
        "w2_cv": nrm(ks[9], (L, CMP_HIDDEN, HEAD_DIM), CMP_HIDDEN ** -0.5),
        "w_out": nrm(ks[10], (L, D_MIX, D_MODEL), D_MIX ** -0.5 * BETA),
        "ln1_g": 1.0 + nrm(ks[11], (L, D_MODEL), 0.02),
        "ln1_b": nrm(ks[12], (L, D_MODEL), 0.02),
        "w_rg": nrm(ks[13], (L, D_MODEL, N_GROUPS), D_MODEL ** -0.5),
        "b_rg": nrm(ks[14], (L, N_GROUPS), 0.01),
        "w_re": nrm(ks[15], (L, D_MODEL, N_EXPERTS), D_MODEL ** -0.5),
        "b_re": nrm(ks[16], (L, N_EXPERTS), 0.01),
        "w_e_in": nrm(ks[17], (L, N_EXPERTS, D_MODEL, 2 * D_EXPERT), D_MODEL ** -0.5),
        "w_e_out": nrm(ks[18], (L, N_EXPERTS, D_EXPERT, D_MODEL), D_EXPERT ** -0.5 * BETA),
        "ln2_g": 1.0 + nrm(ks[19], (L, D_MODEL), 0.02),
        "ln2_b": nrm(ks[20], (L, D_MODEL), 0.02),
        "w_ple": nrm(ks[21], (L, D_PLE, D_MODEL), D_PLE ** -0.5 * BETA),
        "w_ple_gate": nrm(ks[22], (L, D_MODEL, D_MODEL), D_MODEL ** -0.5),
        "b_ple_gate": nrm(ks[23], (L, D_MODEL), 0.02),
        "ln3_g": 1.0 + nrm(ks[24], (L, D_MODEL), 0.02),
        "ln3_b": nrm(ks[25], (L, D_MODEL), 0.02),
    }


def reference(x, p, w_in, w_conv, pe_ck, w1_ck, w2_ck, pe_cv, w1_cv, w2_cv, w_out,
              ln1_g, ln1_b, w_rg, b_rg, w_re, b_re, w_e_in, w_e_out, ln2_g, ln2_b,
              w_ple, w_ple_gate, b_ple_gate, ln3_g, ln3_b):
    h = x
    for i in range(DEPTH):
        mix = hybrid_mixer(h, w_in[i], w_conv[i], pe_ck[i], w1_ck[i], w2_ck[i],
                           pe_cv[i], w1_cv[i], w2_cv[i], w_out[i])
        h = layer_norm(ALPHA * h + mix, ln1_g[i], ln1_b[i])
        ffn = hier_moe(h, w_rg[i], b_rg[i], w_re[i], b_re[i], w_e_in[i], w_e_out[i])
        h = layer_norm(ALPHA * h + ffn, ln2_g[i], ln2_b[i])
        ple = (p[i] @ w_ple[i]) * jax.nn.sigmoid(h @ w_ple_gate[i] + b_ple_gate[i])
        h = layer_norm(ALPHA * h + ple.astype(h.dtype), ln3_g[i], ln3_b[i])
    return h
```

```cpp
#include <hip/hip_runtime.h>
#include <hip/hip_cooperative_groups.h>
#include <cstdio>
#include <cstdint>
namespace cg = cooperative_groups;

#ifndef N_LAUNCH_SPLIT
#define N_LAUNCH_SPLIT 0
#endif

#define LAS __attribute__((address_space(3)))
typedef unsigned short bf16_t;
typedef short bf16x8 __attribute__((ext_vector_type(8)));
typedef float f32x4 __attribute__((ext_vector_type(4)));
typedef float f32x2 __attribute__((ext_vector_type(2)));
typedef unsigned u32x4 __attribute__((ext_vector_type(4)));
typedef unsigned u32x2 __attribute__((ext_vector_type(2)));
typedef __bf16 bf16x2_t __attribute__((ext_vector_type(2)));
typedef LAS unsigned char lds_t;

constexpr int NBATCH = 4, SEQ = 8192, T = NBATCH * SEQ, DM = 1024;
constexpr int NTHREADS = 512;
constexpr float ALPHA = 1.189207115002721f;
constexpr float LN_EPS = 1e-5f;
constexpr float QSCALE = 0.125f * 1.4426950408889634f;
constexpr int NIN_PAD = 3072;
constexpr int LDS_BYTES = 163840;

constexpr size_t MiB = 1u << 20;
constexpr size_t WS_CTL = 0;
constexpr size_t WS_WIN = 1 * MiB;
constexpr size_t WS_WOUT = 7 * MiB;
constexpr size_t WS_WPG = 9 * MiB;
constexpr size_t WS_WPLE = 11 * MiB;
constexpr size_t WS_W1CK = 12 * MiB;
constexpr size_t WS_W1CV = 12 * MiB + 512 * 1024;
constexpr size_t WS_W2CK = 13 * MiB;
constexpr size_t WS_W2CV = 13 * MiB + 64 * 1024;
constexpr size_t WS_BIAS1 = 13 * MiB + 128 * 1024;
constexpr size_t WS_WRB = 13 * MiB + 256 * 1024;
constexpr size_t WS_WEIN = 14 * MiB;
constexpr size_t WS_WEOUT = 78 * MiB;
constexpr size_t WS_PB = 110 * MiB;
constexpr size_t WS_G = 126 * MiB;
constexpr size_t WS_KCMP = 129 * MiB;
constexpr size_t WS_VCMPT = 129 * MiB + 512 * 1024;
constexpr size_t WS_ASGE = 130 * MiB;
constexpr size_t WS_ASGS = 130 * MiB + 256 * 1024;
constexpr size_t WS_ASGW = 130 * MiB + 512 * 1024;
constexpr size_t WS_TOKL = 131 * MiB;
constexpr size_t WS_H1B = 140 * MiB;
constexpr size_t WS_RA = 204 * MiB;
constexpr size_t WS_RB = 276 * MiB;
constexpr size_t WS_U = WS_RB, WS_CB = WS_RB + 32 * MiB, WS_Q = WS_RB + 64 * MiB, WS_KC = WS_RB + 96 * MiB, WS_VC = WS_RB + 104 * MiB;
constexpr size_t WS_KS = WS_RB + 112 * MiB, WS_VST = WS_RB + 120 * MiB, WS_KW = WS_RB + 128 * MiB, WS_VWT = WS_RB + 136 * MiB;
constexpr size_t WS_H1LO = 420 * MiB;
constexpr size_t WS_XCH1 = 484 * MiB;
constexpr size_t WS_XCH3 = 485 * MiB;
constexpr size_t WS_END = 486 * MiB;

struct Params {
    const float* in[26];
    float* out;
    unsigned char* ws;
    int ph_lo, ph_hi;
};

__device__ __forceinline__ unsigned pk2(float lo, float hi) { f32x2 v = {lo, hi}; bf16x2_t b = __builtin_convertvector(v, bf16x2_t); return __builtin_bit_cast(unsigned, b); }
__device__ __forceinline__ bf16_t f2bf(float f) { return (bf16_t)(pk2(f, 0.f) & 0xffffu); }
__device__ __forceinline__ float bf2f(unsigned h) { return __uint_as_float(h << 16); }
__device__ __forceinline__ float bflo(unsigned w) { return __uint_as_float(w << 16); }
__device__ __forceinline__ float bfhi(unsigned w) { return __uint_as_float(w & 0xffff0000u); }
__device__ __forceinline__ u32x2 pk4(f32x4 v) { u32x2 o; o.x = pk2(v[0], v[1]); o.y = pk2(v[2], v[3]); return o; }
__device__ __forceinline__ unsigned pk4_f8(float a, float b, float c, float d) { int w = 0; w = __builtin_amdgcn_cvt_pk_fp8_f32(a, b, w, false); w = __builtin_amdgcn_cvt_pk_fp8_f32(c, d, w, true); return (unsigned)w; }
__device__ __forceinline__ u32x2 pk8_f8(f32x4 a, f32x4 b) { u32x2 o; o.x = pk4_f8(a[0], a[1], a[2], a[3]); o.y = pk4_f8(b[0], b[1], b[2], b[3]); return o; }
__device__ __forceinline__ u32x4 pk8(f32x4 a, f32x4 b) { u32x4 o; o.x = pk2(a[0], a[1]); o.y = pk2(a[2], a[3]); o.z = pk2(b[0], b[1]); o.w = pk2(b[2], b[3]); return o; }
__host__ __device__ __forceinline__ int perm64(int n) { return (n & ~63) | (((n >> 2) & 3) << 4) | (((n >> 4) & 3) << 2) | (n & 3); }
__device__ __forceinline__ float fexp2(float x) { return __builtin_amdgcn_exp2f(x); }
__device__ __forceinline__ float sigmoidf_(float x) { return __builtin_amdgcn_rcpf(1.0f + __expf(-x)); }
__device__ __forceinline__ int lds_off(int row, int chunk) { return row * 128 + ((chunk ^ ((row >> 1) & 7)) << 4); }
__device__ __forceinline__ bf16x8 lds_ld16(lds_t* p) { return *(LAS bf16x8*)p; }
__device__ __forceinline__ void lds_st16(lds_t* p, u32x4 v) { *(LAS u32x4*)p = v; }
__device__ __forceinline__ bf16x8 gld16(const bf16_t* p) { return *(const bf16x8*)p; }
__device__ __forceinline__ f32x4 mfma16(bf16x8 a, bf16x8 b, f32x4 c) { return __builtin_amdgcn_mfma_f32_16x16x32_bf16(a, b, c, 0, 0, 0); }
__device__ __forceinline__ int fenc(float f) { int b = __float_as_int(f); return b >= 0 ? b : (b ^ 0x7fffffff); }
__device__ __forceinline__ float fdec(int b) { return __int_as_float(b >= 0 ? b : (b ^ 0x7fffffff)); }
__device__ __forceinline__ float sx(float v, int m) { return __shfl_xor(v, m); }

__device__ __forceinline__ void lds_addf(LAS float* p, float v) { (void)__hip_atomic_fetch_add(p, v, __ATOMIC_RELAXED, __HIP_MEMORY_SCOPE_WORKGROUP); }
__device__ __forceinline__ void lds_addi_nr(LAS int* p, int v) { (void)__hip_atomic_fetch_add(p, v, __ATOMIC_RELAXED, __HIP_MEMORY_SCOPE_WORKGROUP); }
__device__ __forceinline__ int lds_addi(LAS int* p, int v) { return __hip_atomic_fetch_add(p, v, __ATOMIC_RELAXED, __HIP_MEMORY_SCOPE_WORKGROUP); }
__device__ __forceinline__ void lds_maxi(LAS int* p, int v) { (void)__hip_atomic_fetch_max(p, v, __ATOMIC_RELAXED, __HIP_MEMORY_SCOPE_WORKGROUP); }
__device__ __forceinline__ void lds_oru(LAS unsigned* p, unsigned v) { (void)__hip_atomic_fetch_or(p, v, __ATOMIC_RELAXED, __HIP_MEMORY_SCOPE_WORKGROUP); }

template <int BM, int BN, int WTM = 64, int WTN = 64, bool ZERO = true>
__device__ __forceinline__ void gemm_mainloop(lds_t* lds, const bf16_t* (&ap)[BM / 64], int astep, const bf16_t* (&bp)[BN / 64], int nk, f32x4 (&acc)[WTM / 16][WTN / 16]) {
    constexpr int NA = BM / 64, NB_ = BN / 64, WN = BN / WTN, MT = WTM / 16, NT = WTN / 16;
    static_assert((BM / WTM) * (BN / WTN) == 8, "8 waves");
    constexpr int STAGE = (BM + BN) * 128;
    int tid = threadIdx.x; asm volatile("" : "+v"(tid));
    const int lane = tid & 63, wid = __builtin_amdgcn_readfirstlane(tid >> 6);
    const int r = lane & 15, q = lane >> 4;
    const int wm = wid / WN, wn = wid % WN;
    const int sc = tid & 7, sr = tid >> 3;
    const int wofs = sr * 128 + ((sc ^ ((sr >> 1) & 7)) << 4);
    const int x0 = (q ^ (r >> 1)) << 4;
    const int aoff = (wm * WTM + r) * 128, boff = BM * 128 + (wn * WTN + r) * 128;
    u32x4 ra0[NA], rb0[NB_], ra1[NA], rb1[NB_];
    if (ZERO) {
#pragma unroll
        for (int i = 0; i < MT; ++i)
#pragma unroll
            for (int j = 0; j < NT; ++j) acc[i][j] = (f32x4){0.f, 0.f, 0.f, 0.f};
    }
#define GM_LOAD(RA, RB, KT) do { _Pragma("unroll") for (int i = 0; i < NA; ++i) RA[i] = *(const u32x4*)(ap[i] + (size_t)(KT) * astep); \
                                 _Pragma("unroll") for (int i = 0; i < NB_; ++i) RB[i] = *(const u32x4*)(bp[i] + (size_t)(KT) * 64); } while (0)
#define GM_WRITE(RA, RB, ST) do { lds_t* sn_ = lds + (ST) * STAGE; _Pragma("unroll") for (int i = 0; i < NA; ++i) lds_st16(sn_ + i * 8192 + wofs, RA[i]); \
                                  _Pragma("unroll") for (int i = 0; i < NB_; ++i) lds_st16(sn_ + BM * 128 + i * 8192 + wofs, RB[i]); } while (0)
#define GM_COMPUTE(ST) do { lds_t* st_ = lds + (ST) * STAGE; _Pragma("unroll") for (int s = 0; s < 2; ++s) { const int xs = x0 ^ (s << 6); bf16x8 a[MT], b[NT]; \
        _Pragma("unroll") for (int i = 0; i < MT; ++i) a[i] = lds_ld16(st_ + aoff + i * 2048 + xs); \
        _Pragma("unroll") for (int i = 0; i < NT; ++i) b[i] = lds_ld16(st_ + boff + i * 2048 + xs); \
        _Pragma("unroll") for (int i = 0; i < MT; ++i) _Pragma("unroll") for (int j = 0; j < NT; ++j) acc[i][j] = mfma16(b[j], a[i], acc[i][j]); } } while (0)
    GM_LOAD(ra0, rb0, 0);
    if (nk > 1) GM_LOAD(ra1, rb1, 1);
    GM_WRITE(ra0, rb0, 0);
    __syncthreads();
    for (int kt = 0; kt < nk; kt += 2) {
        if (kt + 2 < nk) GM_LOAD(ra0, rb0, kt + 2);
        GM_COMPUTE(0);
        if (kt + 1 < nk) GM_WRITE(ra1, rb1, 1);
        __syncthreads();
        if (kt + 1 < nk) {
            if (kt + 3 < nk) GM_LOAD(ra1, rb1, kt + 3);
            GM_COMPUTE(1);
            if (kt + 2 < nk) GM_WRITE(ra0, rb0, 0);
            __syncthreads();
        }
    }
#undef GM_LOAD
#undef GM_WRITE
#undef GM_COMPUTE
}

__device__ __forceinline__ int glds_lchunk(int tid) { return ((tid & 7) ^ ((tid >> 4) & 7)) * 8; }
__device__ __forceinline__ void gemm256_first(lds_t* lds, const bf16_t* abase, const unsigned (&aoffs)[4], const bf16_t* bbase, const unsigned (&boffs)[4]) {
    const int wid = __builtin_amdgcn_readfirstlane(threadIdx.x >> 6);
#pragma unroll
    for (int i = 0; i < 4; ++i) {
        __builtin_amdgcn_global_load_lds((const unsigned*)(abase + aoffs[i]), (LAS unsigned*)(lds + i * 8192 + wid * 1024), 16, 0, 0);
        __builtin_amdgcn_global_load_lds((const unsigned*)(bbase + boffs[i]), (LAS unsigned*)(lds + 32768 + i * 8192 + wid * 1024), 16, 0, 0); }
}
struct AccZero { __device__ __forceinline__ f32x4 operator()(int, int) const { return (f32x4){0.f, 0.f, 0.f, 0.f}; } __device__ __forceinline__ void next() {} };
struct AccFromF32 { const float* p; size_t step; float scale;
    __device__ __forceinline__ f32x4 operator()(int, int j) const { return *(const f32x4*)(p + j * 4) * scale; }
    __device__ __forceinline__ void next() { p += step; asm volatile("" : "+v"(p)); } };
template <class Init = AccZero>
__device__ __forceinline__ void gemm256_main(lds_t* lds, const bf16_t* abase, const unsigned (&aoffs)[4], int astep, const bf16_t* bbase, const unsigned (&boffs)[4], int nk, f32x4 (&acc)[8][4], Init init = Init()) {
    int tid = threadIdx.x; asm volatile("" : "+v"(tid));
    const int lane = tid & 63, wid = __builtin_amdgcn_readfirstlane(tid >> 6);
    const int r = lane & 15, q = lane >> 4, wr = wid >> 2, wc = wid & 3;
    const int x0 = (q ^ (r >> 1)) << 4;
    const int aoff = (wr * 128 + r) * 128, boff = 32768 + (wc * 64 + r) * 128;
    const int sflip = wr;
#pragma unroll
    for (int i = 0; i < 8; ++i) {
#pragma unroll
        for (int j = 0; j < 4; ++j) acc[i][j] = init(i, j);
        init.next(); }
#define G2_STAGE(BUF, KT) do { _Pragma("unroll") for (int i = 0; i < 4; ++i) { \
        __builtin_amdgcn_global_load_lds((const unsigned*)((abase + (size_t)(KT) * astep) + aoffs[i]), (LAS unsigned*)(lds + (BUF) * 65536 + i * 8192 + wid * 1024), 16, 0, 0); \
        __builtin_amdgcn_global_load_lds((const unsigned*)((bbase + (size_t)(KT) * 64) + boffs[i]), (LAS unsigned*)(lds + (BUF) * 65536 + 32768 + i * 8192 + wid * 1024), 16, 0, 0); } } while (0)
#define G2_COMPUTE(BUF) do { lds_t* st_ = lds + (BUF) * 65536; _Pragma("unroll") for (int s = 0; s < 2; ++s) { const int xs = x0 ^ ((s ^ sflip) << 6); bf16x8 a[8], b[4]; \
        _Pragma("unroll") for (int i = 0; i < 8; ++i) a[i] = lds_ld16(st_ + aoff + i * 2048 + xs); \
        _Pragma("unroll") for (int i = 0; i < 4; ++i) b[i] = lds_ld16(st_ + boff + i * 2048 + xs); \
        _Pragma("unroll") for (int i = 0; i < 8; ++i) _Pragma("unroll") for (int j = 0; j < 4; ++j) acc[i][j] = mfma16(b[j], a[i], acc[i][j]); \
        __builtin_amdgcn_sched_barrier(0); } } while (0)
    asm volatile("s_waitcnt vmcnt(0)" ::: "memory");
    __syncthreads();
    for (int t = 0; t < nk; ++t) {
        const int cur = t & 1;
        if (t + 1 < nk) G2_STAGE(cur ^ 1, t + 1);
        G2_COMPUTE(cur);
        asm volatile("s_waitcnt vmcnt(0)" ::: "memory");
        __syncthreads();
    }
#undef G2_STAGE
#undef G2_COMPUTE
}
__device__ __forceinline__ void gemm256(lds_t* lds, const bf16_t* abase, const unsigned (&aoffs)[4], int astep, const bf16_t* bbase, const unsigned (&boffs)[4], int nk, f32x4 (&acc)[8][4]) {
    gemm256_first(lds, abase, aoffs, bbase, boffs);
    gemm256_main(lds, abase, aoffs, astep, bbase, boffs, nk, acc);
}


namespace g8 {
constexpr int HALF = 128, HTB = HALF * 64 * 2, STAGE_BYTES = 8 * HTB;
__device__ __forceinline__ int lds_byte(int r, int c) { const int st = (r >> 4) * 2 + (c >> 5), rr = r & 15, cc = c & 31, ob = rr * 64 + cc * 2; return st * 1024 + (ob ^ (((ob >> 9) & 1) << 5)); }
__device__ __forceinline__ void stage_rc(int b, int& R, int& C) { const int st = b / 1024, sb = b % 1024, swz = sb ^ (((sb >> 9) & 1) << 5); R = (st >> 1) * 16 + swz / 64; C = (st & 1) * 32 + (swz % 64) / 2; }
__device__ __forceinline__ int perm32(int rho) { const int n = rho >> 4, i = rho & 15; return 8 * (i >> 2) + 4 * n + (i & 3); }
struct Unit { int pm, pn, e, ne, rb, idx; };
typedef f32x4 Acc[2][2][4][2];
__device__ __forceinline__ void acc_zero(Acc& acc) {
#pragma unroll
    for (int a = 0; a < 2; ++a)
#pragma unroll
        for (int b = 0; b < 2; ++b)
#pragma unroll
            for (int m = 0; m < 4; ++m)
#pragma unroll
                for (int n = 0; n < 2; ++n) acc[a][b][m][n] = (f32x4){0.f, 0.f, 0.f, 0.f};
}
__device__ __forceinline__ void natural_offsets(unsigned (&voffA)[2][2], int K, int tid) {
#pragma unroll
    for (int i = 0; i < 2; ++i) { int R, C; stage_rc(tid * 16 + i * 8192, R, C); voffA[0][i] = (unsigned)(R * K + C) * 2u; voffA[1][i] = (unsigned)((R + HALF) * K + C) * 2u; }
}
template <class Epi, class Sched>
__device__ __forceinline__ void gemm_phase(lds_t* lds, const int K, const Sched& S, const Epi& E) {
    int tid = threadIdx.x; asm volatile("" : "+v"(tid));
    const int wid = __builtin_amdgcn_readfirstlane(tid >> 6), lane = tid & 63, wr = wid >> 2, wc = wid & 3, fr = lane & 15, fq = lane >> 4;
    const int nt = K / 64;
    unsigned voffA[2][2], voffB[2];
#pragma unroll
    for (int i = 0; i < 2; ++i) { int R, C; stage_rc(tid * 16 + i * 8192, R, C); const int Rb = (R & ~31) + perm32(R & 31); voffB[i] = (unsigned)(Rb * K + C) * 2u; }
    const size_t kstep = 128;
    const unsigned ldsw = (unsigned)wid * 1024u;
    const int aoff = lds_byte(wr * 64 + fr, fq * 8), boff = lds_byte(wc * 32 + fr, fq * 8);
#define G8_SA(b, h) (((b) * 2 + (h)) * g8::HTB)
#define G8_SB(b, h) ((4 + (b) * 2 + (h)) * g8::HTB)
#define G8_STAGE(bufoff, gbase, voff) do { _Pragma("unroll") for (int _i = 0; _i < 2; ++_i) \
        __builtin_amdgcn_global_load_lds((const unsigned*)((const char*)(gbase) + (voff)[_i]), (LAS unsigned*)(lds + (bufoff) + ldsw + _i * 8192), 16, 0, 0); } while (0)
#define G8_LDA(dst, b, h) do { _Pragma("unroll") for (int m = 0; m < 4; ++m) _Pragma("unroll") for (int k = 0; k < 2; ++k) dst[m][k] = *(const LAS bf16x8*)(lds + G8_SA(b, h) + aoff + m * 2048 + k * 1024); } while (0)
#define G8_LDB(dst, b, h) do { _Pragma("unroll") for (int n = 0; n < 2; ++n) _Pragma("unroll") for (int k = 0; k < 2; ++k) dst[n][k] = *(const LAS bf16x8*)(lds + G8_SB(b, h) + boff + n * 2048 + k * 1024); } while (0)
#define G8_MMA(ai, bj, At, Bt) do { __builtin_amdgcn_s_setprio(1); _Pragma("unroll") for (int m = 0; m < 4; ++m) _Pragma("unroll") for (int n = 0; n < 2; ++n) _Pragma("unroll") for (int k = 0; k < 2; ++k) \
        acc[ai][bj][m][n] = __builtin_amdgcn_mfma_f32_16x16x32_bf16(Bt[n][k], At[m][k], acc[ai][bj][m][n], 0, 0, 0); __builtin_amdgcn_s_setprio(0); } while (0)
#define G8_WAIT_V(n) asm volatile("s_waitcnt vmcnt(" #n ")" ::: "memory")
#define G8_WAIT_L(n) asm volatile("s_waitcnt lgkmcnt(" #n ")" ::: "memory")
#define G8_BAR __builtin_amdgcn_s_barrier()
#define G8_SCHED __builtin_amdgcn_sched_barrier(0)
    Unit cur, nxt; int ui = 0;
    if (!S.next(0, cur)) return;
    Acc acc;
    E.init(acc, cur, wr, wc, fr, fq);
    bf16x8 At[4][2], B0[2][2], B1[2][2];
    const char* cA = S.a_base(cur); const char* cB0 = S.b_base(cur, 0); const char* cB1 = S.b_base(cur, 1);
    S.a_offsets(cur, voffA, tid);
    G8_STAGE(G8_SB(0, 0), cB0, voffB); G8_STAGE(G8_SA(0, 0), cA, voffA[0]); G8_STAGE(G8_SB(0, 1), cB1, voffB); G8_STAGE(G8_SA(0, 1), cA, voffA[1]);
    if (wr == 1) G8_BAR;
    G8_WAIT_V(4); G8_BAR;
    G8_STAGE(G8_SB(1, 0), cB0 + kstep, voffB); G8_STAGE(G8_SA(1, 0), cA + kstep, voffA[0]); G8_STAGE(G8_SB(1, 1), cB1 + kstep, voffB);
    G8_WAIT_V(6); G8_BAR;
    E.post_prologue(acc);
    for (;;) {
        const bool has_next = S.next(ui + 1, nxt);
        const char* nA = has_next ? S.a_base(nxt) : cA; const char* nB0 = has_next ? S.b_base(nxt, 0) : cB0; const char* nB1 = has_next ? S.b_base(nxt, 1) : cB1;
        for (int t = 0; t < nt; t += 2) {
            const bool last = (t == nt - 2);
            const char* a1 = cA + (size_t)(t + 1) * kstep;
            const char* a2 = last ? nA : cA + (size_t)(t + 2) * kstep; const char* b20 = last ? nB0 : cB0 + (size_t)(t + 2) * kstep; const char* b21 = last ? nB1 : cB1 + (size_t)(t + 2) * kstep;
            const char* a3 = a2 + kstep; const char* b30 = b20 + kstep; const char* b31 = b21 + kstep;
            G8_LDB(B0, 0, 0); G8_SCHED; G8_LDA(At, 0, 0); G8_STAGE(G8_SA(1, 1), a1, voffA[1]);
            G8_WAIT_L(8); G8_BAR; G8_WAIT_L(0); G8_MMA(0, 0, At, B0); G8_BAR; G8_SCHED;
            if (last && has_next) S.a_offsets(nxt, voffA, tid);
            G8_LDB(B1, 0, 1); G8_STAGE(G8_SB(0, 0), b20, voffB);
            G8_BAR; G8_WAIT_L(0); G8_MMA(0, 1, At, B1); G8_BAR;
            G8_LDA(At, 0, 1); G8_STAGE(G8_SA(0, 0), a2, voffA[0]);
            G8_BAR; G8_WAIT_L(0); G8_MMA(1, 0, At, B0); G8_BAR; G8_SCHED;
            G8_STAGE(G8_SB(0, 1), b21, voffB);
            G8_WAIT_V(6); G8_BAR; G8_MMA(1, 1, At, B1); G8_BAR;
            G8_LDB(B0, 1, 0); G8_SCHED; G8_LDA(At, 1, 0); G8_STAGE(G8_SA(0, 1), a2, voffA[1]);
            G8_WAIT_L(8); G8_BAR; G8_WAIT_L(0); G8_MMA(0, 0, At, B0); G8_BAR; G8_SCHED;
            G8_LDB(B1, 1, 1); G8_STAGE(G8_SB(1, 0), b30, voffB);
            G8_BAR; G8_WAIT_L(0); G8_MMA(0, 1, At, B1); G8_BAR;
            G8_LDA(At, 1, 1); G8_STAGE(G8_SA(1, 0), a3, voffA[0]);
            G8_BAR; G8_WAIT_L(0); G8_MMA(1, 0, At, B0); G8_BAR; G8_SCHED;
            G8_STAGE(G8_SB(1, 1), b31, voffB);
            G8_WAIT_V(6); G8_BAR; G8_MMA(1, 1, At, B1); G8_BAR;
        }
        if constexpr (!Epi::AFTER_DRAIN) E(acc, cur, wr, wc, fr, fq);
        if (!has_next) break;
        cur = nxt; cA = nA; cB0 = nB0; cB1 = nB1; ++ui;
        E.init(acc, cur, wr, wc, fr, fq);
    }
    G8_WAIT_V(0);
    if (wr == 0) G8_BAR;
    G8_BAR;
    if constexpr (Epi::AFTER_DRAIN) E(acc, cur, wr, wc, fr, fq);
#undef G8_SA
#undef G8_SB
#undef G8_STAGE
#undef G8_LDA
#undef G8_LDB
#undef G8_MMA
#undef G8_WAIT_V
#undef G8_WAIT_L
#undef G8_BAR
#undef G8_SCHED
}
typedef int v8i __attribute__((ext_vector_type(8)));
typedef int v4i __attribute__((ext_vector_type(4)));
__device__ __forceinline__ void f8_rc(int tid, int i, int& R, int& Cb) { R = (tid >> 3) + 64 * i; Cb = ((tid & 7) ^ ((R >> 1) & 7)) << 4; }
template <int SCLW, class Epi, class Sched>
__device__ __forceinline__ void gemm_phase_f8(lds_t* lds, const int K, const Sched& S, const Epi& E) {
    int tid = threadIdx.x; asm volatile("" : "+v"(tid));
    const int wid = __builtin_amdgcn_readfirstlane(tid >> 6), lane = tid & 63, wr = wid >> 2, wc = wid & 3, fr = lane & 15, fq = lane >> 4;
    int nt = K / 128; asm volatile("" : "+s"(nt));
    unsigned voffA[2][2], voffB[2];
#pragma unroll
    for (int i = 0; i < 2; ++i) { int R, Cb; f8_rc(tid, i, R, Cb); const int Rb = (R & ~31) + perm32(R & 31); voffB[i] = (unsigned)(Rb * K + Cb); }
    const size_t kstep = 128;
    const unsigned ldsw = (unsigned)wid * 1024u;
    const int c0_ = ((2 * fq) ^ ((fr >> 1) & 7)) << 4;
    const int aoff = (wr * 64 + fr) * 128 + c0_, boff = (wc * 32 + fr) * 128 + c0_;
    constexpr int SCL_ACT = 0x7f7f7f7f, SCL_W = SCLW * 0x01010101;
#define G8_SA(b, h) (((b) * 2 + (h)) * g8::HTB)
#define G8_SB(b, h) ((4 + (b) * 2 + (h)) * g8::HTB)
#define G8_STAGE(bufoff, gbase, voff) do { _Pragma("unroll") for (int _i = 0; _i < 2; ++_i) \
        __builtin_amdgcn_global_load_lds((const unsigned*)((const char*)(gbase) + (voff)[_i]), (LAS unsigned*)(lds + (bufoff) + ldsw + _i * 8192), 16, 0, 0); } while (0)
#define G8_LDA(dst, b, h) do { _Pragma("unroll") for (int m = 0; m < 4; ++m) { const u32x4 lo_ = *(const LAS u32x4*)(lds + G8_SA(b, h) + aoff + m * 2048), hi_ = *(const LAS u32x4*)(lds + G8_SA(b, h) + (aoff ^ 16) + m * 2048); \
        dst[m] = __builtin_shufflevector(__builtin_bit_cast(v4i, lo_), __builtin_bit_cast(v4i, hi_), 0, 1, 2, 3, 4, 5, 6, 7); } } while (0)
#define G8_LDB(dst, b, h) do { _Pragma("unroll") for (int n = 0; n < 2; ++n) { const u32x4 lo_ = *(const LAS u32x4*)(lds + G8_SB(b, h) + boff + n * 2048), hi_ = *(const LAS u32x4*)(lds + G8_SB(b, h) + (boff ^ 16) + n * 2048); \
        dst[n] = __builtin_shufflevector(__builtin_bit_cast(v4i, lo_), __builtin_bit_cast(v4i, hi_), 0, 1, 2, 3, 4, 5, 6, 7); } } while (0)
#define G8_MMA(ai, bj, At, Bt) do { __builtin_amdgcn_s_setprio(1); _Pragma("unroll") for (int m = 0; m < 4; ++m) _Pragma("unroll") for (int n = 0; n < 2; ++n) \
        acc[ai][bj][m][n] = __builtin_amdgcn_mfma_scale_f32_16x16x128_f8f6f4(Bt[n], At[m], acc[ai][bj][m][n], 0, 0, 0, SCL_W, 0, SCL_ACT); __builtin_amdgcn_s_setprio(0); } while (0)
#define G8_WAIT_V(n) asm volatile("s_waitcnt vmcnt(" #n ")" ::: "memory")
#define G8_WAIT_L(n) asm volatile("s_waitcnt lgkmcnt(" #n ")" ::: "memory")
#define G8_BAR __builtin_amdgcn_s_barrier()
#define G8_SCHED __builtin_amdgcn_sched_barrier(0)
    Unit cur, nxt; int ui = 0;
    if (!S.next(0, cur)) return;
    Acc acc;
    E.init(acc, cur, wr, wc, fr, fq);
    v8i At[4], B0[2], B1[2];
    const char* cA = S.a_base(cur); const char* cB0 = S.b_base(cur, 0); const char* cB1 = S.b_base(cur, 1);
    S.a_offsets(cur, voffA, tid);
    G8_STAGE(G8_SB(0, 0), cB0, voffB); G8_STAGE(G8_SA(0, 0), cA, voffA[0]); G8_STAGE(G8_SB(0, 1), cB1, voffB); G8_STAGE(G8_SA(0, 1), cA, voffA[1]);
    if (wr == 1) G8_BAR;
    G8_WAIT_V(4); G8_BAR;
    G8_STAGE(G8_SB(1, 0), cB0 + kstep, voffB); G8_STAGE(G8_SA(1, 0), cA + kstep, voffA[0]); G8_STAGE(G8_SB(1, 1), cB1 + kstep, voffB);
    G8_WAIT_V(6); G8_BAR;
    E.post_prologue(acc);
    for (;;) {
        const bool has_next = S.next(ui + 1, nxt);
        const char* nA = has_next ? S.a_base(nxt) : cA; const char* nB0 = has_next ? S.b_base(nxt, 0) : cB0; const char* nB1 = has_next ? S.b_base(nxt, 1) : cB1;
#pragma unroll 1
        for (int t = 0; t < nt; t += 2) {
            const bool last = (t == nt - 2);
            const char* a1 = cA + (size_t)(t + 1) * kstep;
            const char* a2 = last ? nA : cA + (size_t)(t + 2) * kstep; const char* b20 = last ? nB0 : cB0 + (size_t)(t + 2) * kstep; const char* b21 = last ? nB1 : cB1 + (size_t)(t + 2) * kstep;
            const char* a3 = a2 + kstep; const char* b30 = b20 + kstep; const char* b31 = b21 + kstep;
            G8_LDB(B0, 0, 0); G8_SCHED; G8_LDA(At, 0, 0); G8_STAGE(G8_SA(1, 1), a1, voffA[1]);
            G8_WAIT_L(8); G8_BAR; G8_WAIT_L(0); G8_MMA(0, 0, At, B0); G8_BAR; G8_SCHED;
            if (last && has_next) S.a_offsets(nxt, voffA, tid);
            G8_LDB(B1, 0, 1); G8_STAGE(G8_SB(0, 0), b20, voffB);
            G8_BAR; G8_WAIT_L(0); G8_MMA(0, 1, At, B1); G8_BAR;
            G8_LDA(At, 0, 1); G8_STAGE(G8_SA(0, 0), a2, voffA[0]);
            G8_BAR; G8_WAIT_L(0); G8_MMA(1, 0, At, B0); G8_BAR; G8_SCHED;
            G8_STAGE(G8_SB(0, 1), b21, voffB);
            G8_WAIT_V(6); G8_BAR; G8_MMA(1, 1, At, B1); G8_BAR;
            G8_LDB(B0, 1, 0); G8_SCHED; G8_LDA(At, 1, 0); G8_STAGE(G8_SA(0, 1), a2, voffA[1]);
            G8_WAIT_L(8); G8_BAR; G8_WAIT_L(0); G8_MMA(0, 0, At, B0); G8_BAR; G8_SCHED;
            G8_LDB(B1, 1, 1); G8_STAGE(G8_SB(1, 0), b30, voffB);
            G8_BAR; G8_WAIT_L(0); G8_MMA(0, 1, At, B1); G8_BAR;
            G8_LDA(At, 1, 1); G8_STAGE(G8_SA(1, 0), a3, voffA[0]);
            G8_BAR; G8_WAIT_L(0); G8_MMA(1, 0, At, B0); G8_BAR; G8_SCHED;
            G8_STAGE(G8_SB(1, 1), b31, voffB);
            G8_WAIT_V(6); G8_BAR; G8_MMA(1, 1, At, B1); G8_BAR;
        }
        if constexpr (!Epi::AFTER_DRAIN) E(acc, cur, wr, wc, fr, fq);
        if (!has_next) break;
        cur = nxt; cA = nA; cB0 = nB0; cB1 = nB1; ++ui;
        E.init(acc, cur, wr, wc, fr, fq);
    }
    G8_WAIT_V(0);
    if (wr == 0) G8_BAR;
    G8_BAR;
    if constexpr (Epi::AFTER_DRAIN) E(acc, cur, wr, wc, fr, fq);
#undef G8_SA
#undef G8_SB
#undef G8_STAGE
#undef G8_LDA
#undef G8_LDB
#undef G8_MMA
#undef G8_WAIT_V
#undef G8_WAIT_L
#undef G8_BAR
#undef G8_SCHED
}
}

template <class CM>
__device__ __forceinline__ void transpose_tile(const float* src, int Nsrc, int K, bf16_t* dst, int k0, int n0, CM cm, LAS float* scr) {
    const int tid = threadIdx.x;
    {
        const int tx = tid & 63, ty = tid >> 6;
        const int scol = cm(n0 + tx);
#pragma unroll
        for (int i = 0; i < 8; ++i) { const int kk = ty + 8 * i; scr[kk * 65 + tx] = scol >= 0 ? src[(size_t)(k0 + kk) * Nsrc + scol] : 0.f; }
    }
    __syncthreads();
    {
        const int kp = tid & 31, n1 = tid >> 5;
#pragma unroll
        for (int i = 0; i < 4; ++i) { const int nn = n1 + 16 * i;
            *(unsigned*)(dst + (size_t)(n0 + nn) * K + k0 + 2 * kp) = pk2(scr[(2 * kp) * 65 + nn], scr[(2 * kp + 1) * 65 + nn]); }
    }
    __syncthreads();
}

__device__ __forceinline__ void transpose_tile_f8(const float* src, int Nsrc, int K, unsigned char* dst8, int k0, int n0, float scale, LAS float* scr) {
    const int tid = threadIdx.x;
    {
        const int tx = tid & 63, ty = tid >> 6;
#pragma unroll
        for (int i = 0; i < 8; ++i) { const int kk = ty + 8 * i; scr[kk * 65 + tx] = src[(size_t)(k0 + kk) * Nsrc + n0 + tx]; }
    }
    __syncthreads();
    {
        const int kq = tid & 15, n1 = tid >> 4;
#pragma unroll
        for (int i = 0; i < 2; ++i) { const int nn = n1 + 32 * i;
            *(unsigned*)(dst8 + (size_t)(n0 + nn) * K + k0 + 4 * kq) = pk4_f8(scale * scr[(4 * kq) * 65 + nn], scale * scr[(4 * kq + 1) * 65 + nn], scale * scr[(4 * kq + 2) * 65 + nn], scale * scr[(4 * kq + 3) * 65 + nn]); }
    }
    __syncthreads();
}

__device__ __forceinline__ int inproj_srccol(int n) {
    if (n < 512) return n;
    if (n < 1536) { const int i = (n - 512) >> 1; return (n & 1) ? 1024 + i : 512 + i; }
    if (n < 2840) return n;
    return -1;
}

__device__ __forceinline__ void phase_prep(const Params& P, lds_t* lds) {
    LAS float* scr = (LAS float*)lds;
    unsigned char* ws = P.ws;
    const int G = gridDim.x, bid = blockIdx.x, tid = threadIdx.x;
    constexpr int T_IN = 16 * 48, T_OUT = 256, T_PG = 256, T_PLE = 64, T_W1 = 64, T_W2 = 2, T_EIN = 32 * 256, T_EOUT = 32 * 128;
    constexpr int NT = T_IN + T_OUT + T_PG + T_PLE + 2 * T_W1 + 2 * T_W2 + T_EIN + T_EOUT;
    for (int it = bid; it < NT; it += G) {
        int x = it;
        if (x < T_IN) { transpose_tile(P.in[2], 2840, 1024, (bf16_t*)(ws + WS_WIN), (x / 48) * 64, (x % 48) * 64, [](int n) { return n < 2840 ? n : -1; }, scr); continue; } x -= T_IN;
        if (x < T_OUT) { transpose_tile(P.in[10], 1024, 1024, (bf16_t*)(ws + WS_WOUT), (x / 16) * 64, (x % 16) * 64, [](int n) { return n; }, scr); continue; } x -= T_OUT;
        if (x < T_PG) { transpose_tile(P.in[22], 1024, 1024, (bf16_t*)(ws + WS_WPG), (x / 16) * 64, (x % 16) * 64, [](int n) { return n; }, scr); continue; } x -= T_PG;
        if (x < T_PLE) { transpose_tile(P.in[21], 1024, 256, (bf16_t*)(ws + WS_WPLE), (x / 16) * 64, (x % 16) * 64, [](int n) { return n; }, scr); continue; } x -= T_PLE;
        if (x < T_W1) { transpose_tile(P.in[5], 128, 2048, (bf16_t*)(ws + WS_W1CK), (x / 2) * 64, (x % 2) * 64, [](int n) { return n; }, scr); continue; } x -= T_W1;
        if (x < T_W1) { transpose_tile(P.in[8], 128, 2048, (bf16_t*)(ws + WS_W1CV), (x / 2) * 64, (x % 2) * 64, [](int n) { return n; }, scr); continue; } x -= T_W1;
        if (x < T_W2) { transpose_tile(P.in[6], 64, 128, (bf16_t*)(ws + WS_W2CK), x * 64, 0, [](int n) { return n; }, scr); continue; } x -= T_W2;
        if (x < T_W2) { transpose_tile(P.in[9], 64, 128, (bf16_t*)(ws + WS_W2CV), x * 64, 0, [](int n) { return n; }, scr); continue; } x -= T_W2;
        if (x < T_EIN) { const int e = x >> 8, y = x & 255;
            transpose_tile_f8(P.in[17] + (size_t)e * 1024 * 1024, 1024, 1024, ws + WS_WEIN + (size_t)e * 1024 * 1024, (y / 16) * 64, (y % 16) * 64, 16.f, scr); continue; } x -= T_EIN;
        { const int e = x >> 7, y = x & 127;
            transpose_tile_f8(P.in[18] + (size_t)e * 512 * 1024, 1024, 512, ws + WS_WEOUT + (size_t)e * 1024 * 512, (y / 16) * 64, (y % 16) * 64, 16.f, scr); }
    }
    {
        const size_t gtid = (size_t)bid * NTHREADS + tid, gsz = (size_t)G * NTHREADS;
        const float* x = P.in[0]; bf16_t* xb = (bf16_t*)(ws + WS_H1LO);
        for (size_t i = gtid; i < (size_t)T * DM / 8; i += gsz) {
            const f32x4 a = *(const f32x4*)(x + i * 8), b = *(const f32x4*)(x + i * 8 + 4);
            u32x4 o; o.x = pk2(a[0], a[1]); o.y = pk2(a[2], a[3]); o.z = pk2(b[0], b[1]); o.w = pk2(b[2], b[3]);
            *(u32x4*)(xb + i * 8) = o;
        }
        const float* pp = P.in[1]; bf16_t* pb = (bf16_t*)(ws + WS_PB);
        for (size_t i = gtid; i < (size_t)T * 256 / 8; i += gsz) {
            const f32x4 a = *(const f32x4*)(pp + i * 8), b = *(const f32x4*)(pp + i * 8 + 4);
            u32x4 o; o.x = pk2(a[0], a[1]); o.y = pk2(a[2], a[3]); o.z = pk2(b[0], b[1]); o.w = pk2(b[2], b[3]);
            *(u32x4*)(pb + i * 8) = o;
        }
        bf16_t* wrb = (bf16_t*)(ws + WS_WRB);
        for (size_t i = gtid; i < 64 * 3072; i += gsz) {
            const int n = (int)(i / 3072), kk = (int)(i % 3072), k = kk & 1023, seg = kk >> 10;
            float v = 0.f;
            if (n < 4) v = P.in[13][k * 4 + n]; else if (n < 36) v = P.in[15][k * 32 + (n - 4)];
            const bf16_t hi = f2bf(v); const bf16_t lo = f2bf(v - bf2f(hi));
            wrb[i] = (seg == 1) ? lo : hi;
        }
    }
    if (bid == (G > 1 ? 1 : 0) || bid == (G > 2 ? 2 : 0)) {
        for (int which = 0; which < 2; ++which) {
            if (bid != ((which == 0) ? (G > 1 ? 1 : 0) : (G > 2 ? 2 : 0))) continue;
            const float* pe = P.in[which ? 7 : 4]; const float* w1 = P.in[which ? 8 : 5];
            const int n = tid & 127, ks = tid >> 7;
            float s = 0.f;
            for (int k = ks * 512; k < ks * 512 + 512; ++k) s += pe[k] * w1[(size_t)k * 128 + n];
            scr[ks * 128 + n] = s;
            __syncthreads();
            if (tid < 128) ((float*)(ws + WS_BIAS1))[which * 128 + tid] = scr[tid] + scr[128 + tid] + scr[256 + tid] + scr[384 + tid];
            __syncthreads();
        }
    }
    if (bid == 0 && tid < 64) ((int*)(ws + WS_CTL))[tid] = 0;
#ifndef ATOMIC_BENCH
#define ATOMIC_BENCH 0
#endif
#if ATOMIC_BENCH == 1
    { LAS float* fb = (LAS float*)(lds + 65536);
      for (int it = 0; it < 200; ++it) {
#pragma unroll
        for (int k = 0; k < 16; ++k) lds_addf(fb + (k * 512 + tid), 1.0f); } }
#elif ATOMIC_BENCH == 2
    { LAS int* fb = (LAS int*)(lds + 65536);
      for (int it = 0; it < 200; ++it) {
#pragma unroll
        for (int k = 0; k < 16; ++k) (void)__hip_atomic_fetch_add(fb + (k * 512 + tid), 1, __ATOMIC_RELAXED, __HIP_MEMORY_SCOPE_WORKGROUP); } }
#endif
}

struct SchedInproj {
    const bf16_t* xb; const bf16_t* wt; int G, c;
    __device__ __forceinline__ bool next(int i, g8::Unit& u) const {
        if (G == 256) { if (i >= 6) return false; const int qb = i * 8 + (c & 7), k = c >> 3; u.pm = (qb / 3) * 8 + (k & 7); u.pn = (qb % 3) * 4 + (k >> 3); return true; }
        const int L = i * G + c; if (L >= 128 * 12) return false; u.pm = L / 12; u.pn = L % 12; return true; }
    __device__ __forceinline__ const char* a_base(const g8::Unit& u) const { return (const char*)(xb + (size_t)u.pm * 256 * 1024); }
    __device__ __forceinline__ const char* b_base(const g8::Unit& u, int h) const {
        const int row = (u.pn >= 2 && u.pn < 6) ? ((h ? 1024 : 512) + (u.pn - 2) * 128) : (u.pn * 256 + h * 128);
        return (const char*)(wt + (size_t)row * 1024); }
    __device__ __forceinline__ void a_offsets(const g8::Unit&, unsigned (&v)[2][2], int tid) const { g8::natural_offsets(v, 1024, tid); }
};
struct EpiInproj {
    static constexpr bool AFTER_DRAIN = false;
    unsigned char* ws;
    __device__ __forceinline__ void init(g8::Acc& acc, const g8::Unit&, int, int, int, int) const { g8::acc_zero(acc); }
    __device__ __forceinline__ void post_prologue(g8::Acc&) const {}
    __device__ __forceinline__ void operator()(g8::Acc& acc, const g8::Unit& u, int wr, int wc, int fr, int fq) const {
        const int n0 = wc * 32 + 8 * fq;
        const int pn = u.pn;
        if (pn >= 2 && pn < 6) {
#pragma unroll
            for (int ai = 0; ai < 2; ++ai)
#pragma unroll
                for (int m = 0; m < 4; ++m) { const int t = u.pm * 256 + ai * 128 + wr * 64 + m * 16 + fr;
                    *(u32x4*)((bf16_t*)(ws + WS_U) + (size_t)t * 512 + (pn - 2) * 128 + n0) = pk8(acc[ai][0][m][0] * acc[ai][1][m][0], acc[ai][0][m][1] * acc[ai][1][m][1]); }
            return;
        }
#pragma unroll
        for (int bj = 0; bj < 2; ++bj) {
#pragma unroll
            for (int ai = 0; ai < 2; ++ai)
#pragma unroll
                for (int m = 0; m < 4; ++m) { const int t = u.pm * 256 + ai * 128 + wr * 64 + m * 16 + fr; const int b = t >> 13, s_ = t & 8191;
                    const f32x4 v0 = acc[ai][bj][m][0], v1 = acc[ai][bj][m][1];
                    if (pn < 2) *(u32x4*)((bf16_t*)(ws + WS_CB) + (size_t)t * 512 + pn * 256 + bj * 128 + n0) = pk8(v0, v1);
                    else if (pn < 8) *(u32x4*)((bf16_t*)(ws + WS_Q) + (size_t)t * 512 + (pn - 6) * 256 + bj * 128 + n0) = pk8(v0 * QSCALE, v1 * QSCALE);
                    else if (pn == 8) *(u32x4*)((bf16_t*)(ws + (bj ? WS_VC : WS_KC)) + (size_t)t * 128 + n0) = pk8(v0, v1);
                    else if (pn < 11) { const int kvh = n0 >> 6, d = n0 & 63;
                        if (bj == 0) *(u32x4*)((bf16_t*)(ws + (pn == 9 ? WS_KS : WS_KW)) + ((size_t)((b * 2 + kvh) * SEQ + s_)) * 64 + d) = pk8(v0, v1);
                        else { bf16_t* base = (bf16_t*)(ws + (pn == 9 ? WS_VST : WS_VWT)) + ((size_t)((b * 2 + kvh) * 128 + (s_ >> 6)) * 64 + d) * 64 + (s_ & 63);
#pragma unroll
                            for (int c = 0; c < 4; ++c) { base[c * 64] = f2bf(v0[c]); base[(4 + c) * 64] = f2bf(v1[c]); } } }
                    else if (bj == 0 && n0 < 24) { float* gp = (float*)(ws + WS_G) + (size_t)t * 24 + n0;
                        *(f32x4*)gp = (f32x4){sigmoidf_(v0[0]), sigmoidf_(v0[1]), sigmoidf_(v0[2]), sigmoidf_(v0[3])};
                        *(f32x4*)(gp + 4) = (f32x4){sigmoidf_(v1[0]), sigmoidf_(v1[1]), sigmoidf_(v1[2]), sigmoidf_(v1[3])}; }
                }
        }
    }
};
__device__ __forceinline__ void phase_inproj(const Params& P, lds_t* lds) {
    SchedInproj S{(const bf16_t*)(P.ws + WS_H1LO), (const bf16_t*)(P.ws + WS_WIN), (int)gridDim.x, (int)blockIdx.x};
    EpiInproj E{P.ws};
    g8::gemm_phase(lds, 1024, S, E);
}

__device__ __forceinline__ float gelu_tanh(float x) {
    const float u = 0.7978845608028654f * (x + 0.044715f * x * x * x);
    const float e = __expf(2.f * u);
    const float th = 1.f - 2.f / (e + 1.f);
    return 0.5f * x * (1.f + th);
}

__device__ __forceinline__ void phase_conv_compress(const Params& P, lds_t* lds) {
    unsigned char* ws = P.ws;
    int tid = threadIdx.x; asm volatile("" : "+v"(tid));
    const int lane = tid & 63, wid = __builtin_amdgcn_readfirstlane(tid >> 6), r = lane & 15, q = lane >> 4, sc = tid & 7, sr = tid >> 3;
    const int G = gridDim.x;
    const int NCW = G >= 2 ? (G / 2 < 128 ? G / 2 : 128) : 1;
    const bool do_cmp = (int)blockIdx.x < NCW, do_conv = G < 2 || (int)blockIdx.x >= NCW;
    if (do_cmp) for (int tile = blockIdx.x; tile < 128; tile += NCW) {
        const int which = tile >> 6, mt = tile & 63;
        const bf16_t* src = (const bf16_t*)(ws + (which ? WS_VC : WS_KC));
        const bf16_t* w1 = (const bf16_t*)(ws + (which ? WS_W1CV : WS_W1CK));
        const bf16_t* w2 = (const bf16_t*)(ws + (which ? WS_W2CV : WS_W2CK));
        const float* bias1 = (const float*)(ws + WS_BIAS1) + which * 128;
        const bf16_t* ap[1]; const bf16_t* bp[2];
        { const int row = mt * 64 + sr; const int bk = row >> 9; int n = row & 511; if (n > 510) n = 510;
            ap[0] = src + (size_t)((bk >> 1) * SEQ + 16 * n) * 128 + (bk & 1) * 64 + sc * 8; }
#pragma unroll
        for (int i = 0; i < 2; ++i) bp[i] = w1 + (size_t)(sr + 64 * i) * 2048 + sc * 8;
        f32x4 acc[2][2];
        gemm_mainloop<64, 128, 32, 32>(lds, ap, 128, bp, 32, acc);
        const int wm = wid >> 2, wn = wid & 3;
#pragma unroll
        for (int i = 0; i < 2; ++i) { const int m = wm * 32 + i * 16 + r;
#pragma unroll
            for (int j = 0; j < 2; ++j) { const int n = wn * 32 + j * 16 + 4 * q; const f32x4 bv = *(const f32x4*)(bias1 + n); f32x4 v = acc[i][j] + bv;
                v = (f32x4){gelu_tanh(v[0]), gelu_tanh(v[1]), gelu_tanh(v[2]), gelu_tanh(v[3])};
                const int kk = n >> 6, c = (n & 63) >> 3, half = (n & 7) >> 2;
                *(LAS u32x2*)(lds + kk * 8192 + lds_off(m, c) + half * 8) = pk4(v); } }
#pragma unroll
        for (int kk = 0; kk < 2; ++kk) lds_st16(lds + 65536 + kk * 8192 + lds_off(sr, sc), *(const u32x4*)(w2 + (size_t)sr * 128 + kk * 64 + sc * 8));
        __syncthreads();
        f32x4 a2[2] = {(f32x4){0.f, 0.f, 0.f, 0.f}, (f32x4){0.f, 0.f, 0.f, 0.f}};
#pragma unroll
        for (int kk = 0; kk < 2; ++kk)
#pragma unroll
            for (int s = 0; s < 2; ++s) {
                const bf16x8 a = lds_ld16(lds + kk * 8192 + lds_off(16 * (wid >> 1) + r, 4 * s + q));
#pragma unroll
                for (int j = 0; j < 2; ++j) { const bf16x8 bq = lds_ld16(lds + 65536 + kk * 8192 + lds_off((wid & 1) * 32 + j * 16 + r, 4 * s + q)); a2[j] = mfma16(bq, a, a2[j]); }
            }
        { const int row = mt * 64 + 16 * (wid >> 1) + r; const int bk = row >> 9, n = row & 511;
#pragma unroll
            for (int j = 0; j < 2; ++j) { const int d = (wid & 1) * 32 + j * 16 + 4 * q; const f32x4 v = a2[j];
                if (!which) *(u32x2*)((bf16_t*)(ws + WS_KCMP) + (size_t)(bk * 512 + n) * 64 + d) = pk4(v);
                else { bf16_t* base = (bf16_t*)(ws + WS_VCMPT) + ((size_t)((bk * 8 + (n >> 6)) * 64 + d)) * 64 + (n & 63);
                    base[0] = f2bf(v[0]); base[64] = f2bf(v[1]); base[128] = f2bf(v[2]); base[192] = f2bf(v[3]); } } }
        __syncthreads();
    }
    {
        const bf16_t* U = (const bf16_t*)(ws + WS_U); const bf16_t* CB = (const bf16_t*)(ws + WS_CB); bf16_t* Y = (bf16_t*)(ws + WS_RA);
        const float* wc = P.in[3];
        const size_t gtid = (size_t)(G < 2 ? 0 : (int)blockIdx.x - NCW) * NTHREADS + tid, gsz = (size_t)(G < 2 ? 1 : G - NCW) * NTHREADS;
        if (do_conv) for (size_t it = gtid; it < (size_t)T * 64; it += gsz) {
            const int t = (int)(it >> 6), c8 = (int)(it & 63) * 8, s = t & 8191;
            const u32x4 u2 = *(const u32x4*)(U + (size_t)t * 512 + c8);
            u32x4 u1 = (u32x4){0, 0, 0, 0}, u0 = (u32x4){0, 0, 0, 0};
            if (s >= 1) u1 = *(const u32x4*)(U + (size_t)(t - 1) * 512 + c8);
            if (s >= 2) u0 = *(const u32x4*)(U + (size_t)(t - 2) * 512 + c8);
            const u32x4 cb = *(const u32x4*)(CB + (size_t)t * 512 + c8);
            const f32x4 w0a = *(const f32x4*)(wc + c8), w0b = *(const f32x4*)(wc + c8 + 4);
            const f32x4 w1a = *(const f32x4*)(wc + 512 + c8), w1b = *(const f32x4*)(wc + 512 + c8 + 4);
            const f32x4 w2a = *(const f32x4*)(wc + 1024 + c8), w2b = *(const f32x4*)(wc + 1024 + c8 + 4);
            u32x4 o;
#define CONV2(W, IDX, A0, A1) { const float y0 = bflo(cb.W) * (w0##A0[IDX] * bflo(u0.W) + w1##A0[IDX] * bflo(u1.W) + w2##A0[IDX] * bflo(u2.W)); \
                                const float y1 = bfhi(cb.W) * (w0##A1[IDX + 1] * bfhi(u0.W) + w1##A1[IDX + 1] * bfhi(u1.W) + w2##A1[IDX + 1] * bfhi(u2.W)); o.W = pk2(y0, y1); }
            CONV2(x, 0, a, a) CONV2(y, 2, a, a) CONV2(z, 0, b, b) CONV2(w, 2, b, b)
#undef CONV2
            *(u32x4*)(Y + (size_t)t * 1024 + c8) = o;
        }
    }
}

constexpr int L_Q = 0;
constexpr int L_IMP = 32768;
constexpr int L_OST = 32768;
constexpr int OSS = 68;
constexpr int L_MS = 102400;
constexpr int L_LS = 103424;
constexpr int L_RING = 104448;
constexpr int L_SELM = 153600;
constexpr int L_LIST = 154624;
constexpr int L_NJ = 162816;
constexpr int IMPS = 129;

struct QKFrag { bf16x8 k[4][2]; };
struct VFrag { bf16x8 v[4][2]; };

__device__ __forceinline__ float red16_max(float v) { auto t = __builtin_amdgcn_permlane16_swap(__float_as_uint(v), __float_as_uint(v), false, false); return fmaxf(__uint_as_float(t[0]), __uint_as_float(t[1])); }
__device__ __forceinline__ float red32_max(float v) { auto t = __builtin_amdgcn_permlane32_swap(__float_as_uint(v), __float_as_uint(v), false, false); return fmaxf(__uint_as_float(t[0]), __uint_as_float(t[1])); }
__device__ __forceinline__ float red16_sum(float v) { auto t = __builtin_amdgcn_permlane16_swap(__float_as_uint(v), __float_as_uint(v), false, false); return __uint_as_float(t[0]) + __uint_as_float(t[1]); }
__device__ __forceinline__ float red32_sum(float v) { auto t = __builtin_amdgcn_permlane32_swap(__float_as_uint(v), __float_as_uint(v), false, false); return __uint_as_float(t[0]) + __uint_as_float(t[1]); }
__device__ __forceinline__ float rowq_max(float v) { return red32_max(red16_max(v)); }
__device__ __forceinline__ float rowq_sum(float v) { return red32_sum(red16_sum(v)); }
template <int CTRL> __device__ __forceinline__ float dpp_f(float v) { return __int_as_float(__builtin_amdgcn_update_dpp(0, __float_as_int(v), CTRL, 0xf, 0xf, true)); }
template <int CTRL> __device__ __forceinline__ int dpp_i(int v) { return __builtin_amdgcn_update_dpp(0, v, CTRL, 0xf, 0xf, true); }
__device__ __forceinline__ float quad_sum(float v) { v += dpp_f<0xB1>(v); v += dpp_f<0x4E>(v); return v; }

__device__ __forceinline__ void lds_kfrag(QKFrag& f, lds_t* kslot, int r, int q) {
    int o0 = r * 128 + ((q ^ (r >> 1)) << 4); asm volatile("" : "+v"(o0));
#pragma unroll
    for (int nt = 0; nt < 4; ++nt)
#pragma unroll
        for (int s = 0; s < 2; ++s) f.k[nt][s] = lds_ld16(kslot + ((o0 ^ (s << 6)) + nt * 2048));
}
__device__ __forceinline__ void lds_vfrag(VFrag& f, lds_t* vslot, int r, int q) {
    int o0 = r * 128 + ((q & 1) << 3) + (((q >> 1) ^ (r >> 1)) << 4); asm volatile("" : "+v"(o0));
#pragma unroll
    for (int dt = 0; dt < 4; ++dt)
#pragma unroll
        for (int ks = 0; ks < 2; ++ks) {
            const u32x2 lo = *(LAS u32x2*)(vslot + ((o0 ^ (ks << 6)) + dt * 2048));
            const u32x2 hi = *(LAS u32x2*)(vslot + ((o0 ^ (ks << 6) ^ 32) + dt * 2048));
            u32x4 w; w.x = lo.x; w.y = lo.y; w.z = hi.x; w.w = hi.y;
            f.v[dt][ks] = __builtin_bit_cast(bf16x8, w);
        }
}
__device__ __forceinline__ void qk_tile(f32x4 (&st)[4], const QKFrag& f, const bf16x8 (&yq)[2]) {
#pragma unroll
    for (int nt = 0; nt < 4; ++nt) { f32x4 z = (f32x4){0.f, 0.f, 0.f, 0.f}; z = mfma16(f.k[nt][0], yq[0], z); st[nt] = mfma16(f.k[nt][1], yq[1], z); }
}
__device__ __forceinline__ void pv_tile(f32x4 (&o)[4], const VFrag& f, const f32x4 (&p)[4]) {
    bf16x8 pf[2];
#pragma unroll
    for (int ks = 0; ks < 2; ++ks) { u32x4 w; w.x = pk2(p[2 * ks][0], p[2 * ks][1]); w.y = pk2(p[2 * ks][2], p[2 * ks][3]); w.z = pk2(p[2 * ks + 1][0], p[2 * ks + 1][1]); w.w = pk2(p[2 * ks + 1][2], p[2 * ks + 1][3]);
        pf[ks] = __builtin_bit_cast(bf16x8, w); }
#pragma unroll
    for (int dt = 0; dt < 4; ++dt) { o[dt] = mfma16(f.v[dt][0], pf[0], o[dt]); o[dt] = mfma16(f.v[dt][1], pf[1], o[dt]); }
}
constexpr float SM_THR = 8.f;
__device__ __forceinline__ void qk_tile_c(f32x4 (&st)[4], const QKFrag& f, const bf16x8 (&yq)[2], f32x4 cinit) {
#pragma unroll
    for (int nt = 0; nt < 4; ++nt) { f32x4 z = mfma16(f.k[nt][0], yq[0], cinit); st[nt] = mfma16(f.k[nt][1], yq[1], z); }
}
__device__ __forceinline__ float max16(const f32x4 (&st)[4]) {
    float a = fmaxf(fmaxf(st[0][0], st[0][1]), fmaxf(st[0][2], st[0][3]));
#pragma unroll
    for (int nt = 1; nt < 4; ++nt) a = fmaxf(a, fmaxf(fmaxf(st[nt][0], st[nt][1]), fmaxf(st[nt][2], st[nt][3])));
    return a;
}
__device__ __forceinline__ void mask16(f32x4 (&st)[4], int lo, int hi) {
#pragma unroll
    for (int nt = 0; nt < 4; ++nt)
#pragma unroll
        for (int c = 0; c < 4; ++c) { const int kc_ = 16 * nt + c; if (!((kc_ <= hi) && (kc_ > lo))) st[nt][c] = -1e30f; }
}
__device__ __forceinline__ void softmax_first(float& m, float& l, f32x4& negm, f32x4 (&st)[4]) {
    const float mx = rowq_max(max16(st));
    m = (mx > -1e29f) ? mx : 0.f; negm = (f32x4){-m, -m, -m, -m};
    float ps = 0.f;
#pragma unroll
    for (int nt = 0; nt < 4; ++nt)
#pragma unroll
        for (int c = 0; c < 4; ++c) { const float pp = fexp2(st[nt][c] - m); st[nt][c] = pp; ps += pp; }
    l = ps;
}
template <bool HAS_O>
__device__ __forceinline__ void softmax_next(float& m, float& l, f32x4& negm, f32x4 (&o)[4], f32x4 (&st)[4]) {
    const float mxl = max16(st);
    if (__builtin_amdgcn_ballot_w64(mxl > SM_THR) != 0ull) {
        const float mx = rowq_max(mxl); const float sh = (mx > SM_THR) ? mx : 0.f; const float a = fexp2(-sh);
        m += sh; l *= a; negm = (f32x4){-m, -m, -m, -m};
        if (HAS_O) {
#pragma unroll
            for (int d = 0; d < 4; ++d) o[d] = o[d] * a; }
#pragma unroll
        for (int nt = 0; nt < 4; ++nt)
#pragma unroll
            for (int c = 0; c < 4; ++c) st[nt][c] -= sh;
    }
    float ps = 0.f;
#pragma unroll
    for (int nt = 0; nt < 4; ++nt)
#pragma unroll
        for (int c = 0; c < 4; ++c) { const float pp = fexp2(st[nt][c]); st[nt][c] = pp; ps += pp; }
    l += ps;
}

__device__ __forceinline__ void phase_nsa(const Params& P, lds_t* lds) {
    unsigned char* ws = P.ws;
    const int wid = __builtin_amdgcn_readfirstlane(threadIdx.x >> 6);
    const int G = gridDim.x, g = blockIdx.x;
#define NSA_TID int tid = threadIdx.x; asm volatile("" : "+v"(tid));
#define NSA_LANE_VARS int lane_ = threadIdx.x & 63; asm volatile("" : "+v"(lane_)); const int r = lane_ & 15, q = lane_ >> 4;
    const bf16_t* Qb = (const bf16_t*)(ws + WS_Q);
    const float* GT = (const float*)(ws + WS_G);
    bf16_t* Y = (bf16_t*)(ws + WS_RA);
    LAS float* IMPA = (LAS float*)(lds + L_IMP);
    LAS float* IMPB = (LAS float*)(lds + L_IMP + 64 * IMPS * 4);
    LAS unsigned* SELM = (LAS unsigned*)(lds + L_SELM);
    LAS unsigned char* LIST = (LAS unsigned char*)(lds + L_LIST);
    LAS unsigned char* NJ = (LAS unsigned char*)(lds + L_NJ);
    const f32x4 NEGBIG = (f32x4){-1e30f, -1e30f, -1e30f, -1e30f};
    const f32x4 ZERO4 = (f32x4){0.f, 0.f, 0.f, 0.f};

    const int GQ = G >> 3;
    for (int k = 0;; ++k) {
        int jt, bk;
        if ((G & 7) == 0 && GQ > 0) { const int gi = g >> 3; const int u = (k & 1) ? (k + 1) * GQ - 1 - gi : k * GQ + gi; if (k * GQ >= 128) break; if (u >= 128) continue; jt = 127 - u; bk = g & 7; }
        else { const int idx = k * G + g; if (idx >= 1024) break; jt = 127 - (idx >> 3); bk = idx & 7; }
        const int b = bk >> 1, kvh = bk & 1, t0 = jt * 64;
        { NSA_TID
#pragma unroll
        for (int i = 0; i < 4; ++i) { const int row = (tid >> 3) + 64 * i, c = tid & 7, tok = row >> 2, hh = row & 3;
            lds_st16(lds + L_Q + lds_off(row, c), *(const u32x4*)(Qb + (size_t)(b * SEQ + t0 + tok) * 512 + kvh * 256 + hh * 64 + c * 8)); }
        if (tid < 256) SELM[tid] = 0u; }
        __syncthreads();
#define NSA_GATE(h_, br_) (GT[(size_t)(b * SEQ + t0 + ((32 * wid + 16 * (h_) + r) >> 2)) * 24 + (kvh * 4 + (r & 3)) * 3 + (br_)])
        { NSA_LANE_VARS NSA_TID
            const int nblk = (4 * jt + 3 + 63) >> 6;
            const int nfull = 4 * jt - 2;
            const unsigned goff = (unsigned)tid * 16u;
            const unsigned char* kcb = ws + WS_KCMP + (size_t)bk * 65536;
            const unsigned char* vcb = ws + WS_VCMPT + (size_t)bk * 65536;
            const int stw = lds_off(tid >> 3, tid & 7);
            bf16x8 yq[2][2]; int nlim[2]; float cm[2] = {0.f, 0.f}, cl[2] = {0.f, 0.f}; f32x4 negm[2] = {ZERO4, ZERO4};
#pragma unroll
            for (int h = 0; h < 2; ++h) { const int qrow = 32 * wid + 16 * h + r; nlim[h] = (t0 + (qrow >> 2) - 31) >> 4;
#pragma unroll
                for (int s = 0; s < 2; ++s) yq[h][s] = lds_ld16(lds + L_Q + lds_off(qrow, 4 * s + q)); }
            {
                u32x4 pk_ = *(const u32x4*)(kcb + goff);
#pragma unroll 1
                for (int blk = 0; blk < nblk; ++blk) {
                    lds_t* slot = lds + L_RING + (blk & 1) * 16384;
                    lds_st16(slot + stw, pk_);
                    if (blk + 1 < nblk) pk_ = *(const u32x4*)(kcb + (size_t)(blk + 1) * 8192 + goff);
                    __syncthreads();
                    QKFrag kf; lds_kfrag(kf, slot, r, q);
                    const bool edge = (64 * blk + 63 > nfull);
#pragma unroll
                    for (int h = 0; h < 2; ++h) {
                        f32x4 st[4], dummy[4];
                        if (blk == 0) { qk_tile_c(st, kf, yq[h], ZERO4); if (edge) mask16(st, -1000, nlim[h] - 4 * q); softmax_first(cm[h], cl[h], negm[h], st); }
                        else { qk_tile_c(st, kf, yq[h], negm[h]); if (edge) mask16(st, -1000, nlim[h] - 64 * blk - 4 * q); softmax_next<false>(cm[h], cl[h], negm[h], dummy, st); }
                    }
                }
            }
            float cil[2];
#pragma unroll
            for (int h = 0; h < 2; ++h) { const float l = rowq_sum(cl[h]); cil[h] = l > 0.f ? 1.f / l : 0.f; }
            __syncthreads();
            f32x4 oc[2][4];
#pragma unroll
            for (int h = 0; h < 2; ++h)
#pragma unroll
                for (int d = 0; d < 4; ++d) oc[h][d] = ZERO4;
            {
                u32x4 pk_ = *(const u32x4*)(kcb + goff), pv_ = *(const u32x4*)(vcb + goff);
#pragma unroll 1
                for (int blk = 0; blk < nblk; ++blk) {
                    lds_t* slot = lds + L_RING + (blk & 1) * 16384;
                    lds_st16(slot + stw, pk_); lds_st16(slot + 8192 + stw, pv_);
                    if (blk + 1 < nblk) { pk_ = *(const u32x4*)(kcb + (size_t)(blk + 1) * 8192 + goff); pv_ = *(const u32x4*)(vcb + (size_t)(blk + 1) * 8192 + goff); }
                    __syncthreads();
                    QKFrag kf; lds_kfrag(kf, slot, r, q);
                    const bool edge = (64 * blk + 63 > nfull);
                    f32x4 st[2][4];
#pragma unroll
                    for (int h = 0; h < 2; ++h) {
                        qk_tile_c(st[h], kf, yq[h], negm[h]);
                        if (edge) mask16(st[h], -1000, nlim[h] - 64 * blk - 4 * q);
                        const int tok = (32 * wid + 16 * h + r) >> 2;
#pragma unroll
                        for (int nt = 0; nt < 4; ++nt) {
#pragma unroll
                            for (int c = 0; c < 4; ++c) st[h][nt][c] = fexp2(st[h][nt][c]);
                            const float s4 = quad_sum(((st[h][nt][0] + st[h][nt][1]) + (st[h][nt][2] + st[h][nt][3])) * cil[h]), p3 = quad_sum(st[h][nt][3] * cil[h]);
                            if ((r & 3) == 0) { const int jj = 16 * blk + 4 * nt + q; IMPA[tok * IMPS + jj] = s4; IMPB[tok * IMPS + jj + 1] = p3; }
                        }
                    }
                    VFrag vf; lds_vfrag(vf, slot + 8192, r, q);
#pragma unroll
                    for (int h = 0; h < 2; ++h) pv_tile(oc[h], vf, st[h]);
                }
            }
#pragma unroll
            for (int h = 0; h < 2; ++h) { const int tok = (32 * wid + 16 * h + r) >> 2;
                bf16_t* yp = Y + (size_t)(b * SEQ + t0 + tok) * 1024 + 512 + (kvh * 4 + (r & 3)) * 64 + 4 * q;
                const float sc_ = NSA_GATE(h, 0) * cil[h];
#pragma unroll
                for (int d = 0; d < 4; ++d) *(u32x2*)(yp + 16 * d) = pk4(oc[h][d] * sc_); }
        }
        __syncthreads();
        const bool dense_all = (jt < 16);
        if (!dense_all) {
        { NSA_TID
            const int tok = tid >> 3, sub = tid & 7;
            unsigned flags = 0;
            {
                unsigned key[16];
#pragma unroll
                for (int i = 0; i < 16; ++i) { const int j = sub * 16 + i; const bool valid = (j >= 1 && j <= jt - 2);
                    const float v = IMPA[tok * IMPS + j] + IMPB[tok * IMPS + j]; key[i] = valid ? ((__float_as_uint(v) & 0xFFFFFF80u) | (unsigned)(127 - j)) : 0u; }
                unsigned tau = 0;
#pragma unroll 1
                for (int bit = 30; bit >= 0; --bit) {
                    const unsigned cand = tau | (1u << bit); int cnt = 0;
#pragma unroll
                    for (int i = 0; i < 16; ++i) cnt += (key[i] >= cand) ? 1 : 0;
                    cnt += dpp_i<0xB1>(cnt); cnt += dpp_i<0x4E>(cnt); cnt += dpp_i<0x141>(cnt);
                    if (cnt >= 13) tau = cand;
                }
#pragma unroll
                for (int i = 0; i < 16; ++i) if (key[i] != 0u && key[i] >= tau) flags |= 1u << i;
            }
#pragma unroll
            for (int i = 0; i < 16; ++i) if (flags & (1u << i)) lds_oru(&SELM[(sub * 16 + i) * 2 + (tok >> 5)], 1u << (tok & 31));
        }
        __syncthreads();
        { NSA_TID
            LAS unsigned short* LISTP = (LAS unsigned short*)(lds + L_LIST);
            const int p = tid >> 3, cls = tid & 7;
            if (p < 43 && cls < 7) {
                const int j0 = 1 + 3 * p;
                const unsigned long long A = ((unsigned long long)SELM[j0 * 2 + 1] << 32) | SELM[j0 * 2];
                const unsigned long long B = (j0 + 1 < 128) ? (((unsigned long long)SELM[(j0 + 1) * 2 + 1] << 32) | SELM[(j0 + 1) * 2]) : 0ull;
                const unsigned long long C = (j0 + 2 < 128) ? (((unsigned long long)SELM[(j0 + 2) * 2 + 1] << 32) | SELM[(j0 + 2) * 2]) : 0ull;
                int pos = 0; unsigned long long mine = 0ull; unsigned mkv = 0u;
#define NSA_CLS(K, M, V) { const unsigned long long cm_ = (M); if (cls > (K)) pos += __popcll(cm_); if (cls == (K)) { mine = cm_; mkv = (V); } }
                NSA_CLS(0, A & B & C, 7u) NSA_CLS(1, A & ~B & C, 5u) NSA_CLS(2, A & ~B & ~C, 1u) NSA_CLS(3, A & B & ~C, 3u) NSA_CLS(4, ~A & B & ~C, 2u) NSA_CLS(5, ~A & B & C, 6u) NSA_CLS(6, ~A & ~B & C, 4u)
#undef NSA_CLS
                while (mine) { const int t = __ffsll((long long)mine) - 1; LISTP[p * 64 + pos] = (unsigned short)((unsigned)t | (mkv << 8)); ++pos; mine &= mine - 1; }
                if (cls == 6) NJ[p] = (unsigned char)__popcll(A | B | C);
            }
        }
        __syncthreads();
        }
        { NSA_LANE_VARS NSA_TID
            const int nf = dense_all ? jt + 1 : 3;
            const int jb0 = jt >= 8 ? jt - 8 : 0, nb = jt - jb0 + 1, nd = nf + nb;
            const unsigned goff = (unsigned)tid * 16u;
            const unsigned char* ksb = ws + WS_KS + (size_t)bk * 1048576;
            const unsigned char* vsb = ws + WS_VST + (size_t)bk * 1048576;
            const unsigned char* kwb = ws + WS_KW + (size_t)bk * 1048576;
            const unsigned char* vwb = ws + WS_VWT + (size_t)bk * 1048576;
            const int stw = lds_off(tid >> 3, tid & 7);
            bf16x8 yq[2][2]; float wm_[2] = {0.f, 0.f}, wl[2] = {0.f, 0.f}, sm_[2] = {0.f, 0.f}, sl[2] = {0.f, 0.f};
            f32x4 ow[2][4], os[2][4], negw[2] = {ZERO4, ZERO4}, negs[2] = {ZERO4, ZERO4};
#pragma unroll
            for (int h = 0; h < 2; ++h) { const int qrow = 32 * wid + 16 * h + r;
#pragma unroll
                for (int s = 0; s < 2; ++s) yq[h][s] = lds_ld16(lds + L_Q + lds_off(qrow, 4 * s + q));
#pragma unroll
                for (int d = 0; d < 4; ++d) { ow[h][d] = ZERO4; os[h][d] = ZERO4; } }
            auto item_blk = [&](int i) -> int { return i < nf ? (dense_all ? i : (i == 0 ? 0 : jt - 2 + i)) : jb0 + (i - nf); };
            u32x4 pk0, pv0;
            { const int j = item_blk(0); pk0 = *(const u32x4*)(ksb + (size_t)j * 8192 + goff); pv0 = *(const u32x4*)(vsb + (size_t)j * 8192 + goff); }
            auto dense_item = [&](lds_t* slot, float (&m)[2], float (&l)[2], f32x4 (&negm)[2], f32x4 (&o)[2][4], bool first, bool dhi, bool dlo) {
                QKFrag kf; lds_kfrag(kf, slot, r, q);
                f32x4 st[2][4];
                const bool edge = dhi || dlo;
#pragma unroll
                for (int h = 0; h < 2; ++h) {
                    const int tok = (32 * wid + 16 * h + r) >> 2;
                    const int hi = dhi ? (tok - 4 * q) : 1000, lo = dlo ? (tok - 4 * q) : -1000;
                    if (first) { qk_tile_c(st[h], kf, yq[h], ZERO4); if (edge) mask16(st[h], lo, hi); softmax_first(m[h], l[h], negm[h], st[h]); }
                    else { qk_tile_c(st[h], kf, yq[h], negm[h]); if (edge) mask16(st[h], lo, hi); softmax_next<true>(m[h], l[h], negm[h], o[h], st[h]); }
                }
                VFrag vf; lds_vfrag(vf, slot + 8192, r, q);
#pragma unroll
                for (int h = 0; h < 2; ++h) pv_tile(o[h], vf, st[h]);
            };
#pragma unroll 1
            for (int i = 0; i < nd; ++i) {
                lds_t* slot = lds + L_RING + (i & 1) * 16384;
                lds_st16(slot + stw, pk0); lds_st16(slot + 8192 + stw, pv0);
                if (i + 1 < nd) { const int j = item_blk(i + 1); const bool sn = (i + 1 < nf);
                    pk0 = *(const u32x4*)((sn ? ksb : kwb) + (size_t)j * 8192 + goff); pv0 = *(const u32x4*)((sn ? vsb : vwb) + (size_t)j * 8192 + goff); }
                __syncthreads();
                const int j = item_blk(i);
                if (i < nf) dense_item(slot, sm_, sl, negs, os, i == 0, j == jt, false);
                else dense_item(slot, wm_, wl, negw, ow, i == nf, j == jt, j == jt - 8);
            }
#pragma unroll
            for (int h = 0; h < 2; ++h) { const int qrow = 32 * wid + 16 * h + r; const int tok = qrow >> 2; const float l = rowq_sum(wl[h]); const float il = l > 0.f ? NSA_GATE(h, 2) / l : 0.f;
                bf16_t* yp = Y + (size_t)(b * SEQ + t0 + tok) * 1024 + 512 + (kvh * 4 + (r & 3)) * 64 + 4 * q;
#pragma unroll
                for (int d = 0; d < 4; ++d) { const u32x2 w = *(const u32x2*)(yp + 16 * d); f32x4 v = ow[h][d] * il; v[0] += bflo(w.x); v[1] += bfhi(w.x); v[2] += bflo(w.y); v[3] += bfhi(w.y); *(u32x2*)(yp + 16 * d) = pk4(v); }
                const float ls = rowq_sum(sl[h]);
                LAS float* orow = (LAS float*)(lds + L_OST) + qrow * OSS + 4 * q;
#pragma unroll
                for (int d = 0; d < 4; ++d) *(LAS f32x4*)(orow + 16 * d) = os[h][d];
                if (q == 0) { ((LAS float*)(lds + L_MS))[qrow] = sm_[h]; ((LAS float*)(lds + L_LS))[qrow] = ls; } }
        }
        __syncthreads();
        { NSA_LANE_VARS NSA_TID
            LAS float* MS = (LAS float*)(lds + L_MS); LAS float* LS = (LAS float*)(lds + L_LS);
            if (!dense_all) {
            const unsigned goff = (unsigned)tid * 16u;
            const unsigned char* ksb = ws + WS_KS + (size_t)bk * 1048576;
            const unsigned char* vsb = ws + WS_VST + (size_t)bk * 1048576;
            const int stw = lds_off(tid >> 3, tid & 7);
            const int jlast = jt - 2, nstep = jt / 3;
            const LAS unsigned short* LISTP = (const LAS unsigned short*)(lds + L_LIST);
            u32x4 pk[3], pv[3];
#pragma unroll
            for (int x = 0; x < 3; ++x) { const int jb = 1 + x < jlast ? 1 + x : jlast; pk[x] = *(const u32x4*)(ksb + (size_t)jb * 8192 + goff); pv[x] = *(const u32x4*)(vsb + (size_t)jb * 8192 + goff); }
#pragma unroll 1
            for (int p = 0; p < nstep; ++p) {
#pragma unroll
                for (int x = 0; x < 3; ++x) { lds_st16(lds + L_RING + x * 16384 + stw, pk[x]); lds_st16(lds + L_RING + x * 16384 + 8192 + stw, pv[x]); }
                if (p + 1 < nstep) {
#pragma unroll
                    for (int x = 0; x < 3; ++x) { int jb = 3 * p + 4 + x; jb = jb < jlast ? jb : jlast; pk[x] = *(const u32x4*)(ksb + (size_t)jb * 8192 + goff); pv[x] = *(const u32x4*)(vsb + (size_t)jb * 8192 + goff); } }
                __syncthreads();
                const int np = __builtin_amdgcn_readfirstlane((int)NJ[p]); const int nch = (np + 3) >> 2;
                const int c1 = (wid + 8 - (p & 7)) & 7;
#pragma unroll 1
                for (int c = c1; c < nch; c = (c < 8 ? 15 - c : 16)) {
                    const int ix = 4 * c + (r >> 2); const bool valid = ix < np;
                    const unsigned ent = LISTP[p * 64 + (valid ? ix : 0)];
                    const int tok = (int)(ent & 63u); const unsigned mk = valid ? (ent >> 8) : 0u;
                    const int qrow = tok * 4 + (r & 3);
                    bf16x8 yy[2];
#pragma unroll
                    for (int s2 = 0; s2 < 2; ++s2) yy[s2] = lds_ld16(lds + L_Q + lds_off(qrow, 4 * s2 + q));
                    float mref = MS[qrow];
                    LAS float* orow = (LAS float*)(lds + L_OST) + qrow * OSS + 4 * q;
                    f32x4 o[4]; float lacc = 0.f, asc = 1.f;
#pragma unroll
                    for (int d = 0; d < 4; ++d) o[d] = *(LAS f32x4*)(orow + 16 * d);
#pragma unroll
                    for (int x = 0; x < 3; ++x) {
                        const bool sel = ((mk >> x) & 1u) != 0u;
                        if (__builtin_amdgcn_ballot_w64(sel) == 0ull) continue;
                        lds_t* kslot = lds + L_RING + x * 16384;
                        QKFrag kf; lds_kfrag(kf, kslot, r, q);
                        VFrag vf; lds_vfrag(vf, kslot + 8192, r, q);
                        f32x4 st[4];
                        const f32x4 cin = sel ? (f32x4){-mref, -mref, -mref, -mref} : NEGBIG;
                        qk_tile_c(st, kf, yy, cin);
                        const float mxl = max16(st);
                        if (__builtin_amdgcn_ballot_w64(mxl > SM_THR) != 0ull) {
                            const float mx = rowq_max(mxl); const float sh = (mx > SM_THR) ? mx : 0.f; const float a = fexp2(-sh);
                            mref += sh; asc *= a; lacc *= a;
#pragma unroll
                            for (int d = 0; d < 4; ++d) o[d] = o[d] * a;
#pragma unroll
                            for (int nt = 0; nt < 4; ++nt)
#pragma unroll
                                for (int cc = 0; cc < 4; ++cc) st[nt][cc] -= sh;
                        }
                        float ps = 0.f;
#pragma unroll
                        for (int nt = 0; nt < 4; ++nt)
#pragma unroll
                            for (int cc = 0; cc < 4; ++cc) { const float pp = fexp2(st[nt][cc]); st[nt][cc] = pp; ps += pp; }
                        lacc += ps;
                        pv_tile(o, vf, st);
                    }
                    lacc = rowq_sum(lacc);
                    if (valid) {
#pragma unroll
                        for (int d = 0; d < 4; ++d) *(LAS f32x4*)(orow + 16 * d) = o[d];
                        if (q == 0) { LS[qrow] = LS[qrow] * asc + lacc; MS[qrow] = mref; } }
                }
                __syncthreads();
            }
            }
#pragma unroll
            for (int h = 0; h < 2; ++h) { const int qrow = 32 * wid + 16 * h + r; const int tok = qrow >> 2;
                const float l = LS[qrow]; const float il = l > 0.f ? NSA_GATE(h, 1) / l : 0.f;
                const LAS float* orow = (LAS float*)(lds + L_OST) + qrow * OSS + 4 * q;
                bf16_t* yp = Y + (size_t)(b * SEQ + t0 + tok) * 1024 + 512 + (kvh * 4 + (r & 3)) * 64 + 4 * q;
#pragma unroll
                for (int d = 0; d < 4; ++d) { const u32x2 w = *(const u32x2*)(yp + 16 * d); f32x4 v = *(const LAS f32x4*)(orow + 16 * d) * il; v[0] += bflo(w.x); v[1] += bfhi(w.x); v[2] += bflo(w.y); v[3] += bfhi(w.y); *(u32x2*)(yp + 16 * d) = pk4(v); } }
        }
        __syncthreads();
    }
#ifdef STEP_BENCH
    {
        const int tid = threadIdx.x; const unsigned goff = (unsigned)tid * 16u;
        const unsigned char* ksb = ws + WS_KS + (size_t)(blockIdx.x & 7) * 1048576;
        const int stw = lds_off(tid >> 3, tid & 7);
        u32x4 pkA = *(const u32x4*)(ksb + goff), pvA = *(const u32x4*)(ksb + 8192 + goff);
        int slot_c = 0;
        for (int j = 0; j < STEP_BENCH; ++j) {
            const int slot_n = (slot_c == 2) ? 0 : slot_c + 1;
            lds_st16(lds + L_RING + slot_n * 16384 + stw, pkA); lds_st16(lds + L_RING + slot_n * 16384 + 8192 + stw, pvA);
            pkA = *(const u32x4*)(ksb + (size_t)((j + 2) & 127) * 8192 + goff); pvA = *(const u32x4*)(ksb + (size_t)((j + 3) & 127) * 8192 + goff);
            __syncthreads();
            slot_c = slot_n;
        }
        if (pkA.x == 0x12345678u && pvA.y == 0x9abcdef0u) ((unsigned*)(ws + WS_CTL))[100] = 1;
        __syncthreads();
    }
#endif
#undef NSA_LANE_VARS
#undef NSA_TID
#undef NSA_GATE
}

__device__ __forceinline__ float wave_sum(float v) {
    v += dpp_f<0xB1>(v); v += dpp_f<0x4E>(v); v += dpp_f<0x141>(v); v += dpp_f<0x140>(v);
    return red32_sum(red16_sum(v));
}
__device__ __forceinline__ void ln_row(f32x4 (&v)[4], const f32x4 (&g)[4], const f32x4 (&bt)[4]) {
    float s = 0.f;
#pragma unroll
    for (int j = 0; j < 4; ++j) s += (v[j][0] + v[j][1]) + (v[j][2] + v[j][3]);
    const float mean = wave_sum(s) * (1.f / 1024.f);
    float ss = 0.f;
#pragma unroll
    for (int j = 0; j < 4; ++j) { v[j] = v[j] - mean; ss += (v[j][0] * v[j][0] + v[j][1] * v[j][1]) + (v[j][2] * v[j][2] + v[j][3] * v[j][3]); }
    const float rstd = rsqrtf(wave_sum(ss) * (1.f / 1024.f) + LN_EPS);
#pragma unroll
    for (int j = 0; j < 4; ++j) v[j] = v[j] * rstd * g[j] + bt[j];
}
__device__ __forceinline__ void split_store(bf16_t* hi, bf16_t* lo, f32x4 h) {
    const u32x2 ph = pk4(h);
    f32x4 res; res[0] = h[0] - bflo(ph.x); res[1] = h[1] - bfhi(ph.x); res[2] = h[2] - bflo(ph.y); res[3] = h[3] - bfhi(ph.y);
    *(u32x2*)hi = ph; *(u32x2*)lo = pk4(res);
}
__device__ __forceinline__ f32x4 split_load(const bf16_t* hi, const bf16_t* lo) {
    const u32x2 a = *(const u32x2*)hi, b = *(const u32x2*)lo;
    return (f32x4){bflo(a.x) + bflo(b.x), bfhi(a.x) + bfhi(b.x), bflo(a.y) + bflo(b.y), bfhi(a.y) + bfhi(b.y)};
}

__device__ __forceinline__ void panel_ln_stats(const f32x4 (&val)[8][4], int mt, int ct, unsigned* cnt, unsigned long long* xch, lds_t* scr, int wr, int wc, int r, int q) {
    LAS f32x2* Pp = (LAS f32x2*)scr;
    LAS f32x2* Ss = (LAS f32x2*)(scr + 8192);
    LAS unsigned* flag = (LAS unsigned*)(scr + 8192 + 2048);
    const int tid = threadIdx.x;
#pragma unroll
    for (int i = 0; i < 8; ++i) {
        float sacc = 0.f, sq = 0.f;
#pragma unroll
        for (int j = 0; j < 4; ++j) { const f32x4 v = val[i][j]; sacc += (v[0] + v[1]) + (v[2] + v[3]); sq += (v[0] * v[0] + v[1] * v[1]) + (v[2] * v[2] + v[3] * v[3]); }
        sacc = rowq_sum(sacc); sq = rowq_sum(sq);
        const float mw = sacc * (1.f / 64.f);
        if (q == 0) Pp[(wr * 128 + i * 16 + r) * 4 + wc] = (f32x2){mw, fmaxf(sq - sacc * mw, 0.f)};
        asm volatile("" ::: "memory");
    }
    __syncthreads();
    if (tid < 256) {
        const f32x2 a = Pp[tid * 4 + 0], b = Pp[tid * 4 + 1], c = Pp[tid * 4 + 2], d = Pp[tid * 4 + 3];
        const float m4 = (a.x + b.x + c.x + d.x) * 0.25f;
        const float da = a.x - m4, db = b.x - m4, dc = c.x - m4, dd = d.x - m4;
        const float m2 = (a.y + b.y) + (c.y + d.y) + 64.0f * ((da * da + db * db) + (dc * dc + dd * dd));
        __hip_atomic_store(xch + ((size_t)(mt * 256 + tid) * 4 + ct), ((unsigned long long)__float_as_uint(m2) << 32) | __float_as_uint(m4), __ATOMIC_RELAXED, __HIP_MEMORY_SCOPE_AGENT);
    }
    asm volatile("s_waitcnt vmcnt(0)" ::: "memory");
    __syncthreads();
    if (tid < 64) {
        if (tid == 0) __hip_atomic_fetch_add(cnt + 64 * mt, 1u, __ATOMIC_RELAXED, __HIP_MEMORY_SCOPE_AGENT);
        unsigned spins = 0;
        while ((unsigned)__builtin_amdgcn_readfirstlane(__hip_atomic_load(cnt + 64 * mt, __ATOMIC_RELAXED, __HIP_MEMORY_SCOPE_AGENT)) < 4u) { __builtin_amdgcn_s_sleep(2); if (++spins > (1u << 22)) break; }
        __builtin_amdgcn_fence(__ATOMIC_ACQUIRE, "agent");
        if (tid == 0) flag[0] = 1u;
    }
    asm volatile("s_waitcnt vmcnt(0) lgkmcnt(0)" ::: "memory");
    __syncthreads();
    if (tid < 256) {
        const unsigned long long* sl = xch + (size_t)(mt * 256 + tid) * 4; float mm[4], m2[4], ms = 0.f;
#pragma unroll
        for (int t = 0; t < 4; ++t) { const unsigned long long w = __hip_atomic_load(sl + t, __ATOMIC_RELAXED, __HIP_MEMORY_SCOPE_AGENT); mm[t] = __uint_as_float((unsigned)w); m2[t] = __uint_as_float((unsigned)(w >> 32)); ms += mm[t]; }
        const float mean = ms * 0.25f; float qq = 0.f;
#pragma unroll
        for (int t = 0; t < 4; ++t) { const float dm = mm[t] - mean; qq += m2[t] + 256.0f * dm * dm; }
        Ss[tid] = (f32x2){mean, rsqrtf(qq * (1.f / 1024.f) + LN_EPS)};
    }
    __syncthreads();
}

__device__ __forceinline__ void panel_ln_stats8(const g8::Acc& v, int mt, int ct, unsigned* cnt, unsigned long long* xch, lds_t* scr, int wr, int wc, int fr, int fq) {
    LAS f32x2* Pp = (LAS f32x2*)scr;
    LAS f32x2* Ss = (LAS f32x2*)(scr + 8192);
    const int tid = threadIdx.x;
#pragma unroll
    for (int ai = 0; ai < 2; ++ai)
#pragma unroll
        for (int m = 0; m < 4; ++m) {
            float sacc = 0.f;
#pragma unroll
            for (int bj = 0; bj < 2; ++bj)
#pragma unroll
                for (int n = 0; n < 2; ++n) { const f32x4 x = v[ai][bj][m][n]; sacc += (x[0] + x[1]) + (x[2] + x[3]); }
            sacc = rowq_sum(sacc);
            const float mw = sacc * (1.f / 64.f); float sq = 0.f;
#pragma unroll
            for (int bj = 0; bj < 2; ++bj)
#pragma unroll
                for (int n = 0; n < 2; ++n) { const f32x4 d = v[ai][bj][m][n] - mw; sq += (d[0] * d[0] + d[1] * d[1]) + (d[2] * d[2] + d[3] * d[3]); }
            sq = rowq_sum(sq);
            if (fq == 0) Pp[(ai * 128 + wr * 64 + m * 16 + fr) * 4 + wc] = (f32x2){mw, sq};
        }
    __syncthreads();
    if (tid < 256) {
        const f32x2 a = Pp[tid * 4 + 0], b = Pp[tid * 4 + 1], c = Pp[tid * 4 + 2], d = Pp[tid * 4 + 3];
        const float m4 = (a.x + b.x + c.x + d.x) * 0.25f;
        const float da = a.x - m4, db = b.x - m4, dc = c.x - m4, dd = d.x - m4;
        const float m2 = (a.y + b.y) + (c.y + d.y) + 64.0f * ((da * da + db * db) + (dc * dc + dd * dd));
        __hip_atomic_store(xch + ((size_t)(mt * 256 + tid) * 4 + ct), ((unsigned long long)__float_as_uint(m2) << 32) | __float_as_uint(m4), __ATOMIC_RELAXED, __HIP_MEMORY_SCOPE_AGENT);
    }
    asm volatile("s_waitcnt vmcnt(0)" ::: "memory");
    __syncthreads();
    if (tid < 64) {
        if (tid == 0) __hip_atomic_fetch_add(cnt + 64 * mt, 1u, __ATOMIC_RELAXED, __HIP_MEMORY_SCOPE_AGENT);
        unsigned spins = 0;
        while ((unsigned)__builtin_amdgcn_readfirstlane(__hip_atomic_load(cnt + 64 * mt, __ATOMIC_RELAXED, __HIP_MEMORY_SCOPE_AGENT)) < 4u) { __builtin_amdgcn_s_sleep(2); if (++spins > (1u << 22)) break; }
        __builtin_amdgcn_fence(__ATOMIC_ACQUIRE, "agent");
    }
    asm volatile("s_waitcnt vmcnt(0) lgkmcnt(0)" ::: "memory");
    __syncthreads();
    if (tid < 256) {
        const unsigned long long* sl = xch + (size_t)(mt * 256 + tid) * 4; float mm[4], m2[4], ms = 0.f;
#pragma unroll
        for (int t = 0; t < 4; ++t) { const unsigned long long w = __hip_atomic_load(sl + t, __ATOMIC_RELAXED, __HIP_MEMORY_SCOPE_AGENT); mm[t] = __uint_as_float((unsigned)w); m2[t] = __uint_as_float((unsigned)(w >> 32)); ms += mm[t]; }
        const float mean = ms * 0.25f; float qq = 0.f;
#pragma unroll
        for (int t = 0; t < 4; ++t) { const float dm = mm[t] - mean; qq += m2[t] + 256.0f * dm * dm; }
        Ss[tid] = (f32x2){mean, rsqrtf(qq * (1.f / 1024.f) + LN_EPS)};
    }
    __syncthreads();
}
__device__ __forceinline__ int ln_tile(int it) { const int G = gridDim.x, bid = blockIdx.x;
    if (G & 31) return bid + it * G;
    return it * G + (((bid & 7) + 8 * (bid >> 5)) << 2) + ((bid >> 3) & 3); }
struct SchedOne {
    const bf16_t* A; const bf16_t* W; int K, tile;
    __device__ __forceinline__ bool next(int i, g8::Unit& u) const { if (i > 0 || tile >= 128 * 4) return false; u.pm = tile >> 2; u.pn = tile & 3; return true; }
    __device__ __forceinline__ const char* a_base(const g8::Unit& u) const { return (const char*)(A + (size_t)u.pm * 256 * K); }
    __device__ __forceinline__ const char* b_base(const g8::Unit& u, int h) const { return (const char*)(W + (size_t)(u.pn * 256 + h * 128) * K); }
    __device__ __forceinline__ void a_offsets(const g8::Unit&, unsigned (&v)[2][2], int tid) const { g8::natural_offsets(v, K, tid); }
};

struct EpiOutLn1 {
    static constexpr bool AFTER_DRAIN = true;
    const bf16_t* xb; const float* gam; const float* bet; unsigned char* ws; lds_t* lds;
    __device__ __forceinline__ void init(g8::Acc& acc, const g8::Unit& u, int wr, int wc, int fr, int fq) const {
        const bf16_t* xp = xb + (size_t)(u.pm * 256 + wr * 64 + fr) * 1024 + u.pn * 256 + wc * 32 + 8 * fq;
#pragma unroll
        for (int ai = 0; ai < 2; ++ai)
#pragma unroll
            for (int m = 0; m < 4; ++m)
#pragma unroll
                for (int bj = 0; bj < 2; ++bj) acc[ai][bj][m][0] = __builtin_bit_cast(f32x4, *(const u32x4*)(xp + (size_t)(ai * 128 + m * 16) * 1024 + bj * 128));
    }
    __device__ __forceinline__ void post_prologue(g8::Acc& acc) const {
#pragma unroll
        for (int ai = 0; ai < 2; ++ai)
#pragma unroll
            for (int bj = 0; bj < 2; ++bj)
#pragma unroll
                for (int m = 0; m < 4; ++m) { const u32x4 w = __builtin_bit_cast(u32x4, acc[ai][bj][m][0]);
                    acc[ai][bj][m][0] = (f32x4){bflo(w.x), bfhi(w.x), bflo(w.y), bfhi(w.y)} * ALPHA; acc[ai][bj][m][1] = (f32x4){bflo(w.z), bfhi(w.z), bflo(w.w), bfhi(w.w)} * ALPHA; }
    }
    __device__ __forceinline__ void operator()(g8::Acc& acc, const g8::Unit& u, int wr, int wc, int fr, int fq) const {
        panel_ln_stats8(acc, u.pm, u.pn, (unsigned*)(ws + WS_CTL) + 8192, (unsigned long long*)(ws + WS_XCH1), lds, wr, wc, fr, fq);
        const LAS f32x2* Ss = (const LAS f32x2*)(lds + 8192);
        bf16_t* H1b = (bf16_t*)(ws + WS_H1B); bf16_t* H1lo = (bf16_t*)(ws + WS_H1LO);
        const int col0 = u.pn * 256 + wc * 32 + 8 * fq;
        f32x4 gg[2][2], bb[2][2];
#pragma unroll
        for (int bj = 0; bj < 2; ++bj)
#pragma unroll
            for (int n = 0; n < 2; ++n) { gg[bj][n] = *(const f32x4*)(gam + col0 + bj * 128 + 4 * n); bb[bj][n] = *(const f32x4*)(bet + col0 + bj * 128 + 4 * n); }
#pragma unroll
        for (int ai = 0; ai < 2; ++ai)
#pragma unroll
            for (int m = 0; m < 4; ++m) { const int rl = ai * 128 + wr * 64 + m * 16 + fr; const f32x2 st_ = Ss[rl]; const size_t ro = (size_t)(u.pm * 256 + rl) * 1024 + col0;
#pragma unroll
                for (int bj = 0; bj < 2; ++bj) {
                    const f32x4 h0 = (acc[ai][bj][m][0] - st_.x) * st_.y * gg[bj][0] + bb[bj][0], h1 = (acc[ai][bj][m][1] - st_.x) * st_.y * gg[bj][1] + bb[bj][1];
                    const u32x4 ph = pk8(h0, h1);
                    f32x4 r0, r1; r0[0] = h0[0] - bflo(ph.x); r0[1] = h0[1] - bfhi(ph.x); r0[2] = h0[2] - bflo(ph.y); r0[3] = h0[3] - bfhi(ph.y);
                    r1[0] = h1[0] - bflo(ph.z); r1[1] = h1[1] - bfhi(ph.z); r1[2] = h1[2] - bflo(ph.w); r1[3] = h1[3] - bfhi(ph.w);
                    *(u32x4*)(H1b + ro + bj * 128) = ph; *(u32x4*)(H1lo + ro + bj * 128) = pk8(r0, r1);
                    *(u32x2*)(ws + WS_RB + ro + bj * 128) = pk8_f8(h0, h1); } }
    }
};
__device__ __forceinline__ void phase_outproj_gemm(const Params& P, lds_t* lds) {
    for (int it = 0; ln_tile(it) < 128 * 4; ++it) { const int tile = ln_tile(it);
        SchedOne S{(const bf16_t*)(P.ws + WS_RA), (const bf16_t*)(P.ws + WS_WOUT), 1024, tile};
        EpiOutLn1 E{(const bf16_t*)(P.ws + WS_H1LO), P.in[11], P.in[12], P.ws, lds};
        g8::gemm_phase(lds, 1024, S, E);
        __syncthreads();
    }
}

constexpr int L4_LG = 98304;
constexpr int L4_LCNT = 131072;
constexpr int L4_GB = 131200;
constexpr int L4_AE = 131328;
constexpr int L4_AR = 132352;
constexpr int L4_AW = 133376;

__device__ __forceinline__ void phase_ln1_router(const Params& P, lds_t* lds) {
    unsigned char* ws = P.ws;
    int tid = threadIdx.x; asm volatile("" : "+v"(tid));
    const int lane = tid & 63, wid = __builtin_amdgcn_readfirstlane(tid >> 6), r = lane & 15, q = lane >> 4, sc = tid & 7, sr = tid >> 3;
    const bf16_t* Y = (const bf16_t*)(ws + WS_RA); const bf16_t* wt = (const bf16_t*)(ws + WS_WOUT);
    const float* x = P.in[0]; float* out = P.out; bf16_t* H1b = (bf16_t*)(ws + WS_H1B); bf16_t* H1lo = (bf16_t*)(ws + WS_H1LO);
    const bf16_t* WRB = (const bf16_t*)(ws + WS_WRB);
    int* gcount = (int*)(ws + WS_CTL);
    LAS float* LG = (LAS float*)(lds + L4_LG); LAS int* LCNT = (LAS int*)(lds + L4_LCNT); LAS int* GB = (LAS int*)(lds + L4_GB);
    LAS int* AE = (LAS int*)(lds + L4_AE); LAS int* AR = (LAS int*)(lds + L4_AR); LAS float* AW = (LAS float*)(lds + L4_AW);
    for (int panel = blockIdx.x; panel < 256; panel += gridDim.x) {
        const int row0 = panel * 128;
        if (tid < 32) LCNT[tid] = 0;
        __syncthreads();
        {
            f32x4 hacc[2][4];
            { const bf16_t* ap[2]; const bf16_t* bp[2];
#pragma unroll
              for (int i = 0; i < 2; ++i) ap[i] = H1b + (size_t)(row0 + sr + 64 * i) * 1024 + sc * 8;
              bp[0] = WRB + (size_t)sr * 3072 + sc * 8; bp[1] = WRB + (size_t)sr * 3072 + 1024 + sc * 8;
              gemm_mainloop<128, 128, 32, 64>(lds, ap, 64, bp, 16, hacc); }
            const int wm = wid >> 1, wn = wid & 1;
            if (wn == 0) {
#pragma unroll
                for (int i = 0; i < 2; ++i)
#pragma unroll
                    for (int j = 0; j < 4; ++j) *(LAS f32x4*)(LG + (wm * 32 + i * 16 + r) * 64 + j * 16 + 4 * q) = hacc[i][j]; }
            __syncthreads();
            if (wn == 1) {
#pragma unroll
                for (int i = 0; i < 2; ++i)
#pragma unroll
                    for (int j = 0; j < 4; ++j) { LAS f32x4* d_ = (LAS f32x4*)(LG + (wm * 32 + i * 16 + r) * 64 + j * 16 + 4 * q); *d_ = *d_ + hacc[i][j]; } }
            f32x4 racc[2][2];
            { const bf16_t* ap[2]; const bf16_t* bp[1];
#pragma unroll
              for (int i = 0; i < 2; ++i) ap[i] = H1lo + (size_t)(row0 + sr + 64 * i) * 1024 + sc * 8;
              bp[0] = WRB + (size_t)sr * 3072 + sc * 8;
              gemm_mainloop<128, 64, 32, 32>(lds, ap, 64, bp, 16, racc); }
#pragma unroll
            for (int i = 0; i < 2; ++i)
#pragma unroll
                for (int j = 0; j < 2; ++j) { LAS f32x4* d_ = (LAS f32x4*)(LG + (wm * 32 + i * 16 + r) * 64 + wn * 32 + j * 16 + 4 * q); *d_ = *d_ + racc[i][j]; }
        }
        __syncthreads();
        if (tid < 128) {
            const LAS float* lp = LG + tid * 64;
            const float* brg = P.in[14]; const float* bre = P.in[16];
            float g0 = lp[0] + brg[0]; int gs = 0; float gsum;
            { float gv[4]; gv[0] = g0;
#pragma unroll
              for (int i = 1; i < 4; ++i) { gv[i] = lp[i] + brg[i]; if (gv[i] > g0) { g0 = gv[i]; gs = i; } }
              gsum = 0.f;
#pragma unroll
              for (int i = 0; i < 4; ++i) gsum += __expf(gv[i] - g0); }
            const float gp = 1.f / gsum;
            float ev[8];
#pragma unroll
            for (int i = 0; i < 8; ++i) ev[i] = lp[4 + gs * 8 + i] + bre[gs * 8 + i];
            int i1 = 0; float e1 = ev[0];
#pragma unroll
            for (int i = 1; i < 8; ++i) if (ev[i] > e1) { e1 = ev[i]; i1 = i; }
            int i2 = -1; float e2 = -3.0e38f;
#pragma unroll
            for (int i = 0; i < 8; ++i) if (i != i1 && ev[i] > e2) { e2 = ev[i]; i2 = i; }
            const float x2 = __expf(e2 - e1); const float w1 = gp / (1.f + x2), w2 = gp * x2 / (1.f + x2);
            const int ea = gs * 8 + i1, eb = gs * 8 + i2;
            AE[tid * 2] = ea; AE[tid * 2 + 1] = eb; AW[tid * 2] = w1; AW[tid * 2 + 1] = w2;
            AR[tid * 2] = lds_addi(&LCNT[ea], 1); AR[tid * 2 + 1] = lds_addi(&LCNT[eb], 1);
        }
        __syncthreads();
        if (tid < 32) GB[tid] = atomicAdd(&gcount[tid], LCNT[tid]);
        __syncthreads();
        if (tid < 256) { const int row = tid >> 1, kk = tid & 1, e = AE[row * 2 + kk], slot = GB[e] + AR[row * 2 + kk]; const int tok = row0 + row;
            ((int*)(ws + WS_TOKL))[(size_t)e * 65536 + slot] = tok;
            ((int*)(ws + WS_ASGE))[tok * 2 + kk] = e; ((int*)(ws + WS_ASGS))[tok * 2 + kk] = slot; ((float*)(ws + WS_ASGW))[tok * 2 + kk] = AW[row * 2 + kk]; }
        __syncthreads();
    }
}

constexpr int L5_CNT = 131072;
constexpr int L5_RB = 131200;
constexpr int L5_TB = 131456;

__device__ __forceinline__ void moe_setup(const Params& P, lds_t* lds, int ncol) {
    LAS int* CNT = (LAS int*)(lds + L5_CNT); LAS int* RB = (LAS int*)(lds + L5_RB); LAS int* TB = (LAS int*)(lds + L5_TB);
    const int* gcount = (const int*)(P.ws + WS_CTL);
    int tid = threadIdx.x; asm volatile("" : "+v"(tid));
    if (tid < 32) CNT[tid] = gcount[tid];
    __syncthreads();
    if (tid == 0) { int rb = 0, tb = 0; for (int e = 0; e < 32; ++e) { RB[e] = rb; TB[e] = tb; rb += CNT[e]; tb += ((CNT[e] + 255) >> 8) * ncol; } RB[32] = rb; TB[32] = tb; }
    __syncthreads();
}

struct EpiPark {
    static constexpr bool AFTER_DRAIN = false;
    bf16_t* PLS;
    __device__ __forceinline__ void init(g8::Acc& acc, const g8::Unit&, int, int, int, int) const { g8::acc_zero(acc); }
    __device__ __forceinline__ void post_prologue(g8::Acc&) const {}
    __device__ __forceinline__ void operator()(g8::Acc& acc, const g8::Unit& u, int wr, int wc, int fr, int fq) const {
#pragma unroll
        for (int ai = 0; ai < 2; ++ai)
#pragma unroll
            for (int m = 0; m < 4; ++m) { const size_t ro = (size_t)(u.pm * 256 + ai * 128 + wr * 64 + m * 16 + fr) * 1024 + u.pn * 256 + wc * 32 + 8 * fq;
#pragma unroll
                for (int bj = 0; bj < 2; ++bj) *(u32x4*)(PLS + ro + bj * 128) = pk8(acc[ai][bj][m][0], acc[ai][bj][m][1]); }
    }
};
constexpr int PLE_CTR_WORD = 4096;
constexpr int L_PLEQ = 157200;
struct SchedPleRun {
    const bf16_t* A; const bf16_t* W; int t0, n;
    __device__ __forceinline__ bool next(int i, g8::Unit& u) const { const int tile = t0 + i; if (i >= n || tile >= 128 * 4) return false; u.pm = tile >> 2; u.pn = tile & 3; return true; }
    __device__ __forceinline__ const char* a_base(const g8::Unit& u) const { return (const char*)(A + (size_t)u.pm * 256 * 256); }
    __device__ __forceinline__ const char* b_base(const g8::Unit& u, int h) const { return (const char*)(W + (size_t)(u.pn * 256 + h * 128) * 256); }
    __device__ __forceinline__ void a_offsets(const g8::Unit&, unsigned (&v)[2][2], int tid) const { g8::natural_offsets(v, 256, tid); }
};
__device__ __forceinline__ void ple_fill(const Params& P, lds_t* lds, int n) {
    unsigned* ctr = (unsigned*)(P.ws + WS_CTL) + PLE_CTR_WORD;
    volatile LAS unsigned* qw = (volatile LAS unsigned*)(lds + L_PLEQ);
    int tid = threadIdx.x; asm volatile("" : "+v"(tid));
    if (tid == 0) qw[0] = atomicAdd(ctr, (unsigned)n);
    __syncthreads();
    const unsigned t = qw[0];
    __syncthreads();
    if (t >= 512u) return;
    SchedPleRun S{(const bf16_t*)(P.ws + WS_PB), (const bf16_t*)(P.ws + WS_WPLE), (int)t, n};
    EpiPark E{(bf16_t*)(P.ws + WS_H1LO)};
    g8::gemm_phase(lds, 256, S, E);
    __syncthreads();
}
constexpr int L5_UNIT = 131712;
constexpr int L5_TOKU = 132608;
constexpr int MAXU = 24;
__device__ __forceinline__ int moe_tile(int i) { const int G = gridDim.x, bid = blockIdx.x; return (G & 7) ? bid + i * G : (i * 8 + (bid & 7)) * (G >> 3) + (bid >> 3); }
__device__ __forceinline__ int moe_units(const Params& P, lds_t* lds, int first, bool want_tok) {
    LAS int* CNT = (LAS int*)(lds + L5_CNT); LAS int* RB = (LAS int*)(lds + L5_RB); LAS int* TB = (LAS int*)(lds + L5_TB);
    LAS int* UN = (LAS int*)(lds + L5_UNIT); LAS int* TOKU = (LAS int*)(lds + L5_TOKU);
    int tid = threadIdx.x; asm volatile("" : "+v"(tid));
    const int G = gridDim.x, bid = blockIdx.x;
    const int ntile = TB[32];
    int mine = 0; while (mine < 64 && moe_tile(mine) < ntile) ++mine;
    int nu = mine - first; nu = nu < 0 ? 0 : (nu > MAXU ? MAXU : nu);
    if (tid < nu) { const int tile = moe_tile(first + tid); int e = 0; while (TB[e + 1] <= tile) ++e;
        const int ne = CNT[e], MT = (ne + 255) >> 8, loc = tile - TB[e];
        UN[tid * 8 + 0] = e; UN[tid * 8 + 1] = loc / MT; UN[tid * 8 + 2] = loc % MT; UN[tid * 8 + 3] = ne; UN[tid * 8 + 4] = RB[e]; }
    __syncthreads();
    if (want_tok) { const int* TOKL = (const int*)(P.ws + WS_TOKL);
        for (int idx = tid; idx < nu * 256; idx += NTHREADS) { const int ui = idx >> 8, r = idx & 255; const int e = UN[ui * 8], mt = UN[ui * 8 + 2], ne = UN[ui * 8 + 3];
            int ix = mt * 256 + r; if (ix >= ne) ix = ne - 1; TOKU[idx] = TOKL[(size_t)e * 65536 + ix]; } }
    __syncthreads();
    return nu;
}
__device__ __forceinline__ bool moe_idle_last_round(lds_t* lds) {
    const int ntile = ((LAS int*)(lds + L5_TB))[32]; const int G = gridDim.x;
    const int rounds = (ntile + G - 1) / G;
    return rounds > 0 && moe_tile(rounds - 1) >= ntile;
}
template <bool DOWN> struct SchedMoeF8 {
    lds_t* lds; const unsigned char* A; const unsigned char* W; int nu;
    __device__ __forceinline__ bool next(int i, g8::Unit& u) const { if (i >= nu) return false; const LAS int* UN = (const LAS int*)(lds + L5_UNIT) + i * 8;
        u.e = __builtin_amdgcn_readfirstlane(UN[0]); u.pn = __builtin_amdgcn_readfirstlane(UN[1]); u.pm = __builtin_amdgcn_readfirstlane(UN[2]);
        u.ne = __builtin_amdgcn_readfirstlane(UN[3]); u.rb = __builtin_amdgcn_readfirstlane(UN[4]); u.idx = i; return true; }
    __device__ __forceinline__ const char* a_base(const g8::Unit&) const { return (const char*)A; }
    __device__ __forceinline__ const char* b_base(const g8::Unit& u, int h) const {
        if (DOWN) return (const char*)(W + (size_t)u.e * 1024 * 512 + (size_t)(u.pn * 256 + h * 128) * 512);
        return (const char*)(W + (size_t)u.e * 1024 * 1024 + (size_t)((h ? 512 : 0) + u.pn * 128) * 1024); }
    __device__ __forceinline__ void a_offsets(const g8::Unit& u, unsigned (&v)[2][2], int tid) const {
#pragma unroll
        for (int i = 0; i < 2; ++i) { int R, Cb; g8::f8_rc(tid, i, R, Cb);
#pragma unroll
            for (int h = 0; h < 2; ++h) {
                if (DOWN) { int ix = u.pm * 256 + h * 128 + R; if (ix >= u.ne) ix = u.ne - 1; v[h][i] = (unsigned)((u.rb + ix) * 512 + Cb); }
                else { const int tok = ((const LAS int*)(lds + L5_TOKU))[u.idx * 256 + h * 128 + R]; v[h][i] = (unsigned)(tok * 1024 + Cb); } } }
    }
};
template <bool DOWN> struct SchedMoe {
    lds_t* lds; const bf16_t* A; const bf16_t* W; int nu;
    __device__ __forceinline__ bool next(int i, g8::Unit& u) const { if (i >= nu) return false; const LAS int* UN = (const LAS int*)(lds + L5_UNIT) + i * 8;
        u.e = __builtin_amdgcn_readfirstlane(UN[0]); u.pn = __builtin_amdgcn_readfirstlane(UN[1]); u.pm = __builtin_amdgcn_readfirstlane(UN[2]);
        u.ne = __builtin_amdgcn_readfirstlane(UN[3]); u.rb = __builtin_amdgcn_readfirstlane(UN[4]); u.idx = i; return true; }
    __device__ __forceinline__ const char* a_base(const g8::Unit&) const { return (const char*)A; }
    __device__ __forceinline__ const char* b_base(const g8::Unit& u, int h) const {
        if (DOWN) return (const char*)(W + (size_t)u.e * 1024 * 512 + (size_t)(u.pn * 256 + h * 128) * 512);
        return (const char*)(W + (size_t)u.e * 1024 * 1024 + (size_t)((h ? 512 : 0) + u.pn * 128) * 1024); }
    __device__ __forceinline__ void a_offsets(const g8::Unit& u, unsigned (&v)[2][2], int tid) const {
#pragma unroll
        for (int i = 0; i < 2; ++i) { int R, C; g8::stage_rc(tid * 16 + i * 8192, R, C);
#pragma unroll
            for (int h = 0; h < 2; ++h) {
                if (DOWN) { int ix = u.pm * 256 + h * 128 + R; if (ix >= u.ne) ix = u.ne - 1; v[h][i] = (unsigned)((u.rb + ix) * 512 + C) * 2u; }
                else { const int tok = ((const LAS int*)(lds + L5_TOKU))[u.idx * 256 + h * 128 + R]; v[h][i] = (unsigned)(tok * 1024 + C) * 2u; } } }
    }
};
struct EpiMoeUp {
    static constexpr bool AFTER_DRAIN = false;
    bf16_t* HID;
    __device__ __forceinline__ void init(g8::Acc& acc, const g8::Unit&, int, int, int, int) const { g8::acc_zero(acc); }
    __device__ __forceinline__ void post_prologue(g8::Acc&) const {}
    __device__ __forceinline__ void operator()(g8::Acc& acc, const g8::Unit& u, int wr, int wc, int fr, int fq) const {
#pragma unroll
        for (int ai = 0; ai < 2; ++ai)
#pragma unroll
            for (int m = 0; m < 4; ++m) { const int ix = u.pm * 256 + ai * 128 + wr * 64 + m * 16 + fr;
                if (ix < u.ne) { f32x4 h0, h1;
#pragma unroll
                    for (int c = 0; c < 4; ++c) { const float g0 = acc[ai][0][m][0][c], g1 = acc[ai][0][m][1][c];
                        h0[c] = g0 * sigmoidf_(g0) * acc[ai][1][m][0][c]; h1[c] = g1 * sigmoidf_(g1) * acc[ai][1][m][1][c]; }
                    *(u32x2*)((unsigned char*)HID + (size_t)(u.rb + ix) * 512 + u.pn * 128 + wc * 32 + 8 * fq) = pk8_f8(h0, h1); } }
    }
};
struct EpiMoeDown {
    static constexpr bool AFTER_DRAIN = false;
    bf16_t* OA;
    __device__ __forceinline__ void init(g8::Acc& acc, const g8::Unit&, int, int, int, int) const { g8::acc_zero(acc); }
    __device__ __forceinline__ void post_prologue(g8::Acc&) const {}
    __device__ __forceinline__ void operator()(g8::Acc& acc, const g8::Unit& u, int wr, int wc, int fr, int fq) const {
#pragma unroll
        for (int ai = 0; ai < 2; ++ai)
#pragma unroll
            for (int m = 0; m < 4; ++m) { const int ix = u.pm * 256 + ai * 128 + wr * 64 + m * 16 + fr;
                if (ix < u.ne) {
#pragma unroll
                    for (int bj = 0; bj < 2; ++bj) *(u32x2*)((unsigned char*)OA + (size_t)(u.rb + ix) * 1024 + u.pn * 256 + bj * 128 + wc * 32 + 8 * fq) = pk8_f8(acc[ai][bj][m][0] * 4.f, acc[ai][bj][m][1] * 4.f); } }
    }
};

__device__ __forceinline__ void phase_moe1(const Params& P, lds_t* lds) {
    moe_setup(P, lds, 4);
    for (int first = 0;; first += MAXU) {
        const int nu = moe_units(P, lds, first, true);
        if (nu == 0) break;
        SchedMoeF8<false> S{lds, P.ws + WS_RB, P.ws + WS_WEIN, nu};
        EpiMoeUp E{(bf16_t*)(P.ws + WS_RA)};
        g8::gemm_phase_f8<123>(lds, 1024, S, E);
        __syncthreads();
    }
    if (moe_idle_last_round(lds)) ple_fill(P, lds, 2);
}

__device__ __forceinline__ void phase_moe2(const Params& P, lds_t* lds) {
    moe_setup(P, lds, 4);
    for (int first = 0;; first += MAXU) {
        const int nu = moe_units(P, lds, first, false);
        if (nu == 0) break;
        SchedMoeF8<true> S{lds, P.ws + WS_RA, P.ws + WS_WEOUT, nu};
        EpiMoeDown E{(bf16_t*)(P.ws + WS_RB)};
        g8::gemm_phase_f8<123>(lds, 512, S, E);
        __syncthreads();
    }
    if (moe_idle_last_round(lds)) ple_fill(P, lds, 1);
}

__device__ __forceinline__ void phase_ln2(const Params& P, lds_t* lds) {
    unsigned char* ws = P.ws;
    int tid = threadIdx.x; asm volatile("" : "+v"(tid));
    const int lane = tid & 63, wid = __builtin_amdgcn_readfirstlane(tid >> 6);
    LAS int* RB = (LAS int*)(lds + L5_RB);
    moe_setup(P, lds, 4);
    const bf16_t* OA = (const bf16_t*)(ws + WS_RB); bf16_t* H2b = (bf16_t*)(ws + WS_RA);
    const bf16_t* H1b = (const bf16_t*)(ws + WS_H1B); bf16_t* HLO = (bf16_t*)(ws + WS_H1LO);
    const int* ASGE = (const int*)(ws + WS_ASGE); const int* ASGS = (const int*)(ws + WS_ASGS); const float* ASGW = (const float*)(ws + WS_ASGW);
    f32x4 g[4], bt[4];
#pragma unroll
    for (int j = 0; j < 4; ++j) { g[j] = *(const f32x4*)(P.in[19] + 4 * lane + 256 * j); bt[j] = *(const f32x4*)(P.in[20] + 4 * lane + 256 * j); }
    for (int panel = blockIdx.x; panel < 256; panel += gridDim.x) {
        const int row0 = panel * 128;
        unsigned myo0 = 0, myo1 = 0; float myw0 = 0.f, myw1 = 0.f;
        if (lane < 16) { const int trow = row0 + 16 * wid + lane;
            const int e0 = ASGE[trow * 2], e1 = ASGE[trow * 2 + 1];
            myo0 = (unsigned)(RB[e0] + ASGS[trow * 2]) * 1024u; myo1 = (unsigned)(RB[e1] + ASGS[trow * 2 + 1]) * 1024u;
            myw0 = ASGW[trow * 2] * 0.25f; myw1 = ASGW[trow * 2 + 1] * 0.25f; }
#pragma unroll 2
        for (int rr = 0; rr < 16; ++rr) {
            const int trow = row0 + 16 * wid + rr;
            const size_t ro = (size_t)trow * 1024 + 4 * lane;
            const unsigned q0 = (unsigned)__shfl((int)myo0, rr), q1 = (unsigned)__shfl((int)myo1, rr);
            const float w0 = __shfl(myw0, rr), w1 = __shfl(myw1, rr);
            const unsigned char* o0 = (const unsigned char*)OA + (size_t)q0 + 4 * lane; const unsigned char* o1 = (const unsigned char*)OA + (size_t)q1 + 4 * lane;
            f32x4 v[4];
#pragma unroll
            for (int j = 0; j < 4; ++j) { const u32x2 hw = *(const u32x2*)(H1b + ro + 256 * j); const f32x4 h = (f32x4){bflo(hw.x), bfhi(hw.x), bflo(hw.y), bfhi(hw.y)}; const int a = *(const int*)(o0 + 256 * j), bq = *(const int*)(o1 + 256 * j);
                const f32x2 a01 = __builtin_amdgcn_cvt_pk_f32_fp8(a, false), a23 = __builtin_amdgcn_cvt_pk_f32_fp8(a, true), b01 = __builtin_amdgcn_cvt_pk_f32_fp8(bq, false), b23 = __builtin_amdgcn_cvt_pk_f32_fp8(bq, true);
                f32x4 f; f[0] = w0 * a01[0] + w1 * b01[0]; f[1] = w0 * a01[1] + w1 * b01[1]; f[2] = w0 * a23[0] + w1 * b23[0]; f[3] = w0 * a23[1] + w1 * b23[1];
                v[j] = h * ALPHA + f; }
            ln_row(v, g, bt);
#pragma unroll
            for (int j = 0; j < 4; ++j) *(u32x2*)(H2b + ro + 256 * j) = pk4(v[j]);
        }
    }
}

struct SchedPle {
    const bf16_t* A; const bf16_t* W; int G, c;
    __device__ __forceinline__ bool next(int i, g8::Unit& u) const { const int tile = c + i * G; if (tile >= 128 * 4) return false; u.pm = tile >> 2; u.pn = tile & 3; return true; }
    __device__ __forceinline__ const char* a_base(const g8::Unit& u) const { return (const char*)(A + (size_t)u.pm * 256 * 256); }
    __device__ __forceinline__ const char* b_base(const g8::Unit& u, int h) const { return (const char*)(W + (size_t)(u.pn * 256 + h * 128) * 256); }
    __device__ __forceinline__ void a_offsets(const g8::Unit&, unsigned (&v)[2][2], int tid) const { g8::natural_offsets(v, 256, tid); }
};
struct EpiGateLn3 {
    static constexpr bool AFTER_DRAIN = true;
    const bf16_t* H2b; const bf16_t* PLS; const float* bg; const float* gam; const float* bet; float* out; unsigned char* ws; lds_t* lds;
    __device__ __forceinline__ void init(g8::Acc& acc, const g8::Unit&, int, int, int, int) const { g8::acc_zero(acc); }
    __device__ __forceinline__ void post_prologue(g8::Acc&) const {}
    __device__ __forceinline__ void operator()(g8::Acc& acc, const g8::Unit& u, int wr, int wc, int fr, int fq) const {
        const int col0 = u.pn * 256 + wc * 32 + 8 * fq;
        {
            f32x4 bv[2][2];
#pragma unroll
            for (int bj = 0; bj < 2; ++bj)
#pragma unroll
                for (int n = 0; n < 2; ++n) bv[bj][n] = *(const f32x4*)(bg + col0 + bj * 128 + 4 * n);
#pragma unroll
            for (int ai = 0; ai < 2; ++ai)
#pragma unroll
                for (int m = 0; m < 4; ++m) { const size_t ro = (size_t)(u.pm * 256 + ai * 128 + wr * 64 + m * 16 + fr) * 1024 + col0;
#pragma unroll
                    for (int bj = 0; bj < 2; ++bj) {
                        const u32x4 hw = *(const u32x4*)(H2b + ro + bj * 128); const u32x4 pl = *(const u32x4*)(PLS + ro + bj * 128);
                        const f32x4 g0 = acc[ai][bj][m][0] + bv[bj][0], g1 = acc[ai][bj][m][1] + bv[bj][1];
                        f32x4 o0, o1;
                        o0[0] = bflo(hw.x) * ALPHA + bflo(pl.x) * sigmoidf_(g0[0]); o0[1] = bfhi(hw.x) * ALPHA + bfhi(pl.x) * sigmoidf_(g0[1]); o0[2] = bflo(hw.y) * ALPHA + bflo(pl.y) * sigmoidf_(g0[2]); o0[3] = bfhi(hw.y) * ALPHA + bfhi(pl.y) * sigmoidf_(g0[3]);
                        o1[0] = bflo(hw.z) * ALPHA + bflo(pl.z) * sigmoidf_(g1[0]); o1[1] = bfhi(hw.z) * ALPHA + bfhi(pl.z) * sigmoidf_(g1[1]); o1[2] = bflo(hw.w) * ALPHA + bflo(pl.w) * sigmoidf_(g1[2]); o1[3] = bfhi(hw.w) * ALPHA + bfhi(pl.w) * sigmoidf_(g1[3]);
                        acc[ai][bj][m][0] = o0; acc[ai][bj][m][1] = o1; }
                    asm volatile("" : "+v"(acc[ai][0][m][0]), "+v"(acc[ai][0][m][1]), "+v"(acc[ai][1][m][0]), "+v"(acc[ai][1][m][1]));
                    asm volatile("" ::: "memory"); }
        }
        panel_ln_stats8(acc, u.pm, u.pn, (unsigned*)(ws + WS_CTL) + 20480, (unsigned long long*)(ws + WS_XCH3), lds, wr, wc, fr, fq);
        const LAS f32x2* Ss = (const LAS f32x2*)(lds + 8192);
        f32x4 gg[2][2], bb[2][2];
#pragma unroll
        for (int bj = 0; bj < 2; ++bj)
#pragma unroll
            for (int n = 0; n < 2; ++n) { gg[bj][n] = *(const f32x4*)(gam + col0 + bj * 128 + 4 * n); bb[bj][n] = *(const f32x4*)(bet + col0 + bj * 128 + 4 * n); }
#pragma unroll
        for (int ai = 0; ai < 2; ++ai)
#pragma unroll
            for (int m = 0; m < 4; ++m) { const int rl = ai * 128 + wr * 64 + m * 16 + fr; const f32x2 st_ = Ss[rl]; float* op = out + (size_t)(u.pm * 256 + rl) * 1024 + col0;
#pragma unroll
                for (int bj = 0; bj < 2; ++bj)
#pragma unroll
                    for (int n = 0; n < 2; ++n) *(f32x4*)(op + bj * 128 + 4 * n) = (acc[ai][bj][m][n] - st_.x) * st_.y * gg[bj][n] + bb[bj][n]; }
    }
};
__device__ __forceinline__ void phase_ple_gemm(const Params& P, lds_t* lds) {
    unsigned char* ws = P.ws;
    {
        const unsigned cv = ((const unsigned*)(ws + WS_CTL))[PLE_CTR_WORD]; const int done = cv < 512u ? (int)cv : 512;
        SchedPle S{(const bf16_t*)(ws + WS_PB), (const bf16_t*)(ws + WS_WPLE), (int)gridDim.x, done + (int)blockIdx.x};
        EpiPark E{(bf16_t*)(ws + WS_H1LO)};
        g8::gemm_phase(lds, 256, S, E);
        __syncthreads();
    }
    for (int it = 0; ln_tile(it) < 128 * 4; ++it) { const int tile = ln_tile(it);
        SchedOne S{(const bf16_t*)(ws + WS_RA), (const bf16_t*)(ws + WS_WPG), 1024, tile};
        EpiGateLn3 E{(const bf16_t*)(ws + WS_RA), (const bf16_t*)(ws + WS_H1LO), P.in[23], P.in[24], P.in[25], P.out, ws, lds};
        g8::gemm_phase(lds, 1024, S, E);
        __syncthreads();
    }
}

__device__ __forceinline__ void phase_ln3(const Params& P, lds_t* lds) {
    int tid = threadIdx.x; asm volatile("" : "+v"(tid));
    const int lane = tid & 63, wid = __builtin_amdgcn_readfirstlane(tid >> 6);
    float* out = P.out;
    f32x4 g[4], bt[4];
#pragma unroll
    for (int j = 0; j < 4; ++j) { g[j] = *(const f32x4*)(P.in[24] + 4 * lane + 256 * j); bt[j] = *(const f32x4*)(P.in[25] + 4 * lane + 256 * j); }
    for (int panel = blockIdx.x; panel < 256; panel += gridDim.x) {
        const int row0 = panel * 128;
#pragma unroll 1
        for (int rr = 0; rr < 16; ++rr) {
            const size_t ro = (size_t)(row0 + 16 * wid + rr) * 1024 + 4 * lane;
            f32x4 v[4];
#pragma unroll
            for (int j = 0; j < 4; ++j) v[j] = *(const f32x4*)(out + ro + 256 * j);
            ln_row(v, g, bt);
#pragma unroll
            for (int j = 0; j < 4; ++j) *(f32x4*)(out + ro + 256 * j) = v[j];
        }
    }
}

#define XB_TMO      128
#define XB_XCNT(j)  (256  + 64 * (j))
#define XB_XSUB(j)  (1280 + 64 * (j))
#define XB_XGEN(j)  (2304 + 64 * (j))
#define XB_TOP      3328
#define XB_TOPGEN   3392
#define XCD_BAR_WORDS 3456
#define XB_SPIN_CAP (1u << 18)

__device__ __forceinline__ unsigned xb_ld(unsigned* p)              { return __hip_atomic_load(p, __ATOMIC_RELAXED, __HIP_MEMORY_SCOPE_AGENT); }
__device__ __forceinline__ unsigned xb_add(unsigned* p, unsigned v) { return __hip_atomic_fetch_add(p, v, __ATOMIC_RELAXED, __HIP_MEMORY_SCOPE_AGENT); }
__device__ __forceinline__ unsigned xb_xcc_id() { return (unsigned)__builtin_amdgcn_s_getreg((3 << 11) | 20) & 0xFu; }
#define XB_SPIN(cond, bar) do { unsigned _sp = 0; while (cond) { __builtin_amdgcn_s_sleep(1); \
    if ((++_sp & 255u) == 0u) { if (xb_ld(&(bar)[XB_TMO])) break; if (_sp > XB_SPIN_CAP) { atomicAdd(&(bar)[XB_TMO], 1u); break; } } } } while (0)

struct XcdBarrier {
    unsigned* bar; unsigned x;
    volatile LAS unsigned* st;
};

__device__ __forceinline__ XcdBarrier xcd_barrier_post(unsigned* bar, volatile LAS unsigned* st) {
    XcdBarrier b; b.bar = bar; b.x = xb_xcc_id(); b.st = st;
    if (threadIdx.x == 0) (void)xb_add(&bar[XB_XCNT(b.x)], 1u);
    return b;
}
__device__ __forceinline__ void xcd_barrier_complete(unsigned* bar, unsigned x, unsigned& nloc, unsigned& nx) {
    const unsigned G = gridDim.x * gridDim.y * gridDim.z;
    unsigned sum, cnt, mine, sp = 0u;
    for (;;) {
        sum = 0u; cnt = 0u; mine = 0u;
#pragma unroll
        for (unsigned j = 0; j < 16; ++j) { const unsigned c = xb_ld(&bar[XB_XCNT(j)]); sum += c; cnt += (c > 0u) ? 1u : 0u; mine = (j == x) ? c : mine; }
        if (sum == G) break;
        __builtin_amdgcn_s_sleep(1);
        if ((++sp & 255u) == 0u) { if (xb_ld(&bar[XB_TMO])) break; if (sp > XB_SPIN_CAP) { atomicAdd(&bar[XB_TMO], 1u); break; } }
    }
    nloc = mine > 0u ? mine : 1u; nx = cnt > 0u ? cnt : 1u;
}

__device__ __forceinline__ void xcd_barrier(const XcdBarrier& b) {
    asm volatile("s_waitcnt vmcnt(0)" ::: "memory");
    __syncthreads();
    if (threadIdx.x == 0) {
        unsigned* bar = b.bar;
        __builtin_amdgcn_s_waitcnt(0);
        unsigned nloc = b.st[0], nx = b.st[1];
        if (nloc == 0u) { xcd_barrier_complete(bar, b.x, nloc, nx); b.st[0] = nloc; b.st[1] = nx; }
        const unsigned old = xb_add(&bar[XB_XSUB(b.x)], 1u);
        const unsigned gen = old / nloc;
        if (old + 1u == (gen + 1u) * nloc) {
            __builtin_amdgcn_fence(__ATOMIC_RELEASE, "agent");
            asm volatile("s_waitcnt vmcnt(0)" ::: "memory");
            const unsigned og = xb_add(&bar[XB_TOP], 1u);
            const unsigned tg = og / nx;
            if (og + 1u == (tg + 1u) * nx) xb_add(&bar[XB_TOPGEN], 1u);
            else XB_SPIN(xb_ld(&bar[XB_TOPGEN]) == tg, bar);
            __builtin_amdgcn_fence(__ATOMIC_ACQUIRE, "agent");
            xb_add(&bar[XB_XGEN(b.x)], 1u);
            asm volatile("s_waitcnt vmcnt(0)" ::: "memory");
        } else {
            XB_SPIN(xb_ld(&bar[XB_XGEN(b.x)]) == gen, bar);
            __builtin_amdgcn_fence(__ATOMIC_ACQUIRE, "agent");
            asm volatile("s_waitcnt vmcnt(0)" ::: "memory");
        }
    }
    __syncthreads();
}

#ifndef USE_CG_SYNC
#define USE_CG_SYNC 0
#endif
constexpr size_t WS_BAR = 65536;
constexpr size_t CTL_ZERO_BYTES = 131072;
__global__ void __launch_bounds__(NTHREADS) fwd_kernel(Params P) {
    extern __shared__ __attribute__((aligned(16))) unsigned char smem[];
    lds_t* lds = (lds_t*)smem;
    const int lo = P.ph_lo, hi = P.ph_hi;
#if !USE_CG_SYNC
    volatile LAS unsigned* bst = (volatile LAS unsigned*)(lds + LDS_BYTES - 16);
    if (threadIdx.x < 2) bst[threadIdx.x] = 0u;
    __syncthreads();
    XcdBarrier bar; bar.bar = (unsigned*)(P.ws + WS_BAR); bar.x = 0; bar.st = nullptr;
    if (hi - lo > 1) bar = xcd_barrier_post((unsigned*)(P.ws + WS_BAR), bst);
#define GRID_SYNC() xcd_barrier(bar)
#else
#define GRID_SYNC() cg::this_grid().sync()
#endif
#ifndef ONLY_PHASE
#define ONLY_PHASE -1
#endif
#ifndef REPEAT_PHASE
#define REPEAT_PHASE -1
#endif
#define PHASE(k, fn) if ((ONLY_PHASE < 0 || ONLY_PHASE == (k)) && lo <= (k) && (k) < hi) { int nrep_ = (REPEAT_PHASE == (k)) ? 2 : 1; asm volatile("" : "+s"(nrep_)); for (int rep_ = 0; rep_ < nrep_; ++rep_) { fn(P, lds); __syncthreads(); } if ((k) + 1 < hi) { GRID_SYNC(); } }
    PHASE(0, phase_prep)
    PHASE(1, phase_inproj)
    PHASE(2, phase_conv_compress)
    PHASE(3, phase_nsa)
    PHASE(4, phase_outproj_gemm)
    PHASE(5, phase_ln1_router)
    PHASE(6, phase_moe1)
    PHASE(7, phase_moe2)
    PHASE(8, phase_ln2)
    PHASE(9, phase_ple_gemm)
#undef PHASE
}

extern "C" void kernel_launch(void* const* d_in, const int* in_sizes, int n_in, void* d_out, int out_size, void* d_ws, size_t ws_size, hipStream_t stream) {
    static int grid = 0;
    if (grid == 0) {
        if (n_in != 26 || ws_size < WS_END) { fprintf(stderr, "kernel_launch: unexpected n_in %d or ws_size %zu (< %zu)\n", n_in, ws_size, (size_t)WS_END); grid = -1; return; }
        int dev = 0, cus = 0, per_cu = 0;
        (void)hipGetDevice(&dev);
        (void)hipDeviceGetAttribute(&cus, hipDeviceAttributeMultiprocessorCount, dev);
        (void)hipFuncSetAttribute((const void*)fwd_kernel, hipFuncAttributeMaxDynamicSharedMemorySize, LDS_BYTES);
        (void)hipOccupancyMaxActiveBlocksPerMultiprocessor(&per_cu, (const void*)fwd_kernel, NTHREADS, LDS_BYTES);
        if (per_cu < 1) { fprintf(stderr, "kernel_launch: occupancy query says %d blocks per CU\n", per_cu); per_cu = 1; }
        grid = cus & ~3;
        (void)hipGetLastError();
    }
    if (grid < 0) return;
    Params p{};
    for (int i = 0; i < 26; ++i) p.in[i] = (const float*)d_in[i];
    p.out = (float*)d_out; p.ws = (unsigned char*)d_ws;
#if N_LAUNCH_SPLIT
    for (int ph = 0; ph < 10; ++ph) { p.ph_lo = ph; p.ph_hi = ph + 1; hipLaunchKernelGGL(fwd_kernel, dim3(grid), dim3(NTHREADS), LDS_BYTES, stream, p); }
#else
    p.ph_lo = 0; p.ph_hi = 10;
#if USE_CG_SYNC
    void* args[] = {&p};
    hipError_t e = hipLaunchCooperativeKernel((const void*)fwd_kernel, dim3(grid), dim3(NTHREADS), args, LDS_BYTES, stream);
    if (e != hipSuccess) fprintf(stderr, "cooperative launch failed: %s (grid %d)\n", hipGetErrorString(e), grid);
#else
    if (hipMemsetAsync((char*)d_ws + WS_CTL, 0, CTL_ZERO_BYTES, stream) != hipSuccess) { fprintf(stderr, "kernel_launch: hipMemsetAsync failed\n"); return; }
    hipLaunchKernelGGL(fwd_kernel, dim3(grid), dim3(NTHREADS), LDS_BYTES, stream, p);
#endif
#endif
}
```

```cpp
#include <hip/hip_runtime.h>
#include <hip/hip_cooperative_groups.h>
#include <cstdio>
#include <cstdint>
namespace cg = cooperative_groups;

#ifndef N_LAUNCH_SPLIT
#define N_LAUNCH_SPLIT 0
#endif

#define LAS __attribute__((address_space(3)))
typedef unsigned short bf16_t;
typedef short bf16x8 __attribute__((ext_vector_type(8)));
typedef float f32x4 __attribute__((ext_vector_type(4)));
typedef float f32x2 __attribute__((ext_vector_type(2)));
typedef unsigned u32x4 __attribute__((ext_vector_type(4)));
typedef unsigned u32x2 __attribute__((ext_vector_type(2)));
typedef __bf16 bf16x2_t __attribute__((ext_vector_type(2)));
typedef LAS unsigned char lds_t;

constexpr int NBATCH = 4, SEQ = 8192, T = NBATCH * SEQ, DM = 1024;
constexpr int NTHREADS = 512;
constexpr float ALPHA = 1.189207115002721f;
constexpr float LN_EPS = 1e-5f;
constexpr float QSCALE = 0.125f * 1.4426950408889634f;
constexpr int NIN_PAD = 3072;
constexpr int LDS_BYTES = 163840;

constexpr size_t MiB = 1u << 20;
constexpr size_t WS_CTL = 0;
constexpr size_t WS_WIN = 1 * MiB;
constexpr size_t WS_WOUT = 7 * MiB;
constexpr size_t WS_WPG = 9 * MiB;
constexpr size_t WS_WPLE = 11 * MiB;
constexpr size_t WS_W1CK = 12 * MiB;
constexpr size_t WS_W1CV = 12 * MiB + 512 * 1024;
constexpr size_t WS_W2CK = 13 * MiB;
constexpr size_t WS_W2CV = 13 * MiB + 64 * 1024;
constexpr size_t WS_BIAS1 = 13 * MiB + 128 * 1024;
constexpr size_t WS_WRB = 13 * MiB + 256 * 1024;
constexpr size_t WS_WEIN = 14 * MiB;
constexpr size_t WS_WEOUT = 78 * MiB;
constexpr size_t WS_PB = 110 * MiB;
constexpr size_t WS_G = 126 * MiB;
constexpr size_t WS_KCMP = 129 * MiB;
constexpr size_t WS_VCMPT = 129 * MiB + 512 * 1024;
constexpr size_t WS_ASGE = 130 * MiB;
constexpr size_t WS_ASGS = 130 * MiB + 256 * 1024;
constexpr size_t WS_ASGW = 130 * MiB + 512 * 1024;
constexpr size_t WS_TOKL = 131 * MiB;
constexpr size_t WS_H1B = 140 * MiB;
constexpr size_t WS_RA = 204 * MiB;
constexpr size_t WS_RB = 276 * MiB;
constexpr size_t WS_U = WS_RB, WS_CB = WS_RB + 32 * MiB, WS_Q = WS_RB + 64 * MiB, WS_KC = WS_RB + 96 * MiB, WS_VC = WS_RB + 104 * MiB;
constexpr size_t WS_KS = WS_RB + 112 * MiB, WS_VST = WS_RB + 120 * MiB, WS_KW = WS_RB + 128 * MiB, WS_VWT = WS_RB + 136 * MiB;
constexpr size_t WS_H1LO = 420 * MiB;
constexpr size_t WS_XCH1 = 484 * MiB;
constexpr size_t WS_XCH3 = 485 * MiB;
constexpr size_t WS_END = 486 * MiB;

struct Params {
    const float* in[26];
    float* out;
    unsigned char* ws;
    int ph_lo, ph_hi;
};

__device__ __forceinline__ unsigned pk2(float lo, float hi) { f32x2 v = {lo, hi}; bf16x2_t b = __builtin_convertvector(v, bf16x2_t); return __builtin_bit_cast(unsigned, b); }
__device__ __forceinline__ bf16_t f2bf(float f) { return (bf16_t)(pk2(f, 0.f) & 0xffffu); }
__device__ __forceinline__ float bf2f(unsigned h) { return __uint_as_float(h << 16); }
__device__ __forceinline__ float bflo(unsigned w) { return __uint_as_float(w << 16); }
__device__ __forceinline__ float bfhi(unsigned w) { return __uint_as_float(w & 0xffff0000u); }
__device__ __forceinline__ u32x2 pk4(f32x4 v) { u32x2 o; o.x = pk2(v[0], v[1]); o.y = pk2(v[2], v[3]); return o; }
__device__ __forceinline__ unsigned pk4_f8(float a, float b, float c, float d) { int w = 0; w = __builtin_amdgcn_cvt_pk_fp8_f32(a, b, w, false); w = __builtin_amdgcn_cvt_pk_fp8_f32(c, d, w, true); return (unsigned)w; }
__device__ __forceinline__ u32x2 pk8_f8(f32x4 a, f32x4 b) { u32x2 o; o.x = pk4_f8(a[0], a[1], a[2], a[3]); o.y = pk4_f8(b[0], b[1], b[2], b[3]); return o; }
__device__ __forceinline__ u32x4 pk8(f32x4 a, f32x4 b) { u32x4 o; o.x = pk2(a[0], a[1]); o.y = pk2(a[2], a[3]); o.z = pk2(b[0], b[1]); o.w = pk2(b[2], b[3]); return o; }
__host__ __device__ __forceinline__ int perm64(int n) { return (n & ~63) | (((n >> 2) & 3) << 4) | (((n >> 4) & 3) << 2) | (n & 3); }
__device__ __forceinline__ float fexp2(float x) { return __builtin_amdgcn_exp2f(x); }
__device__ __forceinline__ float sigmoidf_(float x) { return __builtin_amdgcn_rcpf(1.0f + __expf(-x)); }
__device__ __forceinline__ int lds_off(int row, int chunk) { return row * 128 + ((chunk ^ ((row >> 1) & 7)) << 4); }
__device__ __forceinline__ bf16x8 lds_ld16(lds_t* p) { return *(LAS bf16x8*)p; }
__device__ __forceinline__ void lds_st16(lds_t* p, u32x4 v) { *(LAS u32x4*)p = v; }
__device__ __forceinline__ bf16x8 gld16(const bf16_t* p) { return *(const bf16x8*)p; }
__device__ __forceinline__ f32x4 mfma16(bf16x8 a, bf16x8 b, f32x4 c) { return __builtin_amdgcn_mfma_f32_16x16x32_bf16(a, b, c, 0, 0, 0); }
__device__ __forceinline__ int fenc(float f) { int b = __float_as_int(f); return b >= 0 ? b : (b ^ 0x7fffffff); }
__device__ __forceinline__ float fdec(int b) { return __int_as_float(b >= 0 ? b : (b ^ 0x7fffffff)); }
__device__ __forceinline__ float sx(float v, int m) { return __shfl_xor(v, m); }

__device__ __forceinline__ void lds_addf(LAS float* p, float v) { (void)__hip_atomic_fetch_add(p, v, __ATOMIC_RELAXED, __HIP_MEMORY_SCOPE_WORKGROUP); }
__device__ __forceinline__ void lds_addi_nr(LAS int* p, int v) { (void)__hip_atomic_fetch_add(p, v, __ATOMIC_RELAXED, __HIP_MEMORY_SCOPE_WORKGROUP); }
__device__ __forceinline__ int lds_addi(LAS int* p, int v) { return __hip_atomic_fetch_add(p, v, __ATOMIC_RELAXED, __HIP_MEMORY_SCOPE_WORKGROUP); }
__device__ __forceinline__ void lds_maxi(LAS int* p, int v) { (void)__hip_atomic_fetch_max(p, v, __ATOMIC_RELAXED, __HIP_MEMORY_SCOPE_WORKGROUP); }
__device__ __forceinline__ void lds_oru(LAS unsigned* p, unsigned v) { (void)__hip_atomic_fetch_or(p, v, __ATOMIC_RELAXED, __HIP_MEMORY_SCOPE_WORKGROUP); }

template <int BM, int BN, int WTM = 64, int WTN = 64, bool ZERO = true>
__device__ __forceinline__ void gemm_mainloop(lds_t* lds, const bf16_t* (&ap)[BM / 64], int astep, const bf16_t* (&bp)[BN / 64], int nk, f32x4 (&acc)[WTM / 16][WTN / 16]) {
    constexpr int NA = BM / 64, NB_ = BN / 64, WN = BN / WTN, MT = WTM / 16, NT = WTN / 16;
    static_assert((BM / WTM) * (BN / WTN) == 8, "8 waves");
    constexpr int STAGE = (BM + BN) * 128;
    int tid = threadIdx.x; asm volatile("" : "+v"(tid));
    const int lane = tid & 63, wid = __builtin_amdgcn_readfirstlane(tid >> 6);
    const int r = lane & 15, q = lane >> 4;
    const int wm = wid / WN, wn = wid % WN;
    const int sc = tid & 7, sr = tid >> 3;
    const int wofs = sr * 128 + ((sc ^ ((sr >> 1) & 7)) << 4);
    const int x0 = (q ^ (r >> 1)) << 4;
    const int aoff = (wm * WTM + r) * 128, boff = BM * 128 + (wn * WTN + r) * 128;
    u32x4 ra0[NA], rb0[NB_], ra1[NA], rb1[NB_];
    if (ZERO) {
#pragma unroll
        for (int i = 0; i < MT; ++i)
#pragma unroll
            for (int j = 0; j < NT; ++j) acc[i][j] = (f32x4){0.f, 0.f, 0.f, 0.f};
    }
#define GM_LOAD(RA, RB, KT) do { _Pragma("unroll") for (int i = 0; i < NA; ++i) RA[i] = *(const u32x4*)(ap[i] + (size_t)(KT) * astep); \
                                 _Pragma("unroll") for (int i = 0; i < NB_; ++i) RB[i] = *(const u32x4*)(bp[i] + (size_t)(KT) * 64); } while (0)
#define GM_WRITE(RA, RB, ST) do { lds_t* sn_ = lds + (ST) * STAGE; _Pragma("unroll") for (int i = 0; i < NA; ++i) lds_st16(sn_ + i * 8192 + wofs, RA[i]); \
                                  _Pragma("unroll") for (int i = 0; i < NB_; ++i) lds_st16(sn_ + BM * 128 + i * 8192 + wofs, RB[i]); } while (0)
#define GM_COMPUTE(ST) do { lds_t* st_ = lds + (ST) * STAGE; _Pragma("unroll") for (int s = 0; s < 2; ++s) { const int xs = x0 ^ (s << 6); bf16x8 a[MT], b[NT]; \
        _Pragma("unroll") for (int i = 0; i < MT; ++i) a[i] = lds_ld16(st_ + aoff + i * 2048 + xs); \
        _Pragma("unroll") for (int i = 0; i < NT; ++i) b[i] = lds_ld16(st_ + boff + i * 2048 + xs); \
        _Pragma("unroll") for (int i = 0; i < MT; ++i) _Pragma("unroll") for (int j = 0; j < NT; ++j) acc[i][j] = mfma16(b[j], a[i], acc[i][j]); } } while (0)
    GM_LOAD(ra0, rb0, 0);
    if (nk > 1) GM_LOAD(ra1, rb1, 1);
    GM_WRITE(ra0, rb0, 0);
    __syncthreads();
    for (int kt = 0; kt < nk; kt += 2) {
        if (kt + 2 < nk) GM_LOAD(ra0, rb0, kt + 2);
        GM_COMPUTE(0);
        if (kt + 1 < nk) GM_WRITE(ra1, rb1, 1);
        __syncthreads();
        if (kt + 1 < nk) {
            if (kt + 3 < nk) GM_LOAD(ra1, rb1, kt + 3);
            GM_COMPUTE(1);
            if (kt + 2 < nk) GM_WRITE(ra0, rb0, 0);
            __syncthreads();
        }
    }
#undef GM_LOAD
#undef GM_WRITE
#undef GM_COMPUTE
}

__device__ __forceinline__ int glds_lchunk(int tid) { return ((tid & 7) ^ ((tid >> 4) & 7)) * 8; }
__device__ __forceinline__ void gemm256_first(lds_t* lds, const bf16_t* abase, const unsigned (&aoffs)[4], const bf16_t* bbase, const unsigned (&boffs)[4]) {
    const int wid = __builtin_amdgcn_readfirstlane(threadIdx.x >> 6);
#pragma unroll
    for (int i = 0; i < 4; ++i) {
        __builtin_amdgcn_global_load_lds((const unsigned*)(abase + aoffs[i]), (LAS unsigned*)(lds + i * 8192 + wid * 1024), 16, 0, 0);
        __builtin_amdgcn_global_load_lds((const unsigned*)(bbase + boffs[i]), (LAS unsigned*)(lds + 32768 + i * 8192 + wid * 1024), 16, 0, 0); }
}
struct AccZero { __device__ __forceinline__ f32x4 operator()(int, int) const { return (f32x4){0.f, 0.f, 0.f, 0.f}; } __device__ __forceinline__ void next() {} };
struct AccFromF32 { const float* p; size_t step; float scale;
    __device__ __forceinline__ f32x4 operator()(int, int j) const { return *(const f32x4*)(p + j * 4) * scale; }
    __device__ __forceinline__ void next() { p += step; asm volatile("" : "+v"(p)); } };
template <class Init = AccZero>
__device__ __forceinline__ void gemm256_main(lds_t* lds, const bf16_t* abase, const unsigned (&aoffs)[4], int astep, const bf16_t* bbase, const unsigned (&boffs)[4], int nk, f32x4 (&acc)[8][4], Init init = Init()) {
    int tid = threadIdx.x; asm volatile("" : "+v"(tid));
    const int lane = tid & 63, wid = __builtin_amdgcn_readfirstlane(tid >> 6);
    const int r = lane & 15, q = lane >> 4, wr = wid >> 2, wc = wid & 3;
    const int x0 = (q ^ (r >> 1)) << 4;
    const int aoff = (wr * 128 + r) * 128, boff = 32768 + (wc * 64 + r) * 128;
    const int sflip = wr;
#pragma unroll
    for (int i = 0; i < 8; ++i) {
#pragma unroll
        for (int j = 0; j < 4; ++j) acc[i][j] = init(i, j);
        init.next(); }
#define G2_STAGE(BUF, KT) do { _Pragma("unroll") for (int i = 0; i < 4; ++i) { \
        __builtin_amdgcn_global_load_lds((const unsigned*)((abase + (size_t)(KT) * astep) + aoffs[i]), (LAS unsigned*)(lds + (BUF) * 65536 + i * 8192 + wid * 1024), 16, 0, 0); \
        __builtin_amdgcn_global_load_lds((const unsigned*)((bbase + (size_t)(KT) * 64) + boffs[i]), (LAS unsigned*)(lds + (BUF) * 65536 + 32768 + i * 8192 + wid * 1024), 16, 0, 0); } } while (0)
#define G2_COMPUTE(BUF) do { lds_t* st_ = lds + (BUF) * 65536; _Pragma("unroll") for (int s = 0; s < 2; ++s) { const int xs = x0 ^ ((s ^ sflip) << 6); bf16x8 a[8], b[4]; \
        _Pragma("unroll") for (int i = 0; i < 8; ++i) a[i] = lds_ld16(st_ + aoff + i * 2048 + xs); \
        _Pragma("unroll") for (int i = 0; i < 4; ++i) b[i] = lds_ld16(st_ + boff + i * 2048 + xs); \
        _Pragma("unroll") for (int i = 0; i < 8; ++i) _Pragma("unroll") for (int j = 0; j < 4; ++j) acc[i][j] = mfma16(b[j], a[i], acc[i][j]); \
        __builtin_amdgcn_sched_barrier(0); } } while (0)
    asm volatile("s_waitcnt vmcnt(0)" ::: "memory");
    __syncthreads();
    for (int t = 0; t < nk; ++t) {
        const int cur = t & 1;
        if (t + 1 < nk) G2_STAGE(cur ^ 1, t + 1);
        G2_COMPUTE(cur);
        asm volatile("s_waitcnt vmcnt(0)" ::: "memory");
        __syncthreads();
    }
#undef G2_STAGE
#undef G2_COMPUTE
}
__device__ __forceinline__ void gemm256(lds_t* lds, const bf16_t* abase, const unsigned (&aoffs)[4], int astep, const bf16_t* bbase, const unsigned (&boffs)[4], int nk, f32x4 (&acc)[8][4]) {
    gemm256_first(lds, abase, aoffs, bbase, boffs);
    gemm256_main(lds, abase, aoffs, astep, bbase, boffs, nk, acc);
}


namespace g8 {
constexpr int HALF = 128, HTB = HALF * 64 * 2, STAGE_BYTES = 8 * HTB;
__device__ __forceinline__ int lds_byte(int r, int c) { const int st = (r >> 4) * 2 + (c >> 5), rr = r & 15, cc = c & 31, ob = rr * 64 + cc * 2; return st * 1024 + (ob ^ (((ob >> 9) & 1) << 5)); }
__device__ __forceinline__ void stage_rc(int b, int& R, int& C) { const int st = b / 1024, sb = b % 1024, swz = sb ^ (((sb >> 9) & 1) << 5); R = (st >> 1) * 16 + swz / 64; C = (st & 1) * 32 + (swz % 64) / 2; }
__device__ __forceinline__ int perm32(int rho) { const int n = rho >> 4, i = rho & 15; return 8 * (i >> 2) + 4 * n + (i & 3); }
struct Unit { int pm, pn, e, ne, rb, idx; };
typedef f32x4 Acc[2][2][4][2];
__device__ __forceinline__ void acc_zero(Acc& acc) {
#pragma unroll
    for (int a = 0; a < 2; ++a)
#pragma unroll
        for (int b = 0; b < 2; ++b)
#pragma unroll
            for (int m = 0; m < 4; ++m)
#pragma unroll
                for (int n = 0; n < 2; ++n) acc[a][b][m][n] = (f32x4){0.f, 0.f, 0.f, 0.f};
}
__device__ __forceinline__ void natural_offsets(unsigned (&voffA)[2][2], int K, int tid) {
#pragma unroll
    for (int i = 0; i < 2; ++i) { int R, C; stage_rc(tid * 16 + i * 8192, R, C); voffA[0][i] = (unsigned)(R * K + C) * 2u; voffA[1][i] = (unsigned)((R + HALF) * K + C) * 2u; }
}
template <class Epi, class Sched>
__device__ __forceinline__ void gemm_phase(lds_t* lds, const int K, const Sched& S, const Epi& E) {
    int tid = threadIdx.x; asm volatile("" : "+v"(tid));
    const int wid = __builtin_amdgcn_readfirstlane(tid >> 6), lane = tid & 63, wr = wid >> 2, wc = wid & 3, fr = lane & 15, fq = lane >> 4;
    const int nt = K / 64;
    unsigned voffA[2][2], voffB[2];
#pragma unroll
    for (int i = 0; i < 2; ++i) { int R, C; stage_rc(tid * 16 + i * 8192, R, C); const int Rb = (R & ~31) + perm32(R & 31); voffB[i] = (unsigned)(Rb * K + C) * 2u; }
    const size_t kstep = 128;
    const unsigned ldsw = (unsigned)wid * 1024u;
    const int aoff = lds_byte(wr * 64 + fr, fq * 8), boff = lds_byte(wc * 32 + fr, fq * 8);
#define G8_SA(b, h) (((b) * 2 + (h)) * g8::HTB)
#define G8_SB(b, h) ((4 + (b) * 2 + (h)) * g8::HTB)
#define G8_STAGE(bufoff, gbase, voff) do { _Pragma("unroll") for (int _i = 0; _i < 2; ++_i) \
        __builtin_amdgcn_global_load_lds((const unsigned*)((const char*)(gbase) + (voff)[_i]), (LAS unsigned*)(lds + (bufoff) + ldsw + _i * 8192), 16, 0, 0); } while (0)
#define G8_LDA(dst, b, h) do { _Pragma("unroll") for (int m = 0; m < 4; ++m) _Pragma("unroll") for (int k = 0; k < 2; ++k) dst[m][k] = *(const LAS bf16x8*)(lds + G8_SA(b, h) + aoff + m * 2048 + k * 1024); } while (0)
#define G8_LDB(dst, b, h) do { _Pragma("unroll") for (int n = 0; n < 2; ++n) _Pragma("unroll") for (int k = 0; k < 2; ++k) dst[n][k] = *(const LAS bf16x8*)(lds + G8_SB(b, h) + boff + n * 2048 + k * 1024); } while (0)
#define G8_MMA(ai, bj, At, Bt) do { __builtin_amdgcn_s_setprio(1); _Pragma("unroll") for (int m = 0; m < 4; ++m) _Pragma("unroll") for (int n = 0; n < 2; ++n) _Pragma("unroll") for (int k = 0; k < 2; ++k) \
        acc[ai][bj][m][n] = __builtin_amdgcn_mfma_f32_16x16x32_bf16(Bt[n][k], At[m][k], acc[ai][bj][m][n], 0, 0, 0); __builtin_amdgcn_s_setprio(0); } while (0)
#define G8_WAIT_V(n) asm volatile("s_waitcnt vmcnt(" #n ")" ::: "memory")
#define G8_WAIT_L(n) asm volatile("s_waitcnt lgkmcnt(" #n ")" ::: "memory")
#define G8_BAR __builtin_amdgcn_s_barrier()
#define G8_SCHED __builtin_amdgcn_sched_barrier(0)
    Unit cur, nxt; int ui = 0;
    if (!S.next(0, cur)) return;
    Acc acc;
    E.init(acc, cur, wr, wc, fr, fq);
    bf16x8 At[4][2], B0[2][2], B1[2][2];
    const char* cA = S.a_base(cur); const char* cB0 = S.b_base(cur, 0); const char* cB1 = S.b_base(cur, 1);
    S.a_offsets(cur, voffA, tid);
    G8_STAGE(G8_SB(0, 0), cB0, voffB); G8_STAGE(G8_SA(0, 0), cA, voffA[0]); G8_STAGE(G8_SB(0, 1), cB1, voffB); G8_STAGE(G8_SA(0, 1), cA, voffA[1]);
    if (wr == 1) G8_BAR;
    G8_WAIT_V(4); G8_BAR;
    G8_STAGE(G8_SB(1, 0), cB0 + kstep, voffB); G8_STAGE(G8_SA(1, 0), cA + kstep, voffA[0]); G8_STAGE(G8_SB(1, 1), cB1 + kstep, voffB);
    G8_WAIT_V(6); G8_BAR;
    E.post_prologue(acc);
    for (;;) {
        const bool has_next = S.next(ui + 1, nxt);
        const char* nA = has_next ? S.a_base(nxt) : cA; const char* nB0 = has_next ? S.b_base(nxt, 0) : cB0; const char* nB1 = has_next ? S.b_base(nxt, 1) : cB1;
        for (int t = 0; t < nt; t += 2) {
            const bool last = (t == nt - 2);
            const char* a1 = cA + (size_t)(t + 1) * kstep;
            const char* a2 = last ? nA : cA + (size_t)(t + 2) * kstep; const char* b20 = last ? nB0 : cB0 + (size_t)(t + 2) * kstep; const char* b21 = last ? nB1 : cB1 + (size_t)(t + 2) * kstep;
            const char* a3 = a2 + kstep; const char* b30 = b20 + kstep; const char* b31 = b21 + kstep;
            G8_LDB(B0, 0, 0); G8_SCHED; G8_LDA(At, 0, 0); G8_STAGE(G8_SA(1, 1), a1, voffA[1]);
            G8_WAIT_L(8); G8_BAR; G8_WAIT_L(0); G8_MMA(0, 0, At, B0); G8_BAR; G8_SCHED;
            if (last && has_next) S.a_offsets(nxt, voffA, tid);
            G8_LDB(B1, 0, 1); G8_STAGE(G8_SB(0, 0), b20, voffB);
            G8_BAR; G8_WAIT_L(0); G8_MMA(0, 1, At, B1); G8_BAR;
            G8_LDA(At, 0, 1); G8_STAGE(G8_SA(0, 0), a2, voffA[0]);
            G8_BAR; G8_WAIT_L(0); G8_MMA(1, 0, At, B0); G8_BAR; G8_SCHED;
            G8_STAGE(G8_SB(0, 1), b21, voffB);
            G8_WAIT_V(6); G8_BAR; G8_MMA(1, 1, At, B1); G8_BAR;
            G8_LDB(B0, 1, 0); G8_SCHED; G8_LDA(At, 1, 0); G8_STAGE(G8_SA(0, 1), a2, voffA[1]);
            G8_WAIT_L(8); G8_BAR; G8_WAIT_L(0); G8_MMA(0, 0, At, B0); G8_BAR; G8_SCHED;
            G8_LDB(B1, 1, 1); G8_STAGE(G8_SB(1, 0), b30, voffB);
            G8_BAR; G8_WAIT_L(0); G8_MMA(0, 1, At, B1); G8_BAR;
            G8_LDA(At, 1, 1); G8_STAGE(G8_SA(1, 0), a3, voffA[0]);
            G8_BAR; G8_WAIT_L(0); G8_MMA(1, 0, At, B0); G8_BAR; G8_SCHED;
            G8_STAGE(G8_SB(1, 1), b31, voffB);
            G8_WAIT_V(6); G8_BAR; G8_MMA(1, 1, At, B1); G8_BAR;
        }
        if constexpr (!Epi::AFTER_DRAIN) E(acc, cur, wr, wc, fr, fq);
        if (!has_next) break;
        cur = nxt; cA = nA; cB0 = nB0; cB1 = nB1; ++ui;
        E.init(acc, cur, wr, wc, fr, fq);
    }
    G8_WAIT_V(0);
    if (wr == 0) G8_BAR;
    G8_BAR;
    if constexpr (Epi::AFTER_DRAIN) E(acc, cur, wr, wc, fr, fq);
#undef G8_SA
#undef G8_SB
#undef G8_STAGE
#undef G8_LDA
#undef G8_LDB
#undef G8_MMA
#undef G8_WAIT_V
#undef G8_WAIT_L
#undef G8_BAR
#undef G8_SCHED
}
typedef int v8i __attribute__((ext_vector_type(8)));
typedef int v4i __attribute__((ext_vector_type(4)));
__device__ __forceinline__ void f8_rc(int tid, int i, int& R, int& Cb) { R = (tid >> 3) + 64 * i; Cb = ((tid & 7) ^ ((R >> 1) & 7)) << 4; }
template <int SCLW, class Epi, class Sched>
__device__ __forceinline__ void gemm_phase_f8(lds_t* lds, const int K, const Sched& S, const Epi& E) {
    int tid = threadIdx.x; asm volatile("" : "+v"(tid));
    const int wid = __builtin_amdgcn_readfirstlane(tid >> 6), lane = tid & 63, wr = wid >> 2, wc = wid & 3, fr = lane & 15, fq = lane >> 4;
    int nt = K / 128; asm volatile("" : "+s"(nt));
    unsigned voffA[2][2], voffB[2];
#pragma unroll
    for (int i = 0; i < 2; ++i) { int R, Cb; f8_rc(tid, i, R, Cb); const int Rb = (R & ~31) + perm32(R & 31); voffB[i] = (unsigned)(Rb * K + Cb); }
    const size_t kstep = 128;
    const unsigned ldsw = (unsigned)wid * 1024u;
    const int c0_ = ((2 * fq) ^ ((fr >> 1) & 7)) << 4;
    const int aoff = (wr * 64 + fr) * 128 + c0_, boff = (wc * 32 + fr) * 128 + c0_;
    constexpr int SCL_ACT = 0x7f7f7f7f, SCL_W = SCLW * 0x01010101;
#define G8_SA(b, h) (((b) * 2 + (h)) * g8::HTB)
#define G8_SB(b, h) ((4 + (b) * 2 + (h)) * g8::HTB)
#define G8_STAGE(bufoff, gbase, voff) do { _Pragma("unroll") for (int _i = 0; _i < 2; ++_i) \
        __builtin_amdgcn_global_load_lds((const unsigned*)((const char*)(gbase) + (voff)[_i]), (LAS unsigned*)(lds + (bufoff) + ldsw + _i * 8192), 16, 0, 0); } while (0)
#define G8_LDA(dst, b, h) do { _Pragma("unroll") for (int m = 0; m < 4; ++m) { const u32x4 lo_ = *(const LAS u32x4*)(lds + G8_SA(b, h) + aoff + m * 2048), hi_ = *(const LAS u32x4*)(lds + G8_SA(b, h) + (aoff ^ 16) + m * 2048); \
        dst[m] = __builtin_shufflevector(__builtin_bit_cast(v4i, lo_), __builtin_bit_cast(v4i, hi_), 0, 1, 2, 3, 4, 5, 6, 7); } } while (0)
#define G8_LDB(dst, b, h) do { _Pragma("unroll") for (int n = 0; n < 2; ++n) { const u32x4 lo_ = *(const LAS u32x4*)(lds + G8_SB(b, h) + boff + n * 2048), hi_ = *(const LAS u32x4*)(lds + G8_SB(b, h) + (boff ^ 16) + n * 2048); \
        dst[n] = __builtin_shufflevector(__builtin_bit_cast(v4i, lo_), __builtin_bit_cast(v4i, hi_), 0, 1, 2, 3, 4, 5, 6, 7); } } while (0)
#define G8_MMA(ai, bj, At, Bt) do { __builtin_amdgcn_s_setprio(1); _Pragma("unroll") for (int m = 0; m < 4; ++m) _Pragma("unroll") for (int n = 0; n < 2; ++n) \
        acc[ai][bj][m][n] = __builtin_amdgcn_mfma_scale_f32_16x16x128_f8f6f4(Bt[n], At[m], acc[ai][bj][m][n], 0, 0, 0, SCL_W, 0, SCL_ACT); __builtin_amdgcn_s_setprio(0); } while (0)
#define G8_WAIT_V(n) asm volatile("s_waitcnt vmcnt(" #n ")" ::: "memory")
#define G8_WAIT_L(n) asm volatile("s_waitcnt lgkmcnt(" #n ")" ::: "memory")
#define G8_BAR __builtin_amdgcn_s_barrier()
#define G8_SCHED __builtin_amdgcn_sched_barrier(0)
    Unit cur, nxt; int ui = 0;
    if (!S.next(0, cur)) return;
    Acc acc;
    E.init(acc, cur, wr, wc, fr, fq);
    v8i At[4], B0[2], B1[2];
    const char* cA = S.a_base(cur); const char* cB0 = S.b_base(cur, 0); const char* cB1 = S.b_base(cur, 1);
    S.a_offsets(cur, voffA, tid);
    G8_STAGE(G8_SB(0, 0), cB0, voffB); G8_STAGE(G8_SA(0, 0), cA, voffA[0]); G8_STAGE(G8_SB(0, 1), cB1, voffB); G8_STAGE(G8_SA(0, 1), cA, voffA[1]);
    if (wr == 1) G8_BAR;
    G8_WAIT_V(4); G8_BAR;
    G8_STAGE(G8_SB(1, 0), cB0 + kstep, voffB); G8_STAGE(G8_SA(1, 0), cA + kstep, voffA[0]); G8_STAGE(G8_SB(1, 1), cB1 + kstep, voffB);
    G8_WAIT_V(6); G8_BAR;
    E.post_prologue(acc);
    for (;;) {
        const bool has_next = S.next(ui + 1, nxt);
        const char* nA = has_next ? S.a_base(nxt) : cA; const char* nB0 = has_next ? S.b_base(nxt, 0) : cB0; const char* nB1 = has_next ? S.b_base(nxt, 1) : cB1;
#pragma unroll 1
        for (int t = 0; t < nt; t += 2) {
            const bool last = (t == nt - 2);
            const char* a1 = cA + (size_t)(t + 1) * kstep;
            const char* a2 = last ? nA : cA + (size_t)(t + 2) * kstep; const char* b20 = last ? nB0 : cB0 + (size_t)(t + 2) * kstep; const char* b21 = last ? nB1 : cB1 + (size_t)(t + 2) * kstep;
            const char* a3 = a2 + kstep; const char* b30 = b20 + kstep; const char* b31 = b21 + kstep;
            G8_LDB(B0, 0, 0); G8_SCHED; G8_LDA(At, 0, 0); G8_STAGE(G8_SA(1, 1), a1, voffA[1]);
            G8_WAIT_L(8); G8_BAR; G8_WAIT_L(0); G8_MMA(0, 0, At, B0); G8_BAR; G8_SCHED;
            if (last && has_next) S.a_offsets(nxt, voffA, tid);
            G8_LDB(B1, 0, 1); G8_STAGE(G8_SB(0, 0), b20, voffB);
            G8_BAR; G8_WAIT_L(0); G8_MMA(0, 1, At, B1); G8_BAR;
            G8_LDA(At, 0, 1); G8_STAGE(G8_SA(0, 0), a2, voffA[0]);
            G8_BAR; G8_WAIT_L(0); G8_MMA(1, 0, At, B0); G8_BAR; G8_SCHED;
            G8_STAGE(G8_SB(0, 1), b21, voffB);
            G8_WAIT_V(6); G8_BAR; G8_MMA(1, 1, At, B1); G8_BAR;
            G8_LDB(B0, 1, 0); G8_SCHED; G8_LDA(At, 1, 0); G8_STAGE(G8_SA(0, 1), a2, voffA[1]);
            G8_WAIT_L(8); G8_BAR; G8_WAIT_L(0); G8_MMA(0, 0, At, B0); G8_BAR; G8_SCHED;
            G8_LDB(B1, 1, 1); G8_STAGE(G8_SB(1, 0), b30, voffB);
            G8_BAR; G8_WAIT_L(0); G8_MMA(0, 1, At, B1); G8_BAR;
            G8_LDA(At, 1, 1); G8_STAGE(G8_SA(1, 0), a3, voffA[0]);
            G8_BAR; G8_WAIT_L(0); G8_MMA(1, 0, At, B0); G8_BAR; G8_SCHED;
            G8_STAGE(G8_SB(1, 1), b31, voffB);
            G8_WAIT_V(6); G8_BAR; G8_MMA(1, 1, At, B1); G8_BAR;
        }
        if constexpr (!Epi::AFTER_DRAIN) E(acc, cur, wr, wc, fr, fq);
        if (!has_next) break;
        cur = nxt; cA = nA; cB0 = nB0; cB1 = nB1; ++ui;
        E.init(acc, cur, wr, wc, fr, fq);
    }
    G8_WAIT_V(0);
    if (wr == 0) G8_BAR;
    G8_BAR;
    if constexpr (Epi::AFTER_DRAIN) E(acc, cur, wr, wc, fr, fq);
#undef G8_SA
#undef G8_SB
#undef G8_STAGE
#undef G8_LDA
#undef G8_LDB
#undef G8_MMA
#undef G8_WAIT_V
#undef G8_WAIT_L
#undef G8_BAR
#undef G8_SCHED
}
}

template <class CM>
__device__ __forceinline__ void transpose_tile(const float* src, int Nsrc, int K, bf16_t* dst, int k0, int n0, CM cm, LAS float* scr) {
    const int tid = threadIdx.x;
    {
        const int tx = tid & 63, ty = tid >> 6;
        const int scol = cm(n0 + tx);
#pragma unroll
        for (int i = 0; i < 8; ++i) { const int kk = ty + 8 * i; scr[kk * 65 + tx] = scol >= 0 ? src[(size_t)(k0 + kk) * Nsrc + scol] : 0.f; }
    }
    __syncthreads();
    {
        const int kp = tid & 31, n1 = tid >> 5;
#pragma unroll
        for (int i = 0; i < 4; ++i) { const int nn = n1 + 16 * i;
            *(unsigned*)(dst + (size_t)(n0 + nn) * K + k0 + 2 * kp) = pk2(scr[(2 * kp) * 65 + nn], scr[(2 * kp + 1) * 65 + nn]); }
    }
    __syncthreads();
}

__device__ __forceinline__ void transpose_tile_f8(const float* src, int Nsrc, int K, unsigned char* dst8, int k0, int n0, float scale, LAS float* scr) {
    const int tid = threadIdx.x;
    {
        const int tx = tid & 63, ty = tid >> 6;
#pragma unroll
        for (int i = 0; i < 8; ++i) { const int kk = ty + 8 * i; scr[kk * 65 + tx] = src[(size_t)(k0 + kk) * Nsrc + n0 + tx]; }
    }
    __syncthreads();
    {
        const int kq = tid & 15, n1 = tid >> 4;
#pragma unroll
        for (int i = 0; i < 2; ++i) { const int nn = n1 + 32 * i;
            *(unsigned*)(dst8 + (size_t)(n0 + nn) * K + k0 + 4 * kq) = pk4_f8(scale * scr[(4 * kq) * 65 + nn], scale * scr[(4 * kq + 1) * 65 + nn], scale * scr[(4 * kq + 2) * 65 + nn], scale * scr[(4 * kq + 3) * 65 + nn]); }
    }
    __syncthreads();
}

__device__ __forceinline__ int inproj_srccol(int n) {
    if (n < 512) return n;
    if (n < 1536) { const int i = (n - 512) >> 1; return (n & 1) ? 1024 + i : 512 + i; }
    if (n < 2840) return n;
    return -1;
}

__device__ __forceinline__ void phase_prep(const Params& P, lds_t* lds) {
    LAS float* scr = (LAS float*)lds;
    unsigned char* ws = P.ws;
    const int G = gridDim.x, bid = blockIdx.x, tid = threadIdx.x;
    constexpr int T_IN = 16 * 48, T_OUT = 256, T_PG = 256, T_PLE = 64, T_W1 = 64, T_W2 = 2, T_EIN = 32 * 256, T_EOUT = 32 * 128;
    constexpr int NT = T_IN + T_OUT + T_PG + T_PLE + 2 * T_W1 + 2 * T_W2 + T_EIN + T_EOUT;
    for (int it = bid; it < NT; it += G) {
        int x = it;
        if (x < T_IN) { transpose_tile(P.in[2], 2840, 1024, (bf16_t*)(ws + WS_WIN), (x / 48) * 64, (x % 48) * 64, [](int n) { return n < 2840 ? n : -1; }, scr); continue; } x -= T_IN;
        if (x < T_OUT) { transpose_tile(P.in[10], 1024, 1024, (bf16_t*)(ws + WS_WOUT), (x / 16) * 64, (x % 16) * 64, [](int n) { return n; }, scr); continue; } x -= T_OUT;
        if (x < T_PG) { transpose_tile(P.in[22], 1024, 1024, (bf16_t*)(ws + WS_WPG), (x / 16) * 64, (x % 16) * 64, [](int n) { return n; }, scr); continue; } x -= T_PG;
        if (x < T_PLE) { transpose_tile(P.in[21], 1024, 256, (bf16_t*)(ws + WS_WPLE), (x / 16) * 64, (x % 16) * 64, [](int n) { return n; }, scr); continue; } x -= T_PLE;
        if (x < T_W1) { transpose_tile(P.in[5], 128, 2048, (bf16_t*)(ws + WS_W1CK), (x / 2) * 64, (x % 2) * 64, [](int n) { return n; }, scr); continue; } x -= T_W1;
        if (x < T_W1) { transpose_tile(P.in[8], 128, 2048, (bf16_t*)(ws + WS_W1CV), (x / 2) * 64, (x % 2) * 64, [](int n) { return n; }, scr); continue; } x -= T_W1;
        if (x < T_W2) { transpose_tile(P.in[6], 64, 128, (bf16_t*)(ws + WS_W2CK), x * 64, 0, [](int n) { return n; }, scr); continue; } x -= T_W2;
        if (x < T_W2) { transpose_tile(P.in[9], 64, 128, (bf16_t*)(ws + WS_W2CV), x * 64, 0, [](int n) { return n; }, scr); continue; } x -= T_W2;
        if (x < T_EIN) { const int e = x >> 8, y = x & 255;
            transpose_tile_f8(P.in[17] + (size_t)e * 1024 * 1024, 1024, 1024, ws + WS_WEIN + (size_t)e * 1024 * 1024, (y / 16) * 64, (y % 16) * 64, 16.f, scr); continue; } x -= T_EIN;
        { const int e = x >> 7, y = x & 127;
            transpose_tile_f8(P.in[18] + (size_t)e * 512 * 1024, 1024, 512, ws + WS_WEOUT + (size_t)e * 1024 * 512, (y / 16) * 64, (y % 16) * 64, 16.f, scr); }
    }
    {
        const size_t gtid = (size_t)bid * NTHREADS + tid, gsz = (size_t)G * NTHREADS;
        const float* x = P.in[0]; bf16_t* xb = (bf16_t*)(ws + WS_H1LO);
        for (size_t i = gtid; i < (size_t)T * DM / 8; i += gsz) {
            const f32x4 a = *(const f32x4*)(x + i * 8), b = *(const f32x4*)(x + i * 8 + 4);
            u32x4 o; o.x = pk2(a[0], a[1]); o.y = pk2(a[2], a[3]); o.z = pk2(b[0], b[1]); o.w = pk2(b[2], b[3]);
            *(u32x4*)(xb + i * 8) = o;
        }
        const float* pp = P.in[1]; bf16_t* pb = (bf16_t*)(ws + WS_PB);
        for (size_t i = gtid; i < (size_t)T * 256 / 8; i += gsz) {
            const f32x4 a = *(const f32x4*)(pp + i * 8), b = *(const f32x4*)(pp + i * 8 + 4);
            u32x4 o; o.x = pk2(a[0], a[1]); o.y = pk2(a[2], a[3]); o.z = pk2(b[0], b[1]); o.w = pk2(b[2], b[3]);
            *(u32x4*)(pb + i * 8) = o;
        }
        bf16_t* wrb = (bf16_t*)(ws + WS_WRB);
        for (size_t i = gtid; i < 64 * 3072; i += gsz) {
            const int n = (int)(i / 3072), kk = (int)(i % 3072), k = kk & 1023, seg = kk >> 10;
            float v = 0.f;
            if (n < 4) v = P.in[13][k * 4 + n]; else if (n < 36) v = P.in[15][k * 32 + (n - 4)];
            const bf16_t hi = f2bf(v); const bf16_t lo = f2bf(v - bf2f(hi));
            wrb[i] = (seg == 1) ? lo : hi;
        }
    }
    if (bid == (G > 1 ? 1 : 0) || bid == (G > 2 ? 2 : 0)) {
        for (int which = 0; which < 2; ++which) {
            if (bid != ((which == 0) ? (G > 1 ? 1 : 0) : (G > 2 ? 2 : 0))) continue;
            const float* pe = P.in[which ? 7 : 4]; const float* w1 = P.in[which ? 8 : 5];
            const int n = tid & 127, ks = tid >> 7;
            float s = 0.f;
            for (int k = ks * 512; k < ks * 512 + 512; ++k) s += pe[k] * w1[(size_t)k * 128 + n];
            scr[ks * 128 + n] = s;
            __syncthreads();
            if (tid < 128) ((float*)(ws + WS_BIAS1))[which * 128 + tid] = scr[tid] + scr[128 + tid] + scr[256 + tid] + scr[384 + tid];
            __syncthreads();
        }
    }
    if (bid == 0 && tid < 64) ((int*)(ws + WS_CTL))[tid] = 0;
#ifndef ATOMIC_BENCH
#define ATOMIC_BENCH 0
#endif
#if ATOMIC_BENCH == 1
    { LAS float* fb = (LAS float*)(lds + 65536);
      for (int it = 0; it < 200; ++it) {
#pragma unroll
        for (int k = 0; k < 16; ++k) lds_addf(fb + (k * 512 + tid), 1.0f); } }
#elif ATOMIC_BENCH == 2
    { LAS int* fb = (LAS int*)(lds + 65536);
      for (int it = 0; it < 200; ++it) {
#pragma unroll
        for (int k = 0; k < 16; ++k) (void)__hip_atomic_fetch_add(fb + (k * 512 + tid), 1, __ATOMIC_RELAXED, __HIP_MEMORY_SCOPE_WORKGROUP); } }
#endif
}

struct SchedInproj {
    const bf16_t* xb; const bf16_t* wt; int G, c;
    __device__ __forceinline__ bool next(int i, g8::Unit& u) const {
        if (G == 256) { if (i >= 6) return false; const int qb = i * 8 + (c & 7), k = c >> 3; u.pm = (qb / 3) * 8 + (k & 7); u.pn = (qb % 3) * 4 + (k >> 3); return true; }
        const int L = i * G + c; if (L >= 128 * 12) return false; u.pm = L / 12; u.pn = L % 12; return true; }
    __device__ __forceinline__ const char* a_base(const g8::Unit& u) const { return (const char*)(xb + (size_t)u.pm * 256 * 1024); }
    __device__ __forceinline__ const char* b_base(const g8::Unit& u, int h) const {
        const int row = (u.pn >= 2 && u.pn < 6) ? ((h ? 1024 : 512) + (u.pn - 2) * 128) : (u.pn * 256 + h * 128);
        return (const char*)(wt + (size_t)row * 1024); }
    __device__ __forceinline__ void a_offsets(const g8::Unit&, unsigned (&v)[2][2], int tid) const { g8::natural_offsets(v, 1024, tid); }
};
struct EpiInproj {
    static constexpr bool AFTER_DRAIN = false;
    unsigned char* ws;
    __device__ __forceinline__ void init(g8::Acc& acc, const g8::Unit&, int, int, int, int) const { g8::acc_zero(acc); }
    __device__ __forceinline__ void post_prologue(g8::Acc&) const {}
    __device__ __forceinline__ void operator()(g8::Acc& acc, const g8::Unit& u, int wr, int wc, int fr, int fq) const {
        const int n0 = wc * 32 + 8 * fq;
        const int pn = u.pn;
        if (pn >= 2 && pn < 6) {
#pragma unroll
            for (int ai = 0; ai < 2; ++ai)
#pragma unroll
                for (int m = 0; m < 4; ++m) { const int t = u.pm * 256 + ai * 128 + wr * 64 + m * 16 + fr;
                    *(u32x4*)((bf16_t*)(ws + WS_U) + (size_t)t * 512 + (pn - 2) * 128 + n0) = pk8(acc[ai][0][m][0] * acc[ai][1][m][0], acc[ai][0][m][1] * acc[ai][1][m][1]); }
            return;
        }
#pragma unroll
        for (int bj = 0; bj < 2; ++bj) {
#pragma unroll
            for (int ai = 0; ai < 2; ++ai)
#pragma unroll
                for (int m = 0; m < 4; ++m) { const int t = u.pm * 256 + ai * 128 + wr * 64 + m * 16 + fr; const int b = t >> 13, s_ = t & 8191;
                    const f32x4 v0 = acc[ai][bj][m][0], v1 = acc[ai][bj][m][1];
                    if (pn < 2) *(u32x4*)((bf16_t*)(ws + WS_CB) + (size_t)t * 512 + pn * 256 + bj * 128 + n0) = pk8(v0, v1);
                    else if (pn < 8) *(u32x4*)((bf16_t*)(ws + WS_Q) + (size_t)t * 512 + (pn - 6) * 256 + bj * 128 + n0) = pk8(v0 * QSCALE, v1 * QSCALE);
                    else if (pn == 8) *(u32x4*)((bf16_t*)(ws + (bj ? WS_VC : WS_KC)) + (size_t)t * 128 + n0) = pk8(v0, v1);
                    else if (pn < 11) { const int kvh = n0 >> 6, d = n0 & 63;
                        if (bj == 0) *(u32x4*)((bf16_t*)(ws + (pn == 9 ? WS_KS : WS_KW)) + ((size_t)((b * 2 + kvh) * SEQ + s_)) * 64 + d) = pk8(v0, v1);
                        else { bf16_t* base = (bf16_t*)(ws + (pn == 9 ? WS_VST : WS_VWT)) + ((size_t)((b * 2 + kvh) * 128 + (s_ >> 6)) * 64 + d) * 64 + (s_ & 63);
#pragma unroll
                            for (int c = 0; c < 4; ++c) { base[c * 64] = f2bf(v0[c]); base[(4 + c) * 64] = f2bf(v1[c]); } } }
                    else if (bj == 0 && n0 < 24) { float* gp = (float*)(ws + WS_G) + (size_t)t * 24 + n0;
                        *(f32x4*)gp = (f32x4){sigmoidf_(v0[0]), sigmoidf_(v0[1]), sigmoidf_(v0[2]), sigmoidf_(v0[3])};
                        *(f32x4*)(gp + 4) = (f32x4){sigmoidf_(v1[0]), sigmoidf_(v1[1]), sigmoidf_(v1[2]), sigmoidf_(v1[3])}; }
                }
        }
    }
};
__device__ __forceinline__ void phase_inproj(const Params& P, lds_t* lds) {
    SchedInproj S{(const bf16_t*)(P.ws + WS_H1LO), (const bf16_t*)(P.ws + WS_WIN), (int)gridDim.x, (int)blockIdx.x};
    EpiInproj E{P.ws};
    g8::gemm_phase(lds, 1024, S, E);
}

__device__ __forceinline__ float gelu_tanh(float x) {
    const float u = 0.7978845608028654f * (x + 0.044715f * x * x * x);
    const float e = __expf(2.f * u);
    const float th = 1.f - 2.f / (e + 1.f);
    return 0.5f * x * (1.f + th);
}

__device__ __forceinline__ void phase_conv_compress(const Params& P, lds_t* lds) {
    unsigned char* ws = P.ws;
    int tid = threadIdx.x; asm volatile("" : "+v"(tid));
    const int lane = tid & 63, wid = __builtin_amdgcn_readfirstlane(tid >> 6), r = lane & 15, q = lane >> 4, sc = tid & 7, sr = tid >> 3;
    const int G = gridDim.x;
    const int NCW = G >= 2 ? (G / 2 < 128 ? G / 2 : 128) : 1;
    const bool do_cmp = (int)blockIdx.x < NCW, do_conv = G < 2 || (int)blockIdx.x >= NCW;
    if (do_cmp) for (int tile = blockIdx.x; tile < 128; tile += NCW) {
        const int which = tile >> 6, mt = tile & 63;
        const bf16_t* src = (const bf16_t*)(ws + (which ? WS_VC : WS_KC));
        const bf16_t* w1 = (const bf16_t*)(ws + (which ? WS_W1CV : WS_W1CK));
        const bf16_t* w2 = (const bf16_t*)(ws + (which ? WS_W2CV : WS_W2CK));
        const float* bias1 = (const float*)(ws + WS_BIAS1) + which * 128;
        const bf16_t* ap[1]; const bf16_t* bp[2];
        { const int row = mt * 64 + sr; const int bk = row >> 9; int n = row & 511; if (n > 510) n = 510;
            ap[0] = src + (size_t)((bk >> 1) * SEQ + 16 * n) * 128 + (bk & 1) * 64 + sc * 8; }
#pragma unroll
        for (int i = 0; i < 2; ++i) bp[i] = w1 + (size_t)(sr + 64 * i) * 2048 + sc * 8;
        f32x4 acc[2][2];
        gemm_mainloop<64, 128, 32, 32>(lds, ap, 128, bp, 32, acc);
        const int wm = wid >> 2, wn = wid & 3;
#pragma unroll
        for (int i = 0; i < 2; ++i) { const int m = wm * 32 + i * 16 + r;
#pragma unroll
            for (int j = 0; j < 2; ++j) { const int n = wn * 32 + j * 16 + 4 * q; const f32x4 bv = *(const f32x4*)(bias1 + n); f32x4 v = acc[i][j] + bv;
                v = (f32x4){gelu_tanh(v[0]), gelu_tanh(v[1]), gelu_tanh(v[2]), gelu_tanh(v[3])};
                const int kk = n >> 6, c = (n & 63) >> 3, half = (n & 7) >> 2;
                *(LAS u32x2*)(lds + kk * 8192 + lds_off(m, c) + half * 8) = pk4(v); } }
#pragma unroll
        for (int kk = 0; kk < 2; ++kk) lds_st16(lds + 65536 + kk * 8192 + lds_off(sr, sc), *(const u32x4*)(w2 + (size_t)sr * 128 + kk * 64 + sc * 8));
        __syncthreads();
        f32x4 a2[2] = {(f32x4){0.f, 0.f, 0.f, 0.f}, (f32x4){0.f, 0.f, 0.f, 0.f}};
#pragma unroll
        for (int kk = 0; kk < 2; ++kk)
#pragma unroll
            for (int s = 0; s < 2; ++s) {
                const bf16x8 a = lds_ld16(lds + kk * 8192 + lds_off(16 * (wid >> 1) + r, 4 * s + q));
#pragma unroll
                for (int j = 0; j < 2; ++j) { const bf16x8 bq = lds_ld16(lds + 65536 + kk * 8192 + lds_off((wid & 1) * 32 + j * 16 + r, 4 * s + q)); a2[j] = mfma16(bq, a, a2[j]); }
            }
        { const int row = mt * 64 + 16 * (wid >> 1) + r; const int bk = row >> 9, n = row & 511;
#pragma unroll
            for (int j = 0; j < 2; ++j) { const int d = (wid & 1) * 32 + j * 16 + 4 * q; const f32x4 v = a2[j];
                if (!which) *(u32x2*)((bf16_t*)(ws + WS_KCMP) + (size_t)(bk * 512 + n) * 64 + d) = pk4(v);
                else { bf16_t* base = (bf16_t*)(ws + WS_VCMPT) + ((size_t)((bk * 8 + (n >> 6)) * 64 + d)) * 64 + (n & 63);
                    base[0] = f2bf(v[0]); base[64] = f2bf(v[1]); base[128] = f2bf(v[2]); base[192] = f2bf(v[3]); } } }
        __syncthreads();
    }
    {
        const bf16_t* U = (const bf16_t*)(ws + WS_U); const bf16_t* CB = (const bf16_t*)(ws + WS_CB); bf16_t* Y = (bf16_t*)(ws + WS_RA);
        const float* wc = P.in[3];
        const size_t gtid = (size_t)(G < 2 ? 0 : (int)blockIdx.x - NCW) * NTHREADS + tid, gsz = (size_t)(G < 2 ? 1 : G - NCW) * NTHREADS;
        if (do_conv) for (size_t it = gtid; it < (size_t)T * 64; it += gsz) {
            const int t = (int)(it >> 6), c8 = (int)(it & 63) * 8, s = t & 8191;
            const u32x4 u2 = *(const u32x4*)(U + (size_t)t * 512 + c8);
            u32x4 u1 = (u32x4){0, 0, 0, 0}, u0 = (u32x4){0, 0, 0, 0};
            if (s >= 1) u1 = *(const u32x4*)(U + (size_t)(t - 1) * 512 + c8);
            if (s >= 2) u0 = *(const u32x4*)(U + (size_t)(t - 2) * 512 + c8);
            const u32x4 cb = *(const u32x4*)(CB + (size_t)t * 512 + c8);
            const f32x4 w0a = *(const f32x4*)(wc + c8), w0b = *(const f32x4*)(wc + c8 + 4);
            const f32x4 w1a = *(const f32x4*)(wc + 512 + c8), w1b = *(const f32x4*)(wc + 512 + c8 + 4);
            const f32x4 w2a = *(const f32x4*)(wc + 1024 + c8), w2b = *(const f32x4*)(wc + 1024 + c8 + 4);
            u32x4 o;
#define CONV2(W, IDX, A0, A1) { const float y0 = bflo(cb.W) * (w0##A0[IDX] * bflo(u0.W) + w1##A0[IDX] * bflo(u1.W) + w2##A0[IDX] * bflo(u2.W)); \
                                const float y1 = bfhi(cb.W) * (w0##A1[IDX + 1] * bfhi(u0.W) + w1##A1[IDX + 1] * bfhi(u1.W) + w2##A1[IDX + 1] * bfhi(u2.W)); o.W = pk2(y0, y1); }
            CONV2(x, 0, a, a) CONV2(y, 2, a, a) CONV2(z, 0, b, b) CONV2(w, 2, b, b)
#undef CONV2
            *(u32x4*)(Y + (size_t)t * 1024 + c8) = o;
        }
    }
}

constexpr int L_Q = 0;
constexpr int L_IMP = 32768;
constexpr int L_OST = 32768;
constexpr int OSS = 68;
constexpr int L_MS = 102400;
constexpr int L_LS = 103424;
constexpr int L_RING = 104448;
constexpr int L_SELM = 153600;
constexpr int L_LIST = 154624;
constexpr int L_NJ = 162816;
constexpr int IMPS = 129;

struct QKFrag { bf16x8 k[4][2]; };
struct VFrag { bf16x8 v[4][2]; };

__device__ __forceinline__ float red16_max(float v) { auto t = __builtin_amdgcn_permlane16_swap(__float_as_uint(v), __float_as_uint(v), false, false); return fmaxf(__uint_as_float(t[0]), __uint_as_float(t[1])); }
__device__ __forceinline__ float red32_max(float v) { auto t = __builtin_amdgcn_permlane32_swap(__float_as_uint(v), __float_as_uint(v), false, false); return fmaxf(__uint_as_float(t[0]), __uint_as_float(t[1])); }
__device__ __forceinline__ float red16_sum(float v) { auto t = __builtin_amdgcn_permlane16_swap(__float_as_uint(v), __float_as_uint(v), false, false); return __uint_as_float(t[0]) + __uint_as_float(t[1]); }
__device__ __forceinline__ float red32_sum(float v) { auto t = __builtin_amdgcn_permlane32_swap(__float_as_uint(v), __float_as_uint(v), false, false); return __uint_as_float(t[0]) + __uint_as_float(t[1]); }
__device__ __forceinline__ float rowq_max(float v) { return red32_max(red16_max(v)); }
__device__ __forceinline__ float rowq_sum(float v) { return red32_sum(red16_sum(v)); }
template <int CTRL> __device__ __forceinline__ float dpp_f(float v) { return __int_as_float(__builtin_amdgcn_update_dpp(0, __float_as_int(v), CTRL, 0xf, 0xf, true)); }
template <int CTRL> __device__ __forceinline__ int dpp_i(int v) { return __builtin_amdgcn_update_dpp(0, v, CTRL, 0xf, 0xf, true); }
__device__ __forceinline__ float quad_sum(float v) { v += dpp_f<0xB1>(v); v += dpp_f<0x4E>(v); return v; }

__device__ __forceinline__ void lds_kfrag(QKFrag& f, lds_t* kslot, int r, int q) {
    int o0 = r * 128 + ((q ^ (r >> 1)) << 4); asm volatile("" : "+v"(o0));
#pragma unroll
    for (int nt = 0; nt < 4; ++nt)
#pragma unroll
        for (int s = 0; s < 2; ++s) f.k[nt][s] = lds_ld16(kslot + ((o0 ^ (s << 6)) + nt * 2048));
}
__device__ __forceinline__ void lds_vfrag(VFrag& f, lds_t* vslot, int r, int q) {
    int o0 = r * 128 + ((q & 1) << 3) + (((q >> 1) ^ (r >> 1)) << 4); asm volatile("" : "+v"(o0));
#pragma unroll
    for (int dt = 0; dt < 4; ++dt)
#pragma unroll
        for (int ks = 0; ks < 2; ++ks) {
            const u32x2 lo = *(LAS u32x2*)(vslot + ((o0 ^ (ks << 6)) + dt * 2048));
            const u32x2 hi = *(LAS u32x2*)(vslot + ((o0 ^ (ks << 6) ^ 32) + dt * 2048));
            u32x4 w; w.x = lo.x; w.y = lo.y; w.z = hi.x; w.w = hi.y;
            f.v[dt][ks] = __builtin_bit_cast(bf16x8, w);
        }
}
__device__ __forceinline__ void qk_tile(f32x4 (&st)[4], const QKFrag& f, const bf16x8 (&yq)[2]) {
#pragma unroll
    for (int nt = 0; nt < 4; ++nt) { f32x4 z = (f32x4){0.f, 0.f, 0.f, 0.f}; z = mfma16(f.k[nt][0], yq[0], z); st[nt] = mfma16(f.k[nt][1], yq[1], z); }
}
__device__ __forceinline__ void pv_tile(f32x4 (&o)[4], const VFrag& f, const f32x4 (&p)[4]) {
    bf16x8 pf[2];
#pragma unroll
    for (int ks = 0; ks < 2; ++ks) { u32x4 w; w.x = pk2(p[2 * ks][0], p[2 * ks][1]); w.y = pk2(p[2 * ks][2], p[2 * ks][3]); w.z = pk2(p[2 * ks + 1][0], p[2 * ks + 1][1]); w.w = pk2(p[2 * ks + 1][2], p[2 * ks + 1][3]);
        pf[ks] = __builtin_bit_cast(bf16x8, w); }
#pragma unroll
    for (int dt = 0; dt < 4; ++dt) { o[dt] = mfma16(f.v[dt][0], pf[0], o[dt]); o[dt] = mfma16(f.v[dt][1], pf[1], o[dt]); }
}
constexpr float SM_THR = 8.f;
__device__ __forceinline__ void qk_tile_c(f32x4 (&st)[4], const QKFrag& f, const bf16x8 (&yq)[2], f32x4 cinit) {
#pragma unroll
    for (int nt = 0; nt < 4; ++nt) { f32x4 z = mfma16(f.k[nt][0], yq[0], cinit); st[nt] = mfma16(f.k[nt][1], yq[1], z); }
}
__device__ __forceinline__ float max16(const f32x4 (&st)[4]) {
    float a = fmaxf(fmaxf(st[0][0], st[0][1]), fmaxf(st[0][2], st[0][3]));
#pragma unroll
    for (int nt = 1; nt < 4; ++nt) a = fmaxf(a, fmaxf(fmaxf(st[nt][0], st[nt][1]), fmaxf(st[nt][2], st[nt][3])));
    return a;
}
__device__ __forceinline__ void mask16(f32x4 (&st)[4], int lo, int hi) {
#pragma unroll
    for (int nt = 0; nt < 4; ++nt)
#pragma unroll
        for (int c = 0; c < 4; ++c) { const int kc_ = 16 * nt + c; if (!((kc_ <= hi) && (kc_ > lo))) st[nt][c] = -1e30f; }
}
__device__ __forceinline__ void softmax_first(float& m, float& l, f32x4& negm, f32x4 (&st)[4]) {
    const float mx = rowq_max(max16(st));
    m = (mx > -1e29f) ? mx : 0.f; negm = (f32x4){-m, -m, -m, -m};
    float ps = 0.f;
#pragma unroll
    for (int nt = 0; nt < 4; ++nt)
#pragma unroll
        for (int c = 0; c < 4; ++c) { const float pp = fexp2(st[nt][c] - m); st[nt][c] = pp; ps += pp; }
    l = ps;
}
template <bool HAS_O>
__device__ __forceinline__ void softmax_next(float& m, float& l, f32x4& negm, f32x4 (&o)[4], f32x4 (&st)[4]) {
    const float mxl = max16(st);
    if (__builtin_amdgcn_ballot_w64(mxl > SM_THR) != 0ull) {
        const float mx = rowq_max(mxl); const float sh = (mx > SM_THR) ? mx : 0.f; const float a = fexp2(-sh);
        m += sh; l *= a; negm = (f32x4){-m, -m, -m, -m};
        if (HAS_O) {
#pragma unroll
            for (int d = 0; d < 4; ++d) o[d] = o[d] * a; }
#pragma unroll
        for (int nt = 0; nt < 4; ++nt)
#pragma unroll
            for (int c = 0; c < 4; ++c) st[nt][c] -= sh;
    }
    float ps = 0.f;
#pragma unroll
    for (int nt = 0; nt < 4; ++nt)
#pragma unroll
        for (int c = 0; c < 4; ++c) { const float pp = fexp2(st[nt][c]); st[nt][c] = pp; ps += pp; }
    l += ps;
}

__device__ __forceinline__ void phase_nsa(const Params& P, lds_t* lds) {
    unsigned char* ws = P.ws;
    const int wid = __builtin_amdgcn_readfirstlane(threadIdx.x >> 6);
    const int G = gridDim.x, g = blockIdx.x;
#define NSA_TID int tid = threadIdx.x; asm volatile("" : "+v"(tid));
#define NSA_LANE_VARS int lane_ = threadIdx.x & 63; asm volatile("" : "+v"(lane_)); const int r = lane_ & 15, q = lane_ >> 4;
    const bf16_t* Qb = (const bf16_t*)(ws + WS_Q);
    const float* GT = (const float*)(ws + WS_G);
    bf16_t* Y = (bf16_t*)(ws + WS_RA);
    LAS float* IMPA = (LAS float*)(lds + L_IMP);
    LAS float* IMPB = (LAS float*)(lds + L_IMP + 64 * IMPS * 4);
    LAS unsigned* SELM = (LAS unsigned*)(lds + L_SELM);
    LAS unsigned char* LIST = (LAS unsigned char*)(lds + L_LIST);
    LAS unsigned char* NJ = (LAS unsigned char*)(lds + L_NJ);
    const f32x4 NEGBIG = (f32x4){-1e30f, -1e30f, -1e30f, -1e30f};
    const f32x4 ZERO4 = (f32x4){0.f, 0.f, 0.f, 0.f};

    const int GQ = G >> 3;
    for (int k = 0;; ++k) {
        int jt, bk;
        if ((G & 7) == 0 && GQ > 0) { const int gi = g >> 3; const int u = (k & 1) ? (k + 1) * GQ - 1 - gi : k * GQ + gi; if (k * GQ >= 128) break; if (u >= 128) continue; jt = 127 - u; bk = g & 7; }
        else { const int idx = k * G + g; if (idx >= 1024) break; jt = 127 - (idx >> 3); bk = idx & 7; }
        const int b = bk >> 1, kvh = bk & 1, t0 = jt * 64;
        { NSA_TID
#pragma unroll
        for (int i = 0; i < 4; ++i) { const int row = (tid >> 3) + 64 * i, c = tid & 7, tok = row >> 2, hh = row & 3;
            lds_st16(lds + L_Q + lds_off(row, c), *(const u32x4*)(Qb + (size_t)(b * SEQ + t0 + tok) * 512 + kvh * 256 + hh * 64 + c * 8)); }
        if (tid < 256) SELM[tid] = 0u; }
        __syncthreads();
#define NSA_GATE(h_, br_) (GT[(size_t)(b * SEQ + t0 + ((32 * wid + 16 * (h_) + r) >> 2)) * 24 + (kvh * 4 + (r & 3)) * 3 + (br_)])
        { NSA_LANE_VARS NSA_TID
            const int nblk = (4 * jt + 3 + 63) >> 6;
            const int nfull = 4 * jt - 2;
            const unsigned goff = (unsigned)tid * 16u;
            const unsigned char* kcb = ws + WS_KCMP + (size_t)bk * 65536;
            const unsigned char* vcb = ws + WS_VCMPT + (size_t)bk * 65536;
            const int stw = lds_off(tid >> 3, tid & 7);
            bf16x8 yq[2][2]; int nlim[2]; float cm[2] = {0.f, 0.f}, cl[2] = {0.f, 0.f}; f32x4 negm[2] = {ZERO4, ZERO4};
#pragma unroll
            for (int h = 0; h < 2; ++h) { const int qrow = 32 * wid + 16 * h + r; nlim[h] = (t0 + (qrow >> 2) - 31) >> 4;
#pragma unroll
                for (int s = 0; s < 2; ++s) yq[h][s] = lds_ld16(lds + L_Q + lds_off(qrow, 4 * s + q)); }
            {
                u32x4 pk_ = *(const u32x4*)(kcb + goff);
#pragma unroll 1
                for (int blk = 0; blk < nblk; ++blk) {
                    lds_t* slot = lds + L_RING + (blk & 1) * 16384;
                    lds_st16(slot + stw, pk_);
                    if (blk + 1 < nblk) pk_ = *(const u32x4*)(kcb + (size_t)(blk + 1) * 8192 + goff);
                    __syncthreads();
                    QKFrag kf; lds_kfrag(kf, slot, r, q);
                    const bool edge = (64 * blk + 63 > nfull);
#pragma unroll
                    for (int h = 0; h < 2; ++h) {
                        f32x4 st[4], dummy[4];
                        if (blk == 0) { qk_tile_c(st, kf, yq[h], ZERO4); if (edge) mask16(st, -1000, nlim[h] - 4 * q); softmax_first(cm[h], cl[h], negm[h], st); }
                        else { qk_tile_c(st, kf, yq[h], negm[h]); if (edge) mask16(st, -1000, nlim[h] - 64 * blk - 4 * q); softmax_next<false>(cm[h], cl[h], negm[h], dummy, st); }
                    }
                }
            }
            float cil[2];
#pragma unroll
            for (int h = 0; h < 2; ++h) { const float l = rowq_sum(cl[h]); cil[h] = l > 0.f ? 1.f / l : 0.f; }
            __syncthreads();
            f32x4 oc[2][4];
#pragma unroll
            for (int h = 0; h < 2; ++h)
#pragma unroll
                for (int d = 0; d < 4; ++d) oc[h][d] = ZERO4;
            {
                u32x4 pk_ = *(const u32x4*)(kcb + goff), pv_ = *(const u32x4*)(vcb + goff);
#pragma unroll 1
                for (int blk = 0; blk < nblk; ++blk) {
                    lds_t* slot = lds + L_RING + (blk & 1) * 16384;
                    lds_st16(slot + stw, pk_); lds_st16(slot + 8192 + stw, pv_);
                    if (blk + 1 < nblk) { pk_ = *(const u32x4*)(kcb + (size_t)(blk + 1) * 8192 + goff); pv_ = *(const u32x4*)(vcb + (size_t)(blk + 1) * 8192 + goff); }
                    __syncthreads();
                    QKFrag kf; lds_kfrag(kf, slot, r, q);
                    const bool edge = (64 * blk + 63 > nfull);
                    f32x4 st[2][4];
#pragma unroll
                    for (int h = 0; h < 2; ++h) {
                        qk_tile_c(st[h], kf, yq[h], negm[h]);
                        if (edge) mask16(st[h], -1000, nlim[h] - 64 * blk - 4 * q);
                        const int tok = (32 * wid + 16 * h + r) >> 2;
#pragma unroll
                        for (int nt = 0; nt < 4; ++nt) {
#pragma unroll
                            for (int c = 0; c < 4; ++c) st[h][nt][c] = fexp2(st[h][nt][c]);
                            const float s4 = quad_sum(((st[h][nt][0] + st[h][nt][1]) + (st[h][nt][2] + st[h][nt][3])) * cil[h]), p3 = quad_sum(st[h][nt][3] * cil[h]);
                            if ((r & 3) == 0) { const int jj = 16 * blk + 4 * nt + q; IMPA[tok * IMPS + jj] = s4; IMPB[tok * IMPS + jj + 1] = p3; }
                        }
                    }
                    VFrag vf; lds_vfrag(vf, slot + 8192, r, q);
#pragma unroll
                    for (int h = 0; h < 2; ++h) pv_tile(oc[h], vf, st[h]);
                }
            }
#pragma unroll
            for (int h = 0; h < 2; ++h) { const int tok = (32 * wid + 16 * h + r) >> 2;
                bf16_t* yp = Y + (size_t)(b * SEQ + t0 + tok) * 1024 + 512 + (kvh * 4 + (r & 3)) * 64 + 4 * q;
                const float sc_ = NSA_GATE(h, 0) * cil[h];
#pragma unroll
                for (int d = 0; d < 4; ++d) *(u32x2*)(yp + 16 * d) = pk4(oc[h][d] * sc_); }
        }
        __syncthreads();
        const bool dense_all = (jt < 16);
        if (!dense_all) {
        { NSA_TID
            const int tok = tid >> 3, sub = tid & 7;
            unsigned flags = 0;
            {
                unsigned key[16];
#pragma unroll
                for (int i = 0; i < 16; ++i) { const int j = sub * 16 + i; const bool valid = (j >= 1 && j <= jt - 2);
                    const float v = IMPA[tok * IMPS + j] + IMPB[tok * IMPS + j]; key[i] = valid ? ((__float_as_uint(v) & 0xFFFFFF80u) | (unsigned)(127 - j)) : 0u; }
                unsigned tau = 0;
#pragma unroll 1
                for (int bit = 30; bit >= 0; --bit) {
                    const unsigned cand = tau | (1u << bit); int cnt = 0;
#pragma unroll
                    for (int i = 0; i < 16; ++i) cnt += (key[i] >= cand) ? 1 : 0;
                    cnt += dpp_i<0xB1>(cnt); cnt += dpp_i<0x4E>(cnt); cnt += dpp_i<0x141>(cnt);
                    if (cnt >= 13) tau = cand;
                }
#pragma unroll
                for (int i = 0; i < 16; ++i) if (key[i] != 0u && key[i] >= tau) flags |= 1u << i;
            }
#pragma unroll
            for (int i = 0; i < 16; ++i) if (flags & (1u << i)) lds_oru(&SELM[(sub * 16 + i) * 2 + (tok >> 5)], 1u << (tok & 31));
        }
        __syncthreads();
        { NSA_TID
            LAS unsigned short* LISTP = (LAS unsigned short*)(lds + L_LIST);
            const int p = tid >> 3, cls = tid & 7;
            if (p < 43 && cls < 7) {
                const int j0 = 1 + 3 * p;
                const unsigned long long A = ((unsigned long long)SELM[j0 * 2 + 1] << 32) | SELM[j0 * 2];
                const unsigned long long B = (j0 + 1 < 128) ? (((unsigned long long)SELM[(j0 + 1) * 2 + 1] << 32) | SELM[(j0 + 1) * 2]) : 0ull;
                const unsigned long long C = (j0 + 2 < 128) ? (((unsigned long long)SELM[(j0 + 2) * 2 + 1] << 32) | SELM[(j0 + 2) * 2]) : 0ull;
                int pos = 0; unsigned long long mine = 0ull; unsigned mkv = 0u;
#define NSA_CLS(K, M, V) { const unsigned long long cm_ = (M); if (cls > (K)) pos += __popcll(cm_); if (cls == (K)) { mine = cm_; mkv = (V); } }
                NSA_CLS(0, A & B & C, 7u) NSA_CLS(1, A & ~B & C, 5u) NSA_CLS(2, A & ~B & ~C, 1u) NSA_CLS(3, A & B & ~C, 3u) NSA_CLS(4, ~A & B & ~C, 2u) NSA_CLS(5, ~A & B & C, 6u) NSA_CLS(6, ~A & ~B & C, 4u)
#undef NSA_CLS
                while (mine) { const int t = __ffsll((long long)mine) - 1; LISTP[p * 64 + pos] = (unsigned short)((unsigned)t | (mkv << 8)); ++pos; mine &= mine - 1; }
                if (cls == 6) NJ[p] = (unsigned char)__popcll(A | B | C);
            }
        }
        __syncthreads();
        }
        { NSA_LANE_VARS NSA_TID
            const int nf = dense_all ? jt + 1 : 3;
            const int jb0 = jt >= 8 ? jt - 8 : 0, nb = jt - jb0 + 1, nd = nf + nb;
            const unsigned goff = (unsigned)tid * 16u;
            const unsigned char* ksb = ws + WS_KS + (size_t)bk * 1048576;
            const unsigned char* vsb = ws + WS_VST + (size_t)bk * 1048576;
            const unsigned char* kwb = ws + WS_KW + (size_t)bk * 1048576;
            const unsigned char* vwb = ws + WS_VWT + (size_t)bk * 1048576;
            const int stw = lds_off(tid >> 3, tid & 7);
            bf16x8 yq[2][2]; float wm_[2] = {0.f, 0.f}, wl[2] = {0.f, 0.f}, sm_[2] = {0.f, 0.f}, sl[2] = {0.f, 0.f};
            f32x4 ow[2][4], os[2][4], negw[2] = {ZERO4, ZERO4}, negs[2] = {ZERO4, ZERO4};
#pragma unroll
            for (int h = 0; h < 2; ++h) { const int qrow = 32 * wid + 16 * h + r;
#pragma unroll
                for (int s = 0; s < 2; ++s) yq[h][s] = lds_ld16(lds + L_Q + lds_off(qrow, 4 * s + q));
#pragma unroll
                for (int d = 0; d < 4; ++d) { ow[h][d] = ZERO4; os[h][d] = ZERO4; } }
            auto item_blk = [&](int i) -> int { return i < nf ? (dense_all ? i : (i == 0 ? 0 : jt - 2 + i)) : jb0 + (i - nf); };
            u32x4 pk0, pv0;
            { const int j = item_blk(0); pk0 = *(const u32x4*)(ksb + (size_t)j * 8192 + goff); pv0 = *(const u32x4*)(vsb + (size_t)j * 8192 + goff); }
            auto dense_item = [&](lds_t* slot, float (&m)[2], float (&l)[2], f32x4 (&negm)[2], f32x4 (&o)[2][4], bool first, bool dhi, bool dlo) {
                QKFrag kf; lds_kfrag(kf, slot, r, q);
                f32x4 st[2][4];
                const bool edge = dhi || dlo;
#pragma unroll
                for (int h = 0; h < 2; ++h) {
                    const int tok = (32 * wid + 16 * h + r) >> 2;
                    const int hi = dhi ? (tok - 4 * q) : 1000, lo = dlo ? (tok - 4 * q) : -1000;
                    if (first) { qk_tile_c(st[h], kf, yq[h], ZERO4); if (edge) mask16(st[h], lo, hi); softmax_first(m[h], l[h], negm[h], st[h]); }
                    else { qk_tile_c(st[h], kf, yq[h], negm[h]); if (edge) mask16(st[h], lo, hi); softmax_next<true>(m[h], l[h], negm[h], o[h], st[h]); }
                }
                VFrag vf; lds_vfrag(vf, slot + 8192, r, q);
#pragma unroll
                for (int h = 0; h < 2; ++h) pv_tile(o[h], vf, st[h]);
            };
#pragma unroll 1
            for (int i = 0; i < nd; ++i) {
                lds_t* slot = lds + L_RING + (i & 1) * 16384;
                lds_st16(slot + stw, pk0); lds_st16(slot + 8192 + stw, pv0);
                if (i + 1 < nd) { const int j = item_blk(i + 1); const bool sn = (i + 1 < nf);
                    pk0 = *(const u32x4*)((sn ? ksb : kwb) + (size_t)j * 8192 + goff); pv0 = *(const u32x4*)((sn ? vsb : vwb) + (size_t)j * 8192 + goff); }
                __syncthreads();
                const int j = item_blk(i);
                if (i < nf) dense_item(slot, sm_, sl, negs, os, i == 0, j == jt, false);
                else dense_item(slot, wm_, wl, negw, ow, i == nf, j == jt, j == jt - 8);
            }
#pragma unroll
            for (int h = 0; h < 2; ++h) { const int qrow = 32 * wid + 16 * h + r; const int tok = qrow >> 2; const float l = rowq_sum(wl[h]); const float il = l > 0.f ? NSA_GATE(h, 2) / l : 0.f;
                bf16_t* yp = Y + (size_t)(b * SEQ + t0 + tok) * 1024 + 512 + (kvh * 4 + (r & 3)) * 64 + 4 * q;
#pragma unroll
                for (int d = 0; d < 4; ++d) { const u32x2 w = *(const u32x2*)(yp + 16 * d); f32x4 v = ow[h][d] * il; v[0] += bflo(w.x); v[1] += bfhi(w.x); v[2] += bflo(w.y); v[3] += bfhi(w.y); *(u32x2*)(yp + 16 * d) = pk4(v); }
                const float ls = rowq_sum(sl[h]);
                LAS float* orow = (LAS float*)(lds + L_OST) + qrow * OSS + 4 * q;
#pragma unroll
                for (int d = 0; d < 4; ++d) *(LAS f32x4*)(orow + 16 * d) = os[h][d];
                if (q == 0) { ((LAS float*)(lds + L_MS))[qrow] = sm_[h]; ((LAS float*)(lds + L_LS))[qrow] = ls; } }
        }
        __syncthreads();
        { NSA_LANE_VARS NSA_TID
            LAS float* MS = (LAS float*)(lds + L_MS); LAS float* LS = (LAS float*)(lds + L_LS);
            if (!dense_all) {
            const unsigned goff = (unsigned)tid * 16u;
            const unsigned char* ksb = ws + WS_KS + (size_t)bk * 1048576;
            const unsigned char* vsb = ws + WS_VST + (size_t)bk * 1048576;
            const int stw = lds_off(tid >> 3, tid & 7);
            const int jlast = jt - 2, nstep = jt / 3;
            const LAS unsigned short* LISTP = (const LAS unsigned short*)(lds + L_LIST);
            u32x4 pk[3], pv[3];
#pragma unroll
            for (int x = 0; x < 3; ++x) { const int jb = 1 + x < jlast ? 1 + x : jlast; pk[x] = *(const u32x4*)(ksb + (size_t)jb * 8192 + goff); pv[x] = *(const u32x4*)(vsb + (size_t)jb * 8192 + goff); }
#pragma unroll 1
            for (int p = 0; p < nstep; ++p) {
#pragma unroll
                for (int x = 0; x < 3; ++x) { lds_st16(lds + L_RING + x * 16384 + stw, pk[x]); lds_st16(lds + L_RING + x * 16384 + 8192 + stw, pv[x]); }
                if (p + 1 < nstep) {
#pragma unroll
                    for (int x = 0; x < 3; ++x) { int jb = 3 * p + 4 + x; jb = jb < jlast ? jb : jlast; pk[x] = *(const u32x4*)(ksb + (size_t)jb * 8192 + goff); pv[x] = *(const u32x4*)(vsb + (size_t)jb * 8192 + goff); } }
                __syncthreads();
                const int np = __builtin_amdgcn_readfirstlane((int)NJ[p]); const int nch = (np + 3) >> 2;
                const int c1 = (wid + 8 - (p & 7)) & 7;
#pragma unroll 1
                for (int c = c1; c < nch; c = (c < 8 ? 15 - c : 16)) {
                    const int ix = 4 * c + (r >> 2); const bool valid = ix < np;
                    const unsigned ent = LISTP[p * 64 + (valid ? ix : 0)];
                    const int tok = (int)(ent & 63u); const unsigned mk = valid ? (ent >> 8) : 0u;
                    const int qrow = tok * 4 + (r & 3);
                    bf16x8 yy[2];
#pragma unroll
                    for (int s2 = 0; s2 < 2; ++s2) yy[s2] = lds_ld16(lds + L_Q + lds_off(qrow, 4 * s2 + q));
                    float mref = MS[qrow];
                    LAS float* orow = (LAS float*)(lds + L_OST) + qrow * OSS + 4 * q;
                    f32x4 o[4]; float lacc = 0.f, asc = 1.f;
#pragma unroll
                    for (int d = 0; d < 4; ++d) o[d] = *(LAS f32x4*)(orow + 16 * d);
#pragma unroll
                    for (int x = 0; x < 3; ++x) {
                        const bool sel = ((mk >> x) & 1u) != 0u;
                        if (__builtin_amdgcn_ballot_w64(sel) == 0ull) continue;
                        lds_t* kslot = lds + L_RING + x * 16384;
                        QKFrag kf; lds_kfrag(kf, kslot, r, q);
                        VFrag vf; lds_vfrag(vf, kslot + 8192, r, q);
                        f32x4 st[4];
                        const f32x4 cin = sel ? (f32x4){-mref, -mref, -mref, -mref} : NEGBIG;
                        qk_tile_c(st, kf, yy, cin);
                        const float mxl = max16(st);
                        if (__builtin_amdgcn_ballot_w64(mxl > SM_THR) != 0ull) {
                            const float mx = rowq_max(mxl); const float sh = (mx > SM_THR) ? mx : 0.f; const float a = fexp2(-sh);
                            mref += sh; asc *= a; lacc *= a;
#pragma unroll
                            for (int d = 0; d < 4; ++d) o[d] = o[d] * a;
#pragma unroll
                            for (int nt = 0; nt < 4; ++nt)
#pragma unroll
                                for (int cc = 0; cc < 4; ++cc) st[nt][cc] -= sh;
                        }
                        float ps = 0.f;
#pragma unroll
                        for (int nt = 0; nt < 4; ++nt)
#pragma unroll
                            for (int cc = 0; cc < 4; ++cc) { const float pp = fexp2(st[nt][cc]); st[nt][cc] = pp; ps += pp; }
                        lacc += ps;
                        pv_tile(o, vf, st);
                    }
                    lacc = rowq_sum(lacc);
                    if (valid) {
#pragma unroll
                        for (int d = 0; d < 4; ++d) *(LAS f32x4*)(orow + 16 * d) = o[d];
                        if (q == 0) { LS[qrow] = LS[qrow] * asc + lacc; MS[qrow] = mref; } }
                }
                __syncthreads();
            }
            }
#pragma unroll
            for (int h = 0; h < 2; ++h) { const int qrow = 32 * wid + 16 * h + r; const int tok = qrow >> 2;
                const float l = LS[qrow]; const float il = l > 0.f ? NSA_GATE(h, 1) / l : 0.f;
                const LAS float* orow = (LAS float*)(lds + L_OST) + qrow * OSS + 4 * q;
                bf16_t* yp = Y + (size_t)(b * SEQ + t0 + tok) * 1024 + 512 + (kvh * 4 + (r & 3)) * 64 + 4 * q;
#pragma unroll
                for (int d = 0; d < 4; ++d) { const u32x2 w = *(const u32x2*)(yp + 16 * d); f32x4 v = *(const LAS f32x4*)(orow + 16 * d) * il; v[0] += bflo(w.x); v[1] += bfhi(w.x); v[2] += bflo(w.y); v[3] += bfhi(w.y); *(u32x2*)(yp + 16 * d) = pk4(v); } }
        }
        __syncthreads();
    }
#ifdef STEP_BENCH
    {
        const int tid = threadIdx.x; const unsigned goff = (unsigned)tid * 16u;
        const unsigned char* ksb = ws + WS_KS + (size_t)(blockIdx.x & 7) * 1048576;
        const int stw = lds_off(tid >> 3, tid & 7);
        u32x4 pkA = *(const u32x4*)(ksb + goff), pvA = *(const u32x4*)(ksb + 8192 + goff);
        int slot_c = 0;
        for (int j = 0; j < STEP_BENCH; ++j) {
            const int slot_n = (slot_c == 2) ? 0 : slot_c + 1;
            lds_st16(lds + L_RING + slot_n * 16384 + stw, pkA); lds_st16(lds + L_RING + slot_n * 16384 + 8192 + stw, pvA);
            pkA = *(const u32x4*)(ksb + (size_t)((j + 2) & 127) * 8192 + goff); pvA = *(const u32x4*)(ksb + (size_t)((j + 3) & 127) * 8192 + goff);
            __syncthreads();
            slot_c = slot_n;
        }
        if (pkA.x == 0x12345678u && pvA.y == 0x9abcdef0u) ((unsigned*)(ws + WS_CTL))[100] = 1;
        __syncthreads();
    }
#endif
#undef NSA_LANE_VARS
#undef NSA_TID
#undef NSA_GATE
}

__device__ __forceinline__ float wave_sum(float v) {
    v += dpp_f<0xB1>(v); v += dpp_f<0x4E>(v); v += dpp_f<0x141>(v); v += dpp_f<0x140>(v);
    return red32_sum(red16_sum(v));
}
__device__ __forceinline__ void ln_row(f32x4 (&v)[4], const f32x4 (&g)[4], const f32x4 (&bt)[4]) {
    float s = 0.f;
#pragma unroll
    for (int j = 0; j < 4; ++j) s += (v[j][0] + v[j][1]) + (v[j][2] + v[j][3]);
    const float mean = wave_sum(s) * (1.f / 1024.f);
    float ss = 0.f;
#pragma unroll
    for (int j = 0; j < 4; ++j) { v[j] = v[j] - mean; ss += (v[j][0] * v[j][0] + v[j][1] * v[j][1]) + (v[j][2] * v[j][2] + v[j][3] * v[j][3]); }
    const float rstd = rsqrtf(wave_sum(ss) * (1.f / 1024.f) + LN_EPS);
#pragma unroll
    for (int j = 0; j < 4; ++j) v[j] = v[j] * rstd * g[j] + bt[j];
}
__device__ __forceinline__ void split_store(bf16_t* hi, bf16_t* lo, f32x4 h) {
    const u32x2 ph = pk4(h);
    f32x4 res; res[0] = h[0] - bflo(ph.x); res[1] = h[1] - bfhi(ph.x); res[2] = h[2] - bflo(ph.y); res[3] = h[3] - bfhi(ph.y);
    *(u32x2*)hi = ph; *(u32x2*)lo = pk4(res);
}
__device__ __forceinline__ f32x4 split_load(const bf16_t* hi, const bf16_t* lo) {
    const u32x2 a = *(const u32x2*)hi, b = *(const u32x2*)lo;
    return (f32x4){bflo(a.x) + bflo(b.x), bfhi(a.x) + bfhi(b.x), bflo(a.y) + bflo(b.y), bfhi(a.y) + bfhi(b.y)};
}

__device__ __forceinline__ void panel_ln_stats(const f32x4 (&val)[8][4], int mt, int ct, unsigned* cnt, unsigned long long* xch, lds_t* scr, int wr, int wc, int r, int q) {
    LAS f32x2* Pp = (LAS f32x2*)scr;
    LAS f32x2* Ss = (LAS f32x2*)(scr + 8192);
    LAS unsigned* flag = (LAS unsigned*)(scr + 8192 + 2048);
    const int tid = threadIdx.x;
#pragma unroll
    for (int i = 0; i < 8; ++i) {
        float sacc = 0.f, sq = 0.f;
#pragma unroll
        for (int j = 0; j < 4; ++j) { const f32x4 v = val[i][j]; sacc += (v[0] + v[1]) + (v[2] + v[3]); sq += (v[0] * v[0] + v[1] * v[1]) + (v[2] * v[2] + v[3] * v[3]); }
        sacc = rowq_sum(sacc); sq = rowq_sum(sq);
        const float mw = sacc * (1.f / 64.f);
        if (q == 0) Pp[(wr * 128 + i * 16 + r) * 4 + wc] = (f32x2){mw, fmaxf(sq - sacc * mw, 0.f)};
        asm volatile("" ::: "memory");
    }
    __syncthreads();
    if (tid < 256) {
        const f32x2 a = Pp[tid * 4 + 0], b = Pp[tid * 4 + 1], c = Pp[tid * 4 + 2], d = Pp[tid * 4 + 3];
        const float m4 = (a.x + b.x + c.x + d.x) * 0.25f;
        const float da = a.x - m4, db = b.x - m4, dc = c.x - m4, dd = d.x - m4;
        const float m2 = (a.y + b.y) + (c.y + d.y) + 64.0f * ((da * da + db * db) + (dc * dc + dd * dd));
        __hip_atomic_store(xch + ((size_t)(mt * 256 + tid) * 4 + ct), ((unsigned long long)__float_as_uint(m2) << 32) | __float_as_uint(m4), __ATOMIC_RELAXED, __HIP_MEMORY_SCOPE_AGENT);
    }
    asm volatile("s_waitcnt vmcnt(0)" ::: "memory");
    __syncthreads();
    if (tid < 64) {
        if (tid == 0) __hip_atomic_fetch_add(cnt + 64 * mt, 1u, __ATOMIC_RELAXED, __HIP_MEMORY_SCOPE_AGENT);
        unsigned spins = 0;
        while ((unsigned)__builtin_amdgcn_readfirstlane(__hip_atomic_load(cnt + 64 * mt, __ATOMIC_RELAXED, __HIP_MEMORY_SCOPE_AGENT)) < 4u) { __builtin_amdgcn_s_sleep(2); if (++spins > (1u << 22)) break; }
        __builtin_amdgcn_fence(__ATOMIC_ACQUIRE, "agent");
        if (tid == 0) flag[0] = 1u;
    }
    asm volatile("s_waitcnt vmcnt(0) lgkmcnt(0)" ::: "memory");
    __syncthreads();
    if (tid < 256) {
        const unsigned long long* sl = xch + (size_t)(mt * 256 + tid) * 4; float mm[4], m2[4], ms = 0.f;
#pragma unroll
        for (int t = 0; t < 4; ++t) { const unsigned long long w = __hip_atomic_load(sl + t, __ATOMIC_RELAXED, __HIP_MEMORY_SCOPE_AGENT); mm[t] = __uint_as_float((unsigned)w); m2[t] = __uint_as_float((unsigned)(w >> 32)); ms += mm[t]; }
        const float mean = ms * 0.25f; float qq = 0.f;
#pragma unroll
        for (int t = 0; t < 4; ++t) { const float dm = mm[t] - mean; qq += m2[t] + 256.0f * dm * dm; }
        Ss[tid] = (f32x2){mean, rsqrtf(qq * (1.f / 1024.f) + LN_EPS)};
    }
    __syncthreads();
}

__device__ __forceinline__ void panel_ln_stats8(const g8::Acc& v, int mt, int ct, unsigned* cnt, unsigned long long* xch, lds_t* scr, int wr, int wc, int fr, int fq) {
    LAS f32x2* Pp = (LAS f32x2*)scr;
    LAS f32x2* Ss = (LAS f32x2*)(scr + 8192);
    const int tid = threadIdx.x;
#pragma unroll
    for (int ai = 0; ai < 2; ++ai)
#pragma unroll
        for (int m = 0; m < 4; ++m) {
            float sacc = 0.f;
#pragma unroll
            for (int bj = 0; bj < 2; ++bj)
#pragma unroll
                for (int n = 0; n < 2; ++n) { const f32x4 x = v[ai][bj][m][n]; sacc += (x[0] + x[1]) + (x[2] + x[3]); }
            sacc = rowq_sum(sacc);
            const float mw = sacc * (1.f / 64.f); float sq = 0.f;
#pragma unroll
            for (int bj = 0; bj < 2; ++bj)
#pragma unroll
                for (int n = 0; n < 2; ++n) { const f32x4 d = v[ai][bj][m][n] - mw; sq += (d[0] * d[0] + d[1] * d[1]) + (d[2] * d[2] + d[3] * d[3]); }
            sq = rowq_sum(sq);
            if (fq == 0) Pp[(ai * 128 + wr * 64 + m * 16 + fr) * 4 + wc] = (f32x2){mw, sq};
        }
    __syncthreads();
    if (tid < 256) {
        const f32x2 a = Pp[tid * 4 + 0], b = Pp[tid * 4 + 1], c = Pp[tid * 4 + 2], d = Pp[tid * 4 + 3];
        const float m4 = (a.x + b.x + c.x + d.x) * 0.25f;
        const float da = a.x - m4, db = b.x - m4, dc = c.x - m4, dd = d.x - m4;
        const float m2 = (a.y + b.y) + (c.y + d.y) + 64.0f * ((da * da + db * db) + (dc * dc + dd * dd));
        __hip_atomic_store(xch + ((size_t)(mt * 256 + tid) * 4 + ct), ((unsigned long long)__float_as_uint(m2) << 32) | __float_as_uint(m4), __ATOMIC_RELAXED, __HIP_MEMORY_SCOPE_AGENT);
    }
    asm volatile("s_waitcnt vmcnt(0)" ::: "memory");
    __syncthreads();
    if (tid < 64) {
        if (tid == 0) __hip_atomic_fetch_add(cnt + 64 * mt, 1u, __ATOMIC_RELAXED, __HIP_MEMORY_SCOPE_AGENT);
        unsigned spins = 0;
        while ((unsigned)__builtin_amdgcn_readfirstlane(__hip_atomic_load(cnt + 64 * mt, __ATOMIC_RELAXED, __HIP_MEMORY_SCOPE_AGENT)) < 4u) { __builtin_amdgcn_s_sleep(2); if (++spins > (1u << 22)) break; }
        __builtin_amdgcn_fence(__ATOMIC_ACQUIRE, "agent");
    }
    asm volatile("s_waitcnt vmcnt(0) lgkmcnt(0)" ::: "memory");
    __syncthreads();
    if (tid < 256) {
        const unsigned long long* sl = xch + (size_t)(mt * 256 + tid) * 4; float mm[4], m2[4], ms = 0.f;
#pragma unroll
        for (int t = 0; t < 4; ++t) { const unsigned long long w = __hip_atomic_load(sl + t, __ATOMIC_RELAXED, __HIP_MEMORY_SCOPE_AGENT); mm[t] = __uint_as_float((unsigned)w); m2[t] = __uint_as_float((unsigned)(w >> 32)); ms += mm[t]; }
        const float mean = ms * 0.25f; float qq = 0.f;
#pragma unroll
        for (int t = 0; t < 4; ++t) { const float dm = mm[t] - mean; qq += m2[t] + 256.0f * dm * dm; }
        Ss[tid] = (f32x2){mean, rsqrtf(qq * (1.f / 1024.f) + LN_EPS)};
    }
    __syncthreads();
}
__device__ __forceinline__ int ln_tile(int it) { const int G = gridDim.x, bid = blockIdx.x;
    if (G & 31) return bid + it * G;
    return it * G + (((bid & 7) + 8 * (bid >> 5)) << 2) + ((bid >> 3) & 3); }
struct SchedOne {
    const bf16_t* A; const bf16_t* W; int K, tile;
    __device__ __forceinline__ bool next(int i, g8::Unit& u) const { if (i > 0 || tile >= 128 * 4) return false; u.pm = tile >> 2; u.pn = tile & 3; return true; }
    __device__ __forceinline__ const char* a_base(const g8::Unit& u) const { return (const char*)(A + (size_t)u.pm * 256 * K); }
    __device__ __forceinline__ const char* b_base(const g8::Unit& u, int h) const { return (const char*)(W + (size_t)(u.pn * 256 + h * 128) * K); }
    __device__ __forceinline__ void a_offsets(const g8::Unit&, unsigned (&v)[2][2], int tid) const { g8::natural_offsets(v, K, tid); }
};

struct EpiOutLn1 {
    static constexpr bool AFTER_DRAIN = true;
    const bf16_t* xb; const float* gam; const float* bet; unsigned char* ws; lds_t* lds;
    __device__ __forceinline__ void init(g8::Acc& acc, const g8::Unit& u, int wr, int wc, int fr, int fq) const {
        const bf16_t* xp = xb + (size_t)(u.pm * 256 + wr * 64 + fr) * 1024 + u.pn * 256 + wc * 32 + 8 * fq;
#pragma unroll
        for (int ai = 0; ai < 2; ++ai)
#pragma unroll
            for (int m = 0; m < 4; ++m)
#pragma unroll
                for (int bj = 0; bj < 2; ++bj) acc[ai][bj][m][0] = __builtin_bit_cast(f32x4, *(const u32x4*)(xp + (size_t)(ai * 128 + m * 16) * 1024 + bj * 128));
    }
    __device__ __forceinline__ void post_prologue(g8::Acc& acc) const {
#pragma unroll
        for (int ai = 0; ai < 2; ++ai)
#pragma unroll
            for (int bj = 0; bj < 2; ++bj)
#pragma unroll
                for (int m = 0; m < 4; ++m) { const u32x4 w = __builtin_bit_cast(u32x4, acc[ai][bj][m][0]);
                    acc[ai][bj][m][0] = (f32x4){bflo(w.x), bfhi(w.x), bflo(w.y), bfhi(w.y)} * ALPHA; acc[ai][bj][m][1] = (f32x4){bflo(w.z), bfhi(w.z), bflo(w.w), bfhi(w.w)} * ALPHA; }
    }
    __device__ __forceinline__ void operator()(g8::Acc& acc, const g8::Unit& u, int wr, int wc, int fr, int fq) const {
        panel_ln_stats8(acc, u.pm, u.pn, (unsigned*)(ws + WS_CTL) + 8192, (unsigned long long*)(ws + WS_XCH1), lds, wr, wc, fr, fq);
        const LAS f32x2* Ss = (const LAS f32x2*)(lds + 8192);
        bf16_t* H1b = (bf16_t*)(ws + WS_H1B); bf16_t* H1lo = (bf16_t*)(ws + WS_H1LO);
        const int col0 = u.pn * 256 + wc * 32 + 8 * fq;
        f32x4 gg[2][2], bb[2][2];
#pragma unroll
        for (int bj = 0; bj < 2; ++bj)
#pragma unroll
            for (int n = 0; n < 2; ++n) { gg[bj][n] = *(const f32x4*)(gam + col0 + bj * 128 + 4 * n); bb[bj][n] = *(const f32x4*)(bet + col0 + bj * 128 + 4 * n); }
#pragma unroll
        for (int ai = 0; ai < 2; ++ai)
#pragma unroll
            for (int m = 0; m < 4; ++m) { const int rl = ai * 128 + wr * 64 + m * 16 + fr; const f32x2 st_ = Ss[rl]; const size_t ro = (size_t)(u.pm * 256 + rl) * 1024 + col0;
#pragma unroll
                for (int bj = 0; bj < 2; ++bj) {
                    const f32x4 h0 = (acc[ai][bj][m][0] - st_.x) * st_.y * gg[bj][0] + bb[bj][0], h1 = (acc[ai][bj][m][1] - st_.x) * st_.y * gg[bj][1] + bb[bj][1];
                    const u32x4 ph = pk8(h0, h1);
                    f32x4 r0, r1; r0[0] = h0[0] - bflo(ph.x); r0[1] = h0[1] - bfhi(ph.x); r0[2] = h0[2] - bflo(ph.y); r0[3] = h0[3] - bfhi(ph.y);
                    r1[0] = h1[0] - bflo(ph.z); r1[1] = h1[1] - bfhi(ph.z); r1[2] = h1[2] - bflo(ph.w); r1[3] = h1[3] - bfhi(ph.w);
                    *(u32x4*)(H1b + ro + bj * 128) = ph; *(u32x4*)(H1lo + ro + bj * 128) = pk8(r0, r1);
                    *(u32x2*)(ws + WS_RB + ro + bj * 128) = pk8_f8(h0, h1); } }
    }
};
__device__ __forceinline__ void phase_outproj_gemm(const Params& P, lds_t* lds) {
    for (int it = 0; ln_tile(it) < 128 * 4; ++it) { const int tile = ln_tile(it);
        SchedOne S{(const bf16_t*)(P.ws + WS_RA), (const bf16_t*)(P.ws + WS_WOUT), 1024, tile};
        EpiOutLn1 E{(const bf16_t*)(P.ws + WS_H1LO), P.in[11], P.in[12], P.ws, lds};
        g8::gemm_phase(lds, 1024, S, E);
        __syncthreads();
    }
}

constexpr int L4_LG = 98304;
constexpr int L4_LCNT = 131072;
constexpr int L4_GB = 131200;
constexpr int L4_AE = 131328;
constexpr int L4_AR = 132352;
constexpr int L4_AW = 133376;

__device__ __forceinline__ void phase_ln1_router(const Params& P, lds_t* lds) {
    unsigned char* ws = P.ws;
    int tid = threadIdx.x; asm volatile("" : "+v"(tid));
    const int lane = tid & 63, wid = __builtin_amdgcn_readfirstlane(tid >> 6), r = lane & 15, q = lane >> 4, sc = tid & 7, sr = tid >> 3;
    const bf16_t* Y = (const bf16_t*)(ws + WS_RA); const bf16_t* wt = (const bf16_t*)(ws + WS_WOUT);
    const float* x = P.in[0]; float* out = P.out; bf16_t* H1b = (bf16_t*)(ws + WS_H1B); bf16_t* H1lo = (bf16_t*)(ws + WS_H1LO);
    const bf16_t* WRB = (const bf16_t*)(ws + WS_WRB);
    int* gcount = (int*)(ws + WS_CTL);
    LAS float* LG = (LAS float*)(lds + L4_LG); LAS int* LCNT = (LAS int*)(lds + L4_LCNT); LAS int* GB = (LAS int*)(lds + L4_GB);
    LAS int* AE = (LAS int*)(lds + L4_AE); LAS int* AR = (LAS int*)(lds + L4_AR); LAS float* AW = (LAS float*)(lds + L4_AW);
    for (int panel = blockIdx.x; panel < 256; panel += gridDim.x) {
        const int row0 = panel * 128;
        if (tid < 32) LCNT[tid] = 0;
        __syncthreads();
        {
            f32x4 hacc[2][4];
            { const bf16_t* ap[2]; const bf16_t* bp[2];
#pragma unroll
              for (int i = 0; i < 2; ++i) ap[i] = H1b + (size_t)(row0 + sr + 64 * i) * 1024 + sc * 8;
              bp[0] = WRB + (size_t)sr * 3072 + sc * 8; bp[1] = WRB + (size_t)sr * 3072 + 1024 + sc * 8;
              gemm_mainloop<128, 128, 32, 64>(lds, ap, 64, bp, 16, hacc); }
            const int wm = wid >> 1, wn = wid & 1;
            if (wn == 0) {
#pragma unroll
                for (int i = 0; i < 2; ++i)
#pragma unroll
                    for (int j = 0; j < 4; ++j) *(LAS f32x4*)(LG + (wm * 32 + i * 16 + r) * 64 + j * 16 + 4 * q) = hacc[i][j]; }
            __syncthreads();
            if (wn == 1) {
#pragma unroll
                for (int i = 0; i < 2; ++i)
#pragma unroll
                    for (int j = 0; j < 4; ++j) { LAS f32x4* d_ = (LAS f32x4*)(LG + (wm * 32 + i * 16 + r) * 64 + j * 16 + 4 * q); *d_ = *d_ + hacc[i][j]; } }
            f32x4 racc[2][2];
            { const bf16_t* ap[2]; const bf16_t* bp[1];
#pragma unroll
              for (int i = 0; i < 2; ++i) ap[i] = H1lo + (size_t)(row0 + sr + 64 * i) * 1024 + sc * 8;
              bp[0] = WRB + (size_t)sr * 3072 + sc * 8;
              gemm_mainloop<128, 64, 32, 32>(lds, ap, 64, bp, 16, racc); }
#pragma unroll
            for (int i = 0; i < 2; ++i)
#pragma unroll
                for (int j = 0; j < 2; ++j) { LAS f32x4* d_ = (LAS f32x4*)(LG + (wm * 32 + i * 16 + r) * 64 + wn * 32 + j * 16 + 4 * q); *d_ = *d_ + racc[i][j]; }
        }
        __syncthreads();
        if (tid < 128) {
            const LAS float* lp = LG + tid * 64;
            const float* brg = P.in[14]; const float* bre = P.in[16];
            float g0 = lp[0] + brg[0]; int gs = 0; float gsum;
            { float gv[4]; gv[0] = g0;
#pragma unroll
              for (int i = 1; i < 4; ++i) { gv[i] = lp[i] + brg[i]; if (gv[i] > g0) { g0 = gv[i]; gs = i; } }
              gsum = 0.f;
#pragma unroll
              for (int i = 0; i < 4; ++i) gsum += __expf(gv[i] - g0); }
            const float gp = 1.f / gsum;
            float ev[8];
#pragma unroll
            for (int i = 0; i < 8; ++i) ev[i] = lp[4 + gs * 8 + i] + bre[gs * 8 + i];
            int i1 = 0; float e1 = ev[0];
#pragma unroll
            for (int i = 1; i < 8; ++i) if (ev[i] > e1) { e1 = ev[i]; i1 = i; }
            int i2 = -1; float e2 = -3.0e38f;
#pragma unroll
            for (int i = 0; i < 8; ++i) if (i != i1 && ev[i] > e2) { e2 = ev[i]; i2 = i; }
            const float x2 = __expf(e2 - e1); const float w1 = gp / (1.f + x2), w2 = gp * x2 / (1.f + x2);
            const int ea = gs * 8 + i1, eb = gs * 8 + i2;
            AE[tid * 2] = ea; AE[tid * 2 + 1] = eb; AW[tid * 2] = w1; AW[tid * 2 + 1] = w2;
            AR[tid * 2] = lds_addi(&LCNT[ea], 1); AR[tid * 2 + 1] = lds_addi(&LCNT[eb], 1);
        }
        __syncthreads();
        if (tid < 32) GB[tid] = atomicAdd(&gcount[tid], LCNT[tid]);
        __syncthreads();
        if (tid < 256) { const int row = tid >> 1, kk = tid & 1, e = AE[row * 2 + kk], slot = GB[e] + AR[row * 2 + kk]; const int tok = row0 + row;
            ((int*)(ws + WS_TOKL))[(size_t)e * 65536 + slot] = tok;
            ((int*)(ws + WS_ASGE))[tok * 2 + kk] = e; ((int*)(ws + WS_ASGS))[tok * 2 + kk] = slot; ((float*)(ws + WS_ASGW))[tok * 2 + kk] = AW[row * 2 + kk]; }
        __syncthreads();
    }
}

constexpr int L5_CNT = 131072;
constexpr int L5_RB = 131200;
constexpr int L5_TB = 131456;

__device__ __forceinline__ void moe_setup(const Params& P, lds_t* lds, int ncol) {
    LAS int* CNT = (LAS int*)(lds + L5_CNT); LAS int* RB = (LAS int*)(lds + L5_RB); LAS int* TB = (LAS int*)(lds + L5_TB);
    const int* gcount = (const int*)(P.ws + WS_CTL);
    int tid = threadIdx.x; asm volatile("" : "+v"(tid));
    if (tid < 32) CNT[tid] = gcount[tid];
    __syncthreads();
    if (tid == 0) { int rb = 0, tb = 0; for (int e = 0; e < 32; ++e) { RB[e] = rb; TB[e] = tb; rb += CNT[e]; tb += ((CNT[e] + 255) >> 8) * ncol; } RB[32] = rb; TB[32] = tb; }
    __syncthreads();
}

struct EpiPark {
    static constexpr bool AFTER_DRAIN = false;
    bf16_t* PLS;
    __device__ __forceinline__ void init(g8::Acc& acc, const g8::Unit&, int, int, int, int) const { g8::acc_zero(acc); }
    __device__ __forceinline__ void post_prologue(g8::Acc&) const {}
    __device__ __forceinline__ void operator()(g8::Acc& acc, const g8::Unit& u, int wr, int wc, int fr, int fq) const {
#pragma unroll
        for (int ai = 0; ai < 2; ++ai)
#pragma unroll
            for (int m = 0; m < 4; ++m) { const size_t ro = (size_t)(u.pm * 256 + ai * 128 + wr * 64 + m * 16 + fr) * 1024 + u.pn * 256 + wc * 32 + 8 * fq;
#pragma unroll
                for (int bj = 0; bj < 2; ++bj) *(u32x4*)(PLS + ro + bj * 128) = pk8(acc[ai][bj][m][0], acc[ai][bj][m][1]); }
    }
};
constexpr int PLE_CTR_WORD = 4096;
constexpr int L_PLEQ = 157200;
struct SchedPleRun {
    const bf16_t* A; const bf16_t* W; int t0, n;
    __device__ __forceinline__ bool next(int i, g8::Unit& u) const { const int tile = t0 + i; if (i >= n || tile >= 128 * 4) return false; u.pm = tile >> 2; u.pn = tile & 3; return true; }
    __device__ __forceinline__ const char* a_base(const g8::Unit& u) const { return (const char*)(A + (size_t)u.pm * 256 * 256); }
    __device__ __forceinline__ const char* b_base(const g8::Unit& u, int h) const { return (const char*)(W + (size_t)(u.pn * 256 + h * 128) * 256); }
    __device__ __forceinline__ void a_offsets(const g8::Unit&, unsigned (&v)[2][2], int tid) const { g8::natural_offsets(v, 256, tid); }
};
__device__ __forceinline__ void ple_fill(const Params& P, lds_t* lds, int n) {
    unsigned* ctr = (unsigned*)(P.ws + WS_CTL) + PLE_CTR_WORD;
    volatile LAS unsigned* qw = (volatile LAS unsigned*)(lds + L_PLEQ);
    int tid = threadIdx.x; asm volatile("" : "+v"(tid));
    if (tid == 0) qw[0] = atomicAdd(ctr, (unsigned)n);
    __syncthreads();
    const unsigned t = qw[0];
    __syncthreads();
    if (t >= 512u) return;
    SchedPleRun S{(const bf16_t*)(P.ws + WS_PB), (const bf16_t*)(P.ws + WS_WPLE), (int)t, n};
    EpiPark E{(bf16_t*)(P.ws + WS_H1LO)};
    g8::gemm_phase(lds, 256, S, E);
    __syncthreads();
}
constexpr int L5_UNIT = 131712;
constexpr int L5_TOKU = 132608;
constexpr int MAXU = 24;
__device__ __forceinline__ int moe_tile(int i, int ntile) { const int G = gridDim.x, bid = blockIdx.x;
    if ((G & 7) || i >= ntile / G) return bid + i * G;
    return (i * 8 + (bid & 7)) * (G >> 3) + (bid >> 3); }
__device__ __forceinline__ int moe_units(const Params& P, lds_t* lds, int first, bool want_tok) {
    LAS int* CNT = (LAS int*)(lds + L5_CNT); LAS int* RB = (LAS int*)(lds + L5_RB); LAS int* TB = (LAS int*)(lds + L5_TB);
    LAS int* UN = (LAS int*)(lds + L5_UNIT); LAS int* TOKU = (LAS int*)(lds + L5_TOKU);
    int tid = threadIdx.x; asm volatile("" : "+v"(tid));
    const int G = gridDim.x, bid = blockIdx.x;
    const int ntile = TB[32];
    int mine = 0; while (mine < 64 && moe_tile(mine, ntile) < ntile) ++mine;
    int nu = mine - first; nu = nu < 0 ? 0 : (nu > MAXU ? MAXU : nu);
    if (tid < nu) { const int tile = moe_tile(first + tid, ntile); int e = 0; while (TB[e + 1] <= tile) ++e;
        const int ne = CNT[e], MT = (ne + 255) >> 8, loc = tile - TB[e];
        UN[tid * 8 + 0] = e; UN[tid * 8 + 1] = loc / MT; UN[tid * 8 + 2] = loc % MT; UN[tid * 8 + 3] = ne; UN[tid * 8 + 4] = RB[e]; }
    __syncthreads();
    if (want_tok) { const int* TOKL = (const int*)(P.ws + WS_TOKL);
        for (int idx = tid; idx < nu * 256; idx += NTHREADS) { const int ui = idx >> 8, r = idx & 255; const int e = UN[ui * 8], mt = UN[ui * 8 + 2], ne = UN[ui * 8 + 3];
            int ix = mt * 256 + r; if (ix >= ne) ix = ne - 1; TOKU[idx] = TOKL[(size_t)e * 65536 + ix]; } }
    __syncthreads();
    return nu;
}
__device__ __forceinline__ bool moe_idle_last_round(lds_t* lds) {
    const int ntile = ((LAS int*)(lds + L5_TB))[32]; const int G = gridDim.x;
    const int rounds = (ntile + G - 1) / G;
    return rounds > 0 && moe_tile(rounds - 1, ntile) >= ntile;
}
template <bool DOWN> struct SchedMoeF8 {
    lds_t* lds; const unsigned char* A; const unsigned char* W; int nu;
    __device__ __forceinline__ bool next(int i, g8::Unit& u) const { if (i >= nu) return false; const LAS int* UN = (const LAS int*)(lds + L5_UNIT) + i * 8;
        u.e = __builtin_amdgcn_readfirstlane(UN[0]); u.pn = __builtin_amdgcn_readfirstlane(UN[1]); u.pm = __builtin_amdgcn_readfirstlane(UN[2]);
        u.ne = __builtin_amdgcn_readfirstlane(UN[3]); u.rb = __builtin_amdgcn_readfirstlane(UN[4]); u.idx = i; return true; }
    __device__ __forceinline__ const char* a_base(const g8::Unit&) const { return (const char*)A; }
    __device__ __forceinline__ const char* b_base(const g8::Unit& u, int h) const {
        if (DOWN) return (const char*)(W + (size_t)u.e * 1024 * 512 + (size_t)(u.pn * 256 + h * 128) * 512);
        return (const char*)(W + (size_t)u.e * 1024 * 1024 + (size_t)((h ? 512 : 0) + u.pn * 128) * 1024); }
    __device__ __forceinline__ void a_offsets(const g8::Unit& u, unsigned (&v)[2][2], int tid) const {
#pragma unroll
        for (int i = 0; i < 2; ++i) { int R, Cb; g8::f8_rc(tid, i, R, Cb);
#pragma unroll
            for (int h = 0; h < 2; ++h) {
                if (DOWN) { int ix = u.pm * 256 + h * 128 + R; if (ix >= u.ne) ix = u.ne - 1; v[h][i] = (unsigned)((u.rb + ix) * 512 + Cb); }
                else { const int tok = ((const LAS int*)(lds + L5_TOKU))[u.idx * 256 + h * 128 + R]; v[h][i] = (unsigned)(tok * 1024 + Cb); } } }
    }
};
template <bool DOWN> struct SchedMoe {
    lds_t* lds; const bf16_t* A; const bf16_t* W; int nu;
    __device__ __forceinline__ bool next(int i, g8::Unit& u) const { if (i >= nu) return false; const LAS int* UN = (const LAS int*)(lds + L5_UNIT) + i * 8;
        u.e = __builtin_amdgcn_readfirstlane(UN[0]); u.pn = __builtin_amdgcn_readfirstlane(UN[1]); u.pm = __builtin_amdgcn_readfirstlane(UN[2]);
        u.ne = __builtin_amdgcn_readfirstlane(UN[3]); u.rb = __builtin_amdgcn_readfirstlane(UN[4]); u.idx = i; return true; }
    __device__ __forceinline__ const char* a_base(const g8::Unit&) const { return (const char*)A; }
    __device__ __forceinline__ const char* b_base(const g8::Unit& u, int h) const {
        if (DOWN) return (const char*)(W + (size_t)u.e * 1024 * 512 + (size_t)(u.pn * 256 + h * 128) * 512);
        return (const char*)(W + (size_t)u.e * 1024 * 1024 + (size_t)((h ? 512 : 0) + u.pn * 128) * 1024); }
    __device__ __forceinline__ void a_offsets(const g8::Unit& u, unsigned (&v)[2][2], int tid) const {
#pragma unroll
        for (int i = 0; i < 2; ++i) { int R, C; g8::stage_rc(tid * 16 + i * 8192, R, C);
#pragma unroll
            for (int h = 0; h < 2; ++h) {
                if (DOWN) { int ix = u.pm * 256 + h * 128 + R; if (ix >= u.ne) ix = u.ne - 1; v[h][i] = (unsigned)((u.rb + ix) * 512 + C) * 2u; }
                else { const int tok = ((const LAS int*)(lds + L5_TOKU))[u.idx * 256 + h * 128 + R]; v[h][i] = (unsigned)(tok * 1024 + C) * 2u; } } }
    }
};
struct EpiMoeUp {
    static constexpr bool AFTER_DRAIN = false;
    bf16_t* HID;
    __device__ __forceinline__ void init(g8::Acc& acc, const g8::Unit&, int, int, int, int) const { g8::acc_zero(acc); }
    __device__ __forceinline__ void post_prologue(g8::Acc&) const {}
    __device__ __forceinline__ void operator()(g8::Acc& acc, const g8::Unit& u, int wr, int wc, int fr, int fq) const {
#pragma unroll
        for (int ai = 0; ai < 2; ++ai)
#pragma unroll
            for (int m = 0; m < 4; ++m) { const int ix = u.pm * 256 + ai * 128 + wr * 64 + m * 16 + fr;
                if (ix < u.ne) { f32x4 h0, h1;
#pragma unroll
                    for (int c = 0; c < 4; ++c) { const float g0 = acc[ai][0][m][0][c], g1 = acc[ai][0][m][1][c];
                        h0[c] = g0 * sigmoidf_(g0) * acc[ai][1][m][0][c]; h1[c] = g1 * sigmoidf_(g1) * acc[ai][1][m][1][c]; }
                    *(u32x2*)((unsigned char*)HID + (size_t)(u.rb + ix) * 512 + u.pn * 128 + wc * 32 + 8 * fq) = pk8_f8(h0, h1); } }
    }
};
struct EpiMoeDown {
    static constexpr bool AFTER_DRAIN = false;
    bf16_t* OA;
    __device__ __forceinline__ void init(g8::Acc& acc, const g8::Unit&, int, int, int, int) const { g8::acc_zero(acc); }
    __device__ __forceinline__ void post_prologue(g8::Acc&) const {}
    __device__ __forceinline__ void operator()(g8::Acc& acc, const g8::Unit& u, int wr, int wc, int fr, int fq) const {
#pragma unroll
        for (int ai = 0; ai < 2; ++ai)
#pragma unroll
            for (int m = 0; m < 4; ++m) { const int ix = u.pm * 256 + ai * 128 + wr * 64 + m * 16 + fr;
                if (ix < u.ne) {
#pragma unroll
                    for (int bj = 0; bj < 2; ++bj) *(u32x2*)((unsigned char*)OA + (size_t)(u.rb + ix) * 1024 + u.pn * 256 + bj * 128 + wc * 32 + 8 * fq) = pk8_f8(acc[ai][bj][m][0] * 4.f, acc[ai][bj][m][1] * 4.f); } }
    }
};

__device__ __forceinline__ void phase_moe1(const Params& P, lds_t* lds) {
    moe_setup(P, lds, 4);
    for (int first = 0;; first += MAXU) {
        const int nu = moe_units(P, lds, first, true);
        if (nu == 0) break;
        SchedMoeF8<false> S{lds, P.ws + WS_RB, P.ws + WS_WEIN, nu};
        EpiMoeUp E{(bf16_t*)(P.ws + WS_RA)};
        g8::gemm_phase_f8<123>(lds, 1024, S, E);
        __syncthreads();
    }
    if (moe_idle_last_round(lds)) ple_fill(P, lds, 2);
}

__device__ __forceinline__ void phase_moe2(const Params& P, lds_t* lds) {
    moe_setup(P, lds, 4);
    for (int first = 0;; first += MAXU) {
        const int nu = moe_units(P, lds, first, false);
        if (nu == 0) break;
        SchedMoeF8<true> S{lds, P.ws + WS_RA, P.ws + WS_WEOUT, nu};
        EpiMoeDown E{(bf16_t*)(P.ws + WS_RB)};
        g8::gemm_phase_f8<123>(lds, 512, S, E);
        __syncthreads();
    }
    if (moe_idle_last_round(lds)) ple_fill(P, lds, 1);
}

__device__ __forceinline__ void phase_ln2(const Params& P, lds_t* lds) {
    unsigned char* ws = P.ws;
    int tid = threadIdx.x; asm volatile("" : "+v"(tid));
    const int lane = tid & 63, wid = __builtin_amdgcn_readfirstlane(tid >> 6);
    LAS int* RB = (LAS int*)(lds + L5_RB);
    moe_setup(P, lds, 4);
    const bf16_t* OA = (const bf16_t*)(ws + WS_RB); bf16_t* H2b = (bf16_t*)(ws + WS_RA);
    const bf16_t* H1b = (const bf16_t*)(ws + WS_H1B); bf16_t* HLO = (bf16_t*)(ws + WS_H1LO);
    const int* ASGE = (const int*)(ws + WS_ASGE); const int* ASGS = (const int*)(ws + WS_ASGS); const float* ASGW = (const float*)(ws + WS_ASGW);
    f32x4 g[4], bt[4];
#pragma unroll
    for (int j = 0; j < 4; ++j) { g[j] = *(const f32x4*)(P.in[19] + 4 * lane + 256 * j); bt[j] = *(const f32x4*)(P.in[20] + 4 * lane + 256 * j); }
    for (int panel = blockIdx.x; panel < 256; panel += gridDim.x) {
        const int row0 = panel * 128;
        unsigned myo0 = 0, myo1 = 0; float myw0 = 0.f, myw1 = 0.f;
        if (lane < 16) { const int trow = row0 + 16 * wid + lane;
            const int e0 = ASGE[trow * 2], e1 = ASGE[trow * 2 + 1];
            myo0 = (unsigned)(RB[e0] + ASGS[trow * 2]) * 1024u; myo1 = (unsigned)(RB[e1] + ASGS[trow * 2 + 1]) * 1024u;
            myw0 = ASGW[trow * 2] * 0.25f; myw1 = ASGW[trow * 2 + 1] * 0.25f; }
#pragma unroll 2
        for (int rr = 0; rr < 16; ++rr) {
            const int trow = row0 + 16 * wid + rr;
            const size_t ro = (size_t)trow * 1024 + 4 * lane;
            const unsigned q0 = (unsigned)__shfl((int)myo0, rr), q1 = (unsigned)__shfl((int)myo1, rr);
            const float w0 = __shfl(myw0, rr), w1 = __shfl(myw1, rr);
            const unsigned char* o0 = (const unsigned char*)OA + (size_t)q0 + 4 * lane; const unsigned char* o1 = (const unsigned char*)OA + (size_t)q1 + 4 * lane;
            f32x4 v[4];
#pragma unroll
            for (int j = 0; j < 4; ++j) { const u32x2 hw = *(const u32x2*)(H1b + ro + 256 * j); const f32x4 h = (f32x4){bflo(hw.x), bfhi(hw.x), bflo(hw.y), bfhi(hw.y)}; const int a = *(const int*)(o0 + 256 * j), bq = *(const int*)(o1 + 256 * j);
                const f32x2 a01 = __builtin_amdgcn_cvt_pk_f32_fp8(a, false), a23 = __builtin_amdgcn_cvt_pk_f32_fp8(a, true), b01 = __builtin_amdgcn_cvt_pk_f32_fp8(bq, false), b23 = __builtin_amdgcn_cvt_pk_f32_fp8(bq, true);
                f32x4 f; f[0] = w0 * a01[0] + w1 * b01[0]; f[1] = w0 * a01[1] + w1 * b01[1]; f[2] = w0 * a23[0] + w1 * b23[0]; f[3] = w0 * a23[1] + w1 * b23[1];
                v[j] = h * ALPHA + f; }
            ln_row(v, g, bt);
#pragma unroll
            for (int j = 0; j < 4; ++j) *(u32x2*)(H2b + ro + 256 * j) = pk4(v[j]);
        }
    }
}

struct SchedPle {
    const bf16_t* A; const bf16_t* W; int G, c;
    __device__ __forceinline__ bool next(int i, g8::Unit& u) const { const int tile = c + i * G; if (tile >= 128 * 4) return false; u.pm = tile >> 2; u.pn = tile & 3; return true; }
    __device__ __forceinline__ const char* a_base(const g8::Unit& u) const { return (const char*)(A + (size_t)u.pm * 256 * 256); }
    __device__ __forceinline__ const char* b_base(const g8::Unit& u, int h) const { return (const char*)(W + (size_t)(u.pn * 256 + h * 128) * 256); }
    __device__ __forceinline__ void a_offsets(const g8::Unit&, unsigned (&v)[2][2], int tid) const { g8::natural_offsets(v, 256, tid); }
};
struct EpiGateLn3 {
    static constexpr bool AFTER_DRAIN = true;
    const bf16_t* H2b; const bf16_t* PLS; const float* bg; const float* gam; const float* bet; float* out; unsigned char* ws; lds_t* lds;
    __device__ __forceinline__ void init(g8::Acc& acc, const g8::Unit&, int, int, int, int) const { g8::acc_zero(acc); }
    __device__ __forceinline__ void post_prologue(g8::Acc&) const {}
    __device__ __forceinline__ void operator()(g8::Acc& acc, const g8::Unit& u, int wr, int wc, int fr, int fq) const {
        const int col0 = u.pn * 256 + wc * 32 + 8 * fq;
        {
            f32x4 bv[2][2];
#pragma unroll
            for (int bj = 0; bj < 2; ++bj)
#pragma unroll
                for (int n = 0; n < 2; ++n) bv[bj][n] = *(const f32x4*)(bg + col0 + bj * 128 + 4 * n);
#pragma unroll
            for (int ai = 0; ai < 2; ++ai)
#pragma unroll
                for (int m = 0; m < 4; ++m) { const size_t ro = (size_t)(u.pm * 256 + ai * 128 + wr * 64 + m * 16 + fr) * 1024 + col0;
#pragma unroll
                    for (int bj = 0; bj < 2; ++bj) {
                        const u32x4 hw = *(const u32x4*)(H2b + ro + bj * 128); const u32x4 pl = *(const u32x4*)(PLS + ro + bj * 128);
                        const f32x4 g0 = acc[ai][bj][m][0] + bv[bj][0], g1 = acc[ai][bj][m][1] + bv[bj][1];
                        f32x4 o0, o1;
                        o0[0] = bflo(hw.x) * ALPHA + bflo(pl.x) * sigmoidf_(g0[0]); o0[1] = bfhi(hw.x) * ALPHA + bfhi(pl.x) * sigmoidf_(g0[1]); o0[2] = bflo(hw.y) * ALPHA + bflo(pl.y) * sigmoidf_(g0[2]); o0[3] = bfhi(hw.y) * ALPHA + bfhi(pl.y) * sigmoidf_(g0[3]);
                        o1[0] = bflo(hw.z) * ALPHA + bflo(pl.z) * sigmoidf_(g1[0]); o1[1] = bfhi(hw.z) * ALPHA + bfhi(pl.z) * sigmoidf_(g1[1]); o1[2] = bflo(hw.w) * ALPHA + bflo(pl.w) * sigmoidf_(g1[2]); o1[3] = bfhi(hw.w) * ALPHA + bfhi(pl.w) * sigmoidf_(g1[3]);
                        acc[ai][bj][m][0] = o0; acc[ai][bj][m][1] = o1; }
                    asm volatile("" : "+v"(acc[ai][0][m][0]), "+v"(acc[ai][0][m][1]), "+v"(acc[ai][1][m][0]), "+v"(acc[ai][1][m][1]));
                    asm volatile("" ::: "memory"); }
        }
        panel_ln_stats8(acc, u.pm, u.pn, (unsigned*)(ws + WS_CTL) + 20480, (unsigned long long*)(ws + WS_XCH3), lds, wr, wc, fr, fq);
        const LAS f32x2* Ss = (const LAS f32x2*)(lds + 8192);
        f32x4 gg[2][2], bb[2][2];
#pragma unroll
        for (int bj = 0; bj < 2; ++bj)
#pragma unroll
            for (int n = 0; n < 2; ++n) { gg[bj][n] = *(const f32x4*)(gam + col0 + bj * 128 + 4 * n); bb[bj][n] = *(const f32x4*)(bet + col0 + bj * 128 + 4 * n); }
#pragma unroll
        for (int ai = 0; ai < 2; ++ai)
#pragma unroll
            for (int m = 0; m < 4; ++m) { const int rl = ai * 128 + wr * 64 + m * 16 + fr; const f32x2 st_ = Ss[rl]; float* op = out + (size_t)(u.pm * 256 + rl) * 1024 + col0;
#pragma unroll
                for (int bj = 0; bj < 2; ++bj)
#pragma unroll
                    for (int n = 0; n < 2; ++n) *(f32x4*)(op + bj * 128 + 4 * n) = (acc[ai][bj][m][n] - st_.x) * st_.y * gg[bj][n] + bb[bj][n]; }
    }
};
__device__ __forceinline__ void phase_ple_gemm(const Params& P, lds_t* lds) {
    unsigned char* ws = P.ws;
    {
        const unsigned cv = ((const unsigned*)(ws + WS_CTL))[PLE_CTR_WORD]; const int done = cv < 512u ? (int)cv : 512;
        SchedPle S{(const bf16_t*)(ws + WS_PB), (const bf16_t*)(ws + WS_WPLE), (int)gridDim.x, done + (int)blockIdx.x};
        EpiPark E{(bf16_t*)(ws + WS_H1LO)};
        g8::gemm_phase(lds, 256, S, E);
        __syncthreads();
    }
    for (int it = 0; ln_tile(it) < 128 * 4; ++it) { const int tile = ln_tile(it);
        SchedOne S{(const bf16_t*)(ws + WS_RA), (const bf16_t*)(ws + WS_WPG), 1024, tile};
        EpiGateLn3 E{(const bf16_t*)(ws + WS_RA), (const bf16_t*)(ws + WS_H1LO), P.in[23], P.in[24], P.in[25], P.out, ws, lds};
        g8::gemm_phase(lds, 1024, S, E);
        __syncthreads();
    }
}

__device__ __forceinline__ void phase_ln3(const Params& P, lds_t* lds) {
    int tid = threadIdx.x; asm volatile("" : "+v"(tid));
    const int lane = tid & 63, wid = __builtin_amdgcn_readfirstlane(tid >> 6);
    float* out = P.out;
    f32x4 g[4], bt[4];
#pragma unroll
    for (int j = 0; j < 4; ++j) { g[j] = *(const f32x4*)(P.in[24] + 4 * lane + 256 * j); bt[j] = *(const f32x4*)(P.in[25] + 4 * lane + 256 * j); }
    for (int panel = blockIdx.x; panel < 256; panel += gridDim.x) {
        const int row0 = panel * 128;
#pragma unroll 1
        for (int rr = 0; rr < 16; ++rr) {
            const size_t ro = (size_t)(row0 + 16 * wid + rr) * 1024 + 4 * lane;
            f32x4 v[4];
#pragma unroll
            for (int j = 0; j < 4; ++j) v[j] = *(const f32x4*)(out + ro + 256 * j);
            ln_row(v, g, bt);
#pragma unroll
            for (int j = 0; j < 4; ++j) *(f32x4*)(out + ro + 256 * j) = v[j];
        }
    }
}

#define XB_TMO      128
#define XB_XCNT(j)  (256  + 64 * (j))
#define XB_XSUB(j)  (1280 + 64 * (j))
#define XB_XGEN(j)  (2304 + 64 * (j))
#define XB_TOP      3328
#define XB_TOPGEN   3392
#define XCD_BAR_WORDS 3456
#define XB_SPIN_CAP (1u << 18)

__device__ __forceinline__ unsigned xb_ld(unsigned* p)              { return __hip_atomic_load(p, __ATOMIC_RELAXED, __HIP_MEMORY_SCOPE_AGENT); }
__device__ __forceinline__ unsigned xb_add(unsigned* p, unsigned v) { return __hip_atomic_fetch_add(p, v, __ATOMIC_RELAXED, __HIP_MEMORY_SCOPE_AGENT); }
__device__ __forceinline__ unsigned xb_xcc_id() { return (unsigned)__builtin_amdgcn_s_getreg((3 << 11) | 20) & 0xFu; }
#define XB_SPIN(cond, bar) do { unsigned _sp = 0; while (cond) { __builtin_amdgcn_s_sleep(1); \
    if ((++_sp & 255u) == 0u) { if (xb_ld(&(bar)[XB_TMO])) break; if (_sp > XB_SPIN_CAP) { atomicAdd(&(bar)[XB_TMO], 1u); break; } } } } while (0)

struct XcdBarrier {
    unsigned* bar; unsigned x;
    volatile LAS unsigned* st;
};

__device__ __forceinline__ XcdBarrier xcd_barrier_post(unsigned* bar, volatile LAS unsigned* st) {
    XcdBarrier b; b.bar = bar; b.x = xb_xcc_id(); b.st = st;
    if (threadIdx.x == 0) (void)xb_add(&bar[XB_XCNT(b.x)], 1u);
    return b;
}
__device__ __forceinline__ void xcd_barrier_complete(unsigned* bar, unsigned x, unsigned& nloc, unsigned& nx) {
    const unsigned G = gridDim.x * gridDim.y * gridDim.z;
    unsigned sum, cnt, mine, sp = 0u;
    for (;;) {
        sum = 0u; cnt = 0u; mine = 0u;
#pragma unroll
        for (unsigned j = 0; j < 16; ++j) { const unsigned c = xb_ld(&bar[XB_XCNT(j)]); sum += c; cnt += (c > 0u) ? 1u : 0u; mine = (j == x) ? c : mine; }
        if (sum == G) break;
        __builtin_amdgcn_s_sleep(1);
        if ((++sp & 255u) == 0u) { if (xb_ld(&bar[XB_TMO])) break; if (sp > XB_SPIN_CAP) { atomicAdd(&bar[XB_TMO], 1u); break; } }
    }
    nloc = mine > 0u ? mine : 1u; nx = cnt > 0u ? cnt : 1u;
}

__device__ __forceinline__ void xcd_barrier(const XcdBarrier& b) {
    asm volatile("s_waitcnt vmcnt(0)" ::: "memory");
    __syncthreads();
    if (threadIdx.x == 0) {
        unsigned* bar = b.bar;
        __builtin_amdgcn_s_waitcnt(0);
        unsigned nloc = b.st[0], nx = b.st[1];
        if (nloc == 0u) { xcd_barrier_complete(bar, b.x, nloc, nx); b.st[0] = nloc; b.st[1] = nx; }
        const unsigned old = xb_add(&bar[XB_XSUB(b.x)], 1u);
        const unsigned gen = old / nloc;
        if (old + 1u == (gen + 1u) * nloc) {
            __builtin_amdgcn_fence(__ATOMIC_RELEASE, "agent");
            asm volatile("s_waitcnt vmcnt(0)" ::: "memory");
            const unsigned og = xb_add(&bar[XB_TOP], 1u);
            const unsigned tg = og / nx;
            if (og + 1u == (tg + 1u) * nx) xb_add(&bar[XB_TOPGEN], 1u);
            else XB_SPIN(xb_ld(&bar[XB_TOPGEN]) == tg, bar);
            __builtin_amdgcn_fence(__ATOMIC_ACQUIRE, "agent");
            xb_add(&bar[XB_XGEN(b.x)], 1u);
            asm volatile("s_waitcnt vmcnt(0)" ::: "memory");
        } else {
            XB_SPIN(xb_ld(&bar[XB_XGEN(b.x)]) == gen, bar);
            __builtin_amdgcn_fence(__ATOMIC_ACQUIRE, "agent");
            asm volatile("s_waitcnt vmcnt(0)" ::: "memory");
        }
    }
    __syncthreads();
}

#ifndef USE_CG_SYNC
#define USE_CG_SYNC 0
#endif
constexpr size_t WS_BAR = 65536;
constexpr size_t CTL_ZERO_BYTES = 131072;
__global__ void __launch_bounds__(NTHREADS) fwd_kernel(Params P) {
    extern __shared__ __attribute__((aligned(16))) unsigned char smem[];
    lds_t* lds = (lds_t*)smem;
    const int lo = P.ph_lo, hi = P.ph_hi;
#if !USE_CG_SYNC
    volatile LAS unsigned* bst = (volatile LAS unsigned*)(lds + LDS_BYTES - 16);
    if (threadIdx.x < 2) bst[threadIdx.x] = 0u;
    __syncthreads();
    XcdBarrier bar; bar.bar = (unsigned*)(P.ws + WS_BAR); bar.x = 0; bar.st = nullptr;
    if (hi - lo > 1) bar = xcd_barrier_post((unsigned*)(P.ws + WS_BAR), bst);
#define GRID_SYNC() xcd_barrier(bar)
#else
#define GRID_SYNC() cg::this_grid().sync()
#endif
#ifndef ONLY_PHASE
#define ONLY_PHASE -1
#endif
#ifndef REPEAT_PHASE
#define REPEAT_PHASE -1
#endif
#define PHASE(k, fn) if ((ONLY_PHASE < 0 || ONLY_PHASE == (k)) && lo <= (k) && (k) < hi) { int nrep_ = (REPEAT_PHASE == (k)) ? 2 : 1; asm volatile("" : "+s"(nrep_)); for (int rep_ = 0; rep_ < nrep_; ++rep_) { fn(P, lds); __syncthreads(); } if ((k) + 1 < hi) { GRID_SYNC(); } }
    PHASE(0, phase_prep)
    PHASE(1, phase_inproj)
    PHASE(2, phase_conv_compress)
    PHASE(3, phase_nsa)
    PHASE(4, phase_outproj_gemm)
    PHASE(5, phase_ln1_router)
    PHASE(6, phase_moe1)
    PHASE(7, phase_moe2)
    PHASE(8, phase_ln2)
    PHASE(9, phase_ple_gemm)
#undef PHASE
}

extern "C" void kernel_launch(void* const* d_in, const int* in_sizes, int n_in, void* d_out, int out_size, void* d_ws, size_t ws_size, hipStream_t stream) {
    static int grid = 0;
    if (grid == 0) {
        if (n_in != 26 || ws_size < WS_END) { fprintf(stderr, "kernel_launch: unexpected n_in %d or ws_size %zu (< %zu)\n", n_in, ws_size, (size_t)WS_END); grid = -1; return; }
        int dev = 0, cus = 0, per_cu = 0;
        (void)hipGetDevice(&dev);
        (void)hipDeviceGetAttribute(&cus, hipDeviceAttributeMultiprocessorCount, dev);
        (void)hipFuncSetAttribute((const void*)fwd_kernel, hipFuncAttributeMaxDynamicSharedMemorySize, LDS_BYTES);
        (void)hipOccupancyMaxActiveBlocksPerMultiprocessor(&per_cu, (const void*)fwd_kernel, NTHREADS, LDS_BYTES);
        if (per_cu < 1) { fprintf(stderr, "kernel_launch: occupancy query says %d blocks per CU\n", per_cu); per_cu = 1; }
        grid = cus & ~3;
        (void)hipGetLastError();
    }
    if (grid < 0) return;
    Params p{};
    for (int i = 0; i < 26; ++i) p.in[i] = (const float*)d_in[i];
    p.out = (float*)d_out; p.ws = (unsigned char*)d_ws;
#if N_LAUNCH_SPLIT
    for (int ph = 0; ph < 10; ++ph) { p.ph_lo = ph; p.ph_hi = ph + 1; hipLaunchKernelGGL(fwd_kernel, dim3(grid), dim3(NTHREADS), LDS_BYTES, stream, p); }
#else
    p.ph_lo = 0; p.ph_hi = 10;
#if USE_CG_SYNC
    void* args[] = {&p};
    hipError_t e = hipLaunchCooperativeKernel((const void*)fwd_kernel, dim3(grid), dim3(NTHREADS), args, LDS_BYTES, stream);
    if (e != hipSuccess) fprintf(stderr, "cooperative launch failed: %s (grid %d)\n", hipGetErrorString(e), grid);
#else
    if (hipMemsetAsync((char*)d_ws + WS_CTL, 0, CTL_ZERO_BYTES, stream) != hipSuccess) { fprintf(stderr, "kernel_launch: hipMemsetAsync failed\n"); return; }
    hipLaunchKernelGGL(fwd_kernel, dim3(grid), dim3(NTHREADS), LDS_BYTES, stream, p);
#endif
#endif
}
```

```cpp
#include <hip/hip_runtime.h>
#include <hip/hip_cooperative_groups.h>
#include <cstdio>
#include <cstdint>
namespace cg = cooperative_groups;

#ifndef N_LAUNCH_SPLIT
#define N_LAUNCH_SPLIT 0
#endif

#define LAS __attribute__((address_space(3)))
typedef unsigned short bf16_t;
typedef short bf16x8 __attribute__((ext_vector_type(8)));
typedef float f32x4 __attribute__((ext_vector_type(4)));
typedef float f32x2 __attribute__((ext_vector_type(2)));
typedef unsigned u32x4 __attribute__((ext_vector_type(4)));
typedef unsigned u32x2 __attribute__((ext_vector_type(2)));
typedef __bf16 bf16x2_t __attribute__((ext_vector_type(2)));
typedef LAS unsigned char lds_t;

constexpr int NBATCH = 4, SEQ = 8192, T = NBATCH * SEQ, DM = 1024;
constexpr int NTHREADS = 512;
constexpr float ALPHA = 1.189207115002721f;
constexpr float LN_EPS = 1e-5f;
constexpr float QSCALE = 0.125f * 1.4426950408889634f;
constexpr int NIN_PAD = 3072;
constexpr int LDS_BYTES = 163840;

constexpr size_t MiB = 1u << 20;
constexpr size_t WS_CTL = 0;
constexpr size_t WS_WIN = 1 * MiB;
constexpr size_t WS_WOUT = 7 * MiB;
constexpr size_t WS_WPG = 9 * MiB;
constexpr size_t WS_WPLE = 11 * MiB;
constexpr size_t WS_W1CK = 12 * MiB;
constexpr size_t WS_W1CV = 12 * MiB + 512 * 1024;
constexpr size_t WS_W2CK = 13 * MiB;
constexpr size_t WS_W2CV = 13 * MiB + 64 * 1024;
constexpr size_t WS_BIAS1 = 13 * MiB + 128 * 1024;
constexpr size_t WS_WRB = 13 * MiB + 256 * 1024;
constexpr size_t WS_WEIN = 14 * MiB;
constexpr size_t WS_WEOUT = 78 * MiB;
constexpr size_t WS_PB = 110 * MiB;
constexpr size_t WS_G = 126 * MiB;
constexpr size_t WS_KCMP = 129 * MiB;
constexpr size_t WS_VCMPT = 129 * MiB + 512 * 1024;
constexpr size_t WS_ASGE = 130 * MiB;
constexpr size_t WS_ASGS = 130 * MiB + 256 * 1024;
constexpr size_t WS_ASGW = 130 * MiB + 512 * 1024;
constexpr size_t WS_TOKL = 131 * MiB;
constexpr size_t WS_H1B = 140 * MiB;
constexpr size_t WS_RA = 204 * MiB;
constexpr size_t WS_RB = 276 * MiB;
constexpr size_t WS_U = WS_RB, WS_CB = WS_RB + 32 * MiB, WS_Q = WS_RB + 64 * MiB, WS_KC = WS_RB + 96 * MiB, WS_VC = WS_RB + 104 * MiB;
constexpr size_t WS_KS = WS_RB + 112 * MiB, WS_VST = WS_RB + 120 * MiB, WS_KW = WS_RB + 128 * MiB, WS_VWT = WS_RB + 136 * MiB;
constexpr size_t WS_H1LO = 420 * MiB;
constexpr size_t WS_XCH1 = 484 * MiB;
constexpr size_t WS_XCH3 = 485 * MiB;
constexpr size_t WS_END = 486 * MiB;

struct Params {
    const float* in[26];
    float* out;
    unsigned char* ws;
    int ph_lo, ph_hi;
};

__device__ __forceinline__ unsigned pk2(float lo, float hi) { f32x2 v = {lo, hi}; bf16x2_t b = __builtin_convertvector(v, bf16x2_t); return __builtin_bit_cast(unsigned, b); }
__device__ __forceinline__ bf16_t f2bf(float f) { return (bf16_t)(pk2(f, 0.f) & 0xffffu); }
__device__ __forceinline__ float bf2f(unsigned h) { return __uint_as_float(h << 16); }
__device__ __forceinline__ float bflo(unsigned w) { return __uint_as_float(w << 16); }
__device__ __forceinline__ float bfhi(unsigned w) { return __uint_as_float(w & 0xffff0000u); }
__device__ __forceinline__ u32x2 pk4(f32x4 v) { u32x2 o; o.x = pk2(v[0], v[1]); o.y = pk2(v[2], v[3]); return o; }
__device__ __forceinline__ unsigned pk4_f8(float a, float b, float c, float d) { int w = 0; w = __builtin_amdgcn_cvt_pk_fp8_f32(a, b, w, false); w = __builtin_amdgcn_cvt_pk_fp8_f32(c, d, w, true); return (unsigned)w; }
__device__ __forceinline__ u32x2 pk8_f8(f32x4 a, f32x4 b) { u32x2 o; o.x = pk4_f8(a[0], a[1], a[2], a[3]); o.y = pk4_f8(b[0], b[1], b[2], b[3]); return o; }
__device__ __forceinline__ u32x4 pk8(f32x4 a, f32x4 b) { u32x4 o; o.x = pk2(a[0], a[1]); o.y = pk2(a[2], a[3]); o.z = pk2(b[0], b[1]); o.w = pk2(b[2], b[3]); return o; }
__host__ __device__ __forceinline__ int perm64(int n) { return (n & ~63) | (((n >> 2) & 3) << 4) | (((n >> 4) & 3) << 2) | (n & 3); }
__device__ __forceinline__ float fexp2(float x) { return __builtin_amdgcn_exp2f(x); }
__device__ __forceinline__ float sigmoidf_(float x) { return __builtin_amdgcn_rcpf(1.0f + __expf(-x)); }
__device__ __forceinline__ int lds_off(int row, int chunk) { return row * 128 + ((chunk ^ ((row >> 1) & 7)) << 4); }
__device__ __forceinline__ bf16x8 lds_ld16(lds_t* p) { return *(LAS bf16x8*)p; }
__device__ __forceinline__ void lds_st16(lds_t* p, u32x4 v) { *(LAS u32x4*)p = v; }
__device__ __forceinline__ bf16x8 gld16(const bf16_t* p) { return *(const bf16x8*)p; }
__device__ __forceinline__ f32x4 mfma16(bf16x8 a, bf16x8 b, f32x4 c) { return __builtin_amdgcn_mfma_f32_16x16x32_bf16(a, b, c, 0, 0, 0); }
__device__ __forceinline__ int fenc(float f) { int b = __float_as_int(f); return b >= 0 ? b : (b ^ 0x7fffffff); }
__device__ __forceinline__ float fdec(int b) { return __int_as_float(b >= 0 ? b : (b ^ 0x7fffffff)); }
__device__ __forceinline__ float sx(float v, int m) { return __shfl_xor(v, m); }

__device__ __forceinline__ void lds_addf(LAS float* p, float v) { (void)__hip_atomic_fetch_add(p, v, __ATOMIC_RELAXED, __HIP_MEMORY_SCOPE_WORKGROUP); }
__device__ __forceinline__ void lds_addi_nr(LAS int* p, int v) { (void)__hip_atomic_fetch_add(p, v, __ATOMIC_RELAXED, __HIP_MEMORY_SCOPE_WORKGROUP); }
__device__ __forceinline__ int lds_addi(LAS int* p, int v) { return __hip_atomic_fetch_add(p, v, __ATOMIC_RELAXED, __HIP_MEMORY_SCOPE_WORKGROUP); }
__device__ __forceinline__ void lds_maxi(LAS int* p, int v) { (void)__hip_atomic_fetch_max(p, v, __ATOMIC_RELAXED, __HIP_MEMORY_SCOPE_WORKGROUP); }
__device__ __forceinline__ void lds_oru(LAS unsigned* p, unsigned v) { (void)__hip_atomic_fetch_or(p, v, __ATOMIC_RELAXED, __HIP_MEMORY_SCOPE_WORKGROUP); }

template <int BM, int BN, int WTM = 64, int WTN = 64, bool ZERO = true>
__device__ __forceinline__ void gemm_mainloop(lds_t* lds, const bf16_t* (&ap)[BM / 64], int astep, const bf16_t* (&bp)[BN / 64], int nk, f32x4 (&acc)[WTM / 16][WTN / 16]) {
    constexpr int NA = BM / 64, NB_ = BN / 64, WN = BN / WTN, MT = WTM / 16, NT = WTN / 16;
    static_assert((BM / WTM) * (BN / WTN) == 8, "8 waves");
    constexpr int STAGE = (BM + BN) * 128;
    int tid = threadIdx.x; asm volatile("" : "+v"(tid));
    const int lane = tid & 63, wid = __builtin_amdgcn_readfirstlane(tid >> 6);
    const int r = lane & 15, q = lane >> 4;
    const int wm = wid / WN, wn = wid % WN;
    const int sc = tid & 7, sr = tid >> 3;
    const int wofs = sr * 128 + ((sc ^ ((sr >> 1) & 7)) << 4);
    const int x0 = (q ^ (r >> 1)) << 4;
    const int aoff = (wm * WTM + r) * 128, boff = BM * 128 + (wn * WTN + r) * 128;
    u32x4 ra0[NA], rb0[NB_], ra1[NA], rb1[NB_];
    if (ZERO) {
#pragma unroll
        for (int i = 0; i < MT; ++i)
#pragma unroll
            for (int j = 0; j < NT; ++j) acc[i][j] = (f32x4){0.f, 0.f, 0.f, 0.f};
    }
#define GM_LOAD(RA, RB, KT) do { _Pragma("unroll") for (int i = 0; i < NA; ++i) RA[i] = *(const u32x4*)(ap[i] + (size_t)(KT) * astep); \
                                 _Pragma("unroll") for (int i = 0; i < NB_; ++i) RB[i] = *(const u32x4*)(bp[i] + (size_t)(KT) * 64); } while (0)
#define GM_WRITE(RA, RB, ST) do { lds_t* sn_ = lds + (ST) * STAGE; _Pragma("unroll") for (int i = 0; i < NA; ++i) lds_st16(sn_ + i * 8192 + wofs, RA[i]); \
                                  _Pragma("unroll") for (int i = 0; i < NB_; ++i) lds_st16(sn_ + BM * 128 + i * 8192 + wofs, RB[i]); } while (0)
#define GM_COMPUTE(ST) do { lds_t* st_ = lds + (ST) * STAGE; _Pragma("unroll") for (int s = 0; s < 2; ++s) { const int xs = x0 ^ (s << 6); bf16x8 a[MT], b[NT]; \
        _Pragma("unroll") for (int i = 0; i < MT; ++i) a[i] = lds_ld16(st_ + aoff + i * 2048 + xs); \
        _Pragma("unroll") for (int i = 0; i < NT; ++i) b[i] = lds_ld16(st_ + boff + i * 2048 + xs); \
        _Pragma("unroll") for (int i = 0; i < MT; ++i) _Pragma("unroll") for (int j = 0; j < NT; ++j) acc[i][j] = mfma16(b[j], a[i], acc[i][j]); } } while (0)
    GM_LOAD(ra0, rb0, 0);
    if (nk > 1) GM_LOAD(ra1, rb1, 1);
    GM_WRITE(ra0, rb0, 0);
    __syncthreads();
    for (int kt = 0; kt < nk; kt += 2) {
        if (kt + 2 < nk) GM_LOAD(ra0, rb0, kt + 2);
        GM_COMPUTE(0);
        if (kt + 1 < nk) GM_WRITE(ra1, rb1, 1);
        __syncthreads();
        if (kt + 1 < nk) {
            if (kt + 3 < nk) GM_LOAD(ra1, rb1, kt + 3);
            GM_COMPUTE(1);
            if (kt + 2 < nk) GM_WRITE(ra0, rb0, 0);
            __syncthreads();
        }
    }
#undef GM_LOAD
#undef GM_WRITE
#undef GM_COMPUTE
}

__device__ __forceinline__ int glds_lchunk(int tid) { return ((tid & 7) ^ ((tid >> 4) & 7)) * 8; }
__device__ __forceinline__ void gemm256_first(lds_t* lds, const bf16_t* abase, const unsigned (&aoffs)[4], const bf16_t* bbase, const unsigned (&boffs)[4]) {
    const int wid = __builtin_amdgcn_readfirstlane(threadIdx.x >> 6);
#pragma unroll
    for (int i = 0; i < 4; ++i) {
        __builtin_amdgcn_global_load_lds((const unsigned*)(abase + aoffs[i]), (LAS unsigned*)(lds + i * 8192 + wid * 1024), 16, 0, 0);
        __builtin_amdgcn_global_load_lds((const unsigned*)(bbase + boffs[i]), (LAS unsigned*)(lds + 32768 + i * 8192 + wid * 1024), 16, 0, 0); }
}
struct AccZero { __device__ __forceinline__ f32x4 operator()(int, int) const { return (f32x4){0.f, 0.f, 0.f, 0.f}; } __device__ __forceinline__ void next() {} };
struct AccFromF32 { const float* p; size_t step; float scale;
    __device__ __forceinline__ f32x4 operator()(int, int j) const { return *(const f32x4*)(p + j * 4) * scale; }
    __device__ __forceinline__ void next() { p += step; asm volatile("" : "+v"(p)); } };
template <class Init = AccZero>
__device__ __forceinline__ void gemm256_main(lds_t* lds, const bf16_t* abase, const unsigned (&aoffs)[4], int astep, const bf16_t* bbase, const unsigned (&boffs)[4], int nk, f32x4 (&acc)[8][4], Init init = Init()) {
    int tid = threadIdx.x; asm volatile("" : "+v"(tid));
    const int lane = tid & 63, wid = __builtin_amdgcn_readfirstlane(tid >> 6);
    const int r = lane & 15, q = lane >> 4, wr = wid >> 2, wc = wid & 3;
    const int x0 = (q ^ (r >> 1)) << 4;
    const int aoff = (wr * 128 + r) * 128, boff = 32768 + (wc * 64 + r) * 128;
    const int sflip = wr;
#pragma unroll
    for (int i = 0; i < 8; ++i) {
#pragma unroll
        for (int j = 0; j < 4; ++j) acc[i][j] = init(i, j);
        init.next(); }
#define G2_STAGE(BUF, KT) do { _Pragma("unroll") for (int i = 0; i < 4; ++i) { \
        __builtin_amdgcn_global_load_lds((const unsigned*)((abase + (size_t)(KT) * astep) + aoffs[i]), (LAS unsigned*)(lds + (BUF) * 65536 + i * 8192 + wid * 1024), 16, 0, 0); \
        __builtin_amdgcn_global_load_lds((const unsigned*)((bbase + (size_t)(KT) * 64) + boffs[i]), (LAS unsigned*)(lds + (BUF) * 65536 + 32768 + i * 8192 + wid * 1024), 16, 0, 0); } } while (0)
#define G2_COMPUTE(BUF) do { lds_t* st_ = lds + (BUF) * 65536; _Pragma("unroll") for (int s = 0; s < 2; ++s) { const int xs = x0 ^ ((s ^ sflip) << 6); bf16x8 a[8], b[4]; \
        _Pragma("unroll") for (int i = 0; i < 8; ++i) a[i] = lds_ld16(st_ + aoff + i * 2048 + xs); \
        _Pragma("unroll") for (int i = 0; i < 4; ++i) b[i] = lds_ld16(st_ + boff + i * 2048 + xs); \
        _Pragma("unroll") for (int i = 0; i < 8; ++i) _Pragma("unroll") for (int j = 0; j < 4; ++j) acc[i][j] = mfma16(b[j], a[i], acc[i][j]); \
        __builtin_amdgcn_sched_barrier(0); } } while (0)
    asm volatile("s_waitcnt vmcnt(0)" ::: "memory");
    __syncthreads();
    for (int t = 0; t < nk; ++t) {
        const int cur = t & 1;
        if (t + 1 < nk) G2_STAGE(cur ^ 1, t + 1);
        G2_COMPUTE(cur);
        asm volatile("s_waitcnt vmcnt(0)" ::: "memory");
        __syncthreads();
    }
#undef G2_STAGE
#undef G2_COMPUTE
}
__device__ __forceinline__ void gemm256(lds_t* lds, const bf16_t* abase, const unsigned (&aoffs)[4], int astep, const bf16_t* bbase, const unsigned (&boffs)[4], int nk, f32x4 (&acc)[8][4]) {
    gemm256_first(lds, abase, aoffs, bbase, boffs);
    gemm256_main(lds, abase, aoffs, astep, bbase, boffs, nk, acc);
}


namespace g8 {
constexpr int HALF = 128, HTB = HALF * 64 * 2, STAGE_BYTES = 8 * HTB;
__device__ __forceinline__ int lds_byte(int r, int c) { const int st = (r >> 4) * 2 + (c >> 5), rr = r & 15, cc = c & 31, ob = rr * 64 + cc * 2; return st * 1024 + (ob ^ (((ob >> 9) & 1) << 5)); }
__device__ __forceinline__ void stage_rc(int b, int& R, int& C) { const int st = b / 1024, sb = b % 1024, swz = sb ^ (((sb >> 9) & 1) << 5); R = (st >> 1) * 16 + swz / 64; C = (st & 1) * 32 + (swz % 64) / 2; }
__device__ __forceinline__ int perm32(int rho) { const int n = rho >> 4, i = rho & 15; return 8 * (i >> 2) + 4 * n + (i & 3); }
struct Unit { int pm, pn, e, ne, rb, idx; };
typedef f32x4 Acc[2][2][4][2];
__device__ __forceinline__ void acc_zero(Acc& acc) {
#pragma unroll
    for (int a = 0; a < 2; ++a)
#pragma unroll
        for (int b = 0; b < 2; ++b)
#pragma unroll
            for (int m = 0; m < 4; ++m)
#pragma unroll
                for (int n = 0; n < 2; ++n) acc[a][b][m][n] = (f32x4){0.f, 0.f, 0.f, 0.f};
}
__device__ __forceinline__ void natural_offsets(unsigned (&voffA)[2][2], int K, int tid) {
#pragma unroll
    for (int i = 0; i < 2; ++i) { int R, C; stage_rc(tid * 16 + i * 8192, R, C); voffA[0][i] = (unsigned)(R * K + C) * 2u; voffA[1][i] = (unsigned)((R + HALF) * K + C) * 2u; }
}
template <class Epi, class Sched>
__device__ __forceinline__ void gemm_phase(lds_t* lds, const int K, const Sched& S, const Epi& E) {
    int tid = threadIdx.x; asm volatile("" : "+v"(tid));
    const int wid = __builtin_amdgcn_readfirstlane(tid >> 6), lane = tid & 63, wr = wid >> 2, wc = wid & 3, fr = lane & 15, fq = lane >> 4;
    const int nt = K / 64;
    unsigned voffA[2][2], voffB[2];
#pragma unroll
    for (int i = 0; i < 2; ++i) { int R, C; stage_rc(tid * 16 + i * 8192, R, C); const int Rb = (R & ~31) + perm32(R & 31); voffB[i] = (unsigned)(Rb * K + C) * 2u; }
    const size_t kstep = 128;
    const unsigned ldsw = (unsigned)wid * 1024u;
    const int aoff = lds_byte(wr * 64 + fr, fq * 8), boff = lds_byte(wc * 32 + fr, fq * 8);
#define G8_SA(b, h) (((b) * 2 + (h)) * g8::HTB)
#define G8_SB(b, h) ((4 + (b) * 2 + (h)) * g8::HTB)
#define G8_STAGE(bufoff, gbase, voff) do { _Pragma("unroll") for (int _i = 0; _i < 2; ++_i) \
        __builtin_amdgcn_global_load_lds((const unsigned*)((const char*)(gbase) + (voff)[_i]), (LAS unsigned*)(lds + (bufoff) + ldsw + _i * 8192), 16, 0, 0); } while (0)
#define G8_LDA(dst, b, h) do { _Pragma("unroll") for (int m = 0; m < 4; ++m) _Pragma("unroll") for (int k = 0; k < 2; ++k) dst[m][k] = *(const LAS bf16x8*)(lds + G8_SA(b, h) + aoff + m * 2048 + k * 1024); } while (0)
#define G8_LDB(dst, b, h) do { _Pragma("unroll") for (int n = 0; n < 2; ++n) _Pragma("unroll") for (int k = 0; k < 2; ++k) dst[n][k] = *(const LAS bf16x8*)(lds + G8_SB(b, h) + boff + n * 2048 + k * 1024); } while (0)
#define G8_MMA(ai, bj, At, Bt) do { __builtin_amdgcn_s_setprio(1); _Pragma("unroll") for (int m = 0; m < 4; ++m) _Pragma("unroll") for (int n = 0; n < 2; ++n) _Pragma("unroll") for (int k = 0; k < 2; ++k) \
        acc[ai][bj][m][n] = __builtin_amdgcn_mfma_f32_16x16x32_bf16(Bt[n][k], At[m][k], acc[ai][bj][m][n], 0, 0, 0); __builtin_amdgcn_s_setprio(0); } while (0)
#define G8_WAIT_V(n) asm volatile("s_waitcnt vmcnt(" #n ")" ::: "memory")
#define G8_WAIT_L(n) asm volatile("s_waitcnt lgkmcnt(" #n ")" ::: "memory")
#define G8_BAR __builtin_amdgcn_s_barrier()
#define G8_SCHED __builtin_amdgcn_sched_barrier(0)
    Unit cur, nxt; int ui = 0;
    if (!S.next(0, cur)) return;
    Acc acc;
    E.init(acc, cur, wr, wc, fr, fq);
    bf16x8 At[4][2], B0[2][2], B1[2][2];
    const char* cA = S.a_base(cur); const char* cB0 = S.b_base(cur, 0); const char* cB1 = S.b_base(cur, 1);
    S.a_offsets(cur, voffA, tid);
    G8_STAGE(G8_SB(0, 0), cB0, voffB); G8_STAGE(G8_SA(0, 0), cA, voffA[0]); G8_STAGE(G8_SB(0, 1), cB1, voffB); G8_STAGE(G8_SA(0, 1), cA, voffA[1]);
    if (wr == 1) G8_BAR;
    G8_WAIT_V(4); G8_BAR;
    G8_STAGE(G8_SB(1, 0), cB0 + kstep, voffB); G8_STAGE(G8_SA(1, 0), cA + kstep, voffA[0]); G8_STAGE(G8_SB(1, 1), cB1 + kstep, voffB);
    G8_WAIT_V(6); G8_BAR;
    E.post_prologue(acc);
    for (;;) {
        const bool has_next = S.next(ui + 1, nxt);
        const char* nA = has_next ? S.a_base(nxt) : cA; const char* nB0 = has_next ? S.b_base(nxt, 0) : cB0; const char* nB1 = has_next ? S.b_base(nxt, 1) : cB1;
        for (int t = 0; t < nt; t += 2) {
            const bool last = (t == nt - 2);
            const char* a1 = cA + (size_t)(t + 1) * kstep;
            const char* a2 = last ? nA : cA + (size_t)(t + 2) * kstep; const char* b20 = last ? nB0 : cB0 + (size_t)(t + 2) * kstep; const char* b21 = last ? nB1 : cB1 + (size_t)(t + 2) * kstep;
            const char* a3 = a2 + kstep; const char* b30 = b20 + kstep; const char* b31 = b21 + kstep;
            G8_LDB(B0, 0, 0); G8_SCHED; G8_LDA(At, 0, 0); G8_STAGE(G8_SA(1, 1), a1, voffA[1]);
            G8_WAIT_L(8); G8_BAR; G8_WAIT_L(0); G8_MMA(0, 0, At, B0); G8_BAR; G8_SCHED;
            if (last && has_next) S.a_offsets(nxt, voffA, tid);
            G8_LDB(B1, 0, 1); G8_STAGE(G8_SB(0, 0), b20, voffB);
            G8_BAR; G8_WAIT_L(0); G8_MMA(0, 1, At, B1); G8_BAR;
            G8_LDA(At, 0, 1); G8_STAGE(G8_SA(0, 0), a2, voffA[0]);
            G8_BAR; G8_WAIT_L(0); G8_MMA(1, 0, At, B0); G8_BAR; G8_SCHED;
            G8_STAGE(G8_SB(0, 1), b21, voffB);
            G8_WAIT_V(6); G8_BAR; G8_MMA(1, 1, At, B1); G8_BAR;
            G8_LDB(B0, 1, 0); G8_SCHED; G8_LDA(At, 1, 0); G8_STAGE(G8_SA(0, 1), a2, voffA[1]);
            G8_WAIT_L(8); G8_BAR; G8_WAIT_L(0); G8_MMA(0, 0, At, B0); G8_BAR; G8_SCHED;
            G8_LDB(B1, 1, 1); G8_STAGE(G8_SB(1, 0), b30, voffB);
            G8_BAR; G8_WAIT_L(0); G8_MMA(0, 1, At, B1); G8_BAR;
            G8_LDA(At, 1, 1); G8_STAGE(G8_SA(1, 0), a3, voffA[0]);
            G8_BAR; G8_WAIT_L(0); G8_MMA(1, 0, At, B0); G8_BAR; G8_SCHED;
            G8_STAGE(G8_SB(1, 1), b31, voffB);
            G8_WAIT_V(6); G8_BAR; G8_MMA(1, 1, At, B1); G8_BAR;
        }
        if constexpr (!Epi::AFTER_DRAIN) E(acc, cur, wr, wc, fr, fq);
        if (!has_next) break;
        cur = nxt; cA = nA; cB0 = nB0; cB1 = nB1; ++ui;
        E.init(acc, cur, wr, wc, fr, fq);
    }
    G8_WAIT_V(0);
    if (wr == 0) G8_BAR;
    G8_BAR;
    if constexpr (Epi::AFTER_DRAIN) E(acc, cur, wr, wc, fr, fq);
#undef G8_SA
#undef G8_SB
#undef G8_STAGE
#undef G8_LDA
#undef G8_LDB
#undef G8_MMA
#undef G8_WAIT_V
#undef G8_WAIT_L
#undef G8_BAR
#undef G8_SCHED
}
typedef int v8i __attribute__((ext_vector_type(8)));
typedef int v4i __attribute__((ext_vector_type(4)));
__device__ __forceinline__ int f8_sw(int row) { const int a = (row >> 1) & 7; return a ^ ((a << 1) & 4); }
__device__ __forceinline__ void f8_rc(int tid, int i, int& R, int& Cb) { R = (tid >> 3) + 64 * i; Cb = ((tid & 7) ^ f8_sw(R)) << 4; }
template <int SCLW, class Epi, class Sched>
__device__ __forceinline__ void gemm_phase_f8(lds_t* lds, const int K, const Sched& S, const Epi& E) {
    int tid = threadIdx.x; asm volatile("" : "+v"(tid));
    const int wid = __builtin_amdgcn_readfirstlane(tid >> 6), lane = tid & 63, wr = wid >> 2, wc = wid & 3, fr = lane & 15, fq = lane >> 4;
    int nt = K / 128; asm volatile("" : "+s"(nt));
    unsigned voffA[2][2], voffB[2];
#pragma unroll
    for (int i = 0; i < 2; ++i) { int R, Cb; f8_rc(tid, i, R, Cb); const int Rb = (R & ~31) + perm32(R & 31); voffB[i] = (unsigned)(Rb * K + Cb); }
    const size_t kstep = 128;
    const unsigned ldsw = (unsigned)wid * 1024u;
    const int c0_ = ((2 * fq) ^ f8_sw(fr)) << 4;
    const int aoff = (wr * 64 + fr) * 128 + c0_, boff = (wc * 32 + fr) * 128 + c0_;
    constexpr int SCL_ACT = 0x7f7f7f7f, SCL_W = SCLW * 0x01010101;
#define G8_SA(b, h) (((b) * 2 + (h)) * g8::HTB)
#define G8_SB(b, h) ((4 + (b) * 2 + (h)) * g8::HTB)
#define G8_STAGE(bufoff, gbase, voff) do { _Pragma("unroll") for (int _i = 0; _i < 2; ++_i) \
        __builtin_amdgcn_global_load_lds((const unsigned*)((const char*)(gbase) + (voff)[_i]), (LAS unsigned*)(lds + (bufoff) + ldsw + _i * 8192), 16, 0, 0); } while (0)
#define G8_LDA(dst, b, h) do { _Pragma("unroll") for (int m = 0; m < 4; ++m) { const u32x4 lo_ = *(const LAS u32x4*)(lds + G8_SA(b, h) + aoff + m * 2048), hi_ = *(const LAS u32x4*)(lds + G8_SA(b, h) + (aoff ^ 16) + m * 2048); \
        dst[m] = __builtin_shufflevector(__builtin_bit_cast(v4i, lo_), __builtin_bit_cast(v4i, hi_), 0, 1, 2, 3, 4, 5, 6, 7); } } while (0)
#define G8_LDB(dst, b, h) do { _Pragma("unroll") for (int n = 0; n < 2; ++n) { const u32x4 lo_ = *(const LAS u32x4*)(lds + G8_SB(b, h) + boff + n * 2048), hi_ = *(const LAS u32x4*)(lds + G8_SB(b, h) + (boff ^ 16) + n * 2048); \
        dst[n] = __builtin_shufflevector(__builtin_bit_cast(v4i, lo_), __builtin_bit_cast(v4i, hi_), 0, 1, 2, 3, 4, 5, 6, 7); } } while (0)
#define G8_MMA(ai, bj, At, Bt) do { __builtin_amdgcn_s_setprio(1); _Pragma("unroll") for (int m = 0; m < 4; ++m) _Pragma("unroll") for (int n = 0; n < 2; ++n) \
        acc[ai][bj][m][n] = __builtin_amdgcn_mfma_scale_f32_16x16x128_f8f6f4(Bt[n], At[m], acc[ai][bj][m][n], 0, 0, 0, SCL_W, 0, SCL_ACT); __builtin_amdgcn_s_setprio(0); } while (0)
#define G8_WAIT_V(n) asm volatile("s_waitcnt vmcnt(" #n ")" ::: "memory")
#define G8_WAIT_L(n) asm volatile("s_waitcnt lgkmcnt(" #n ")" ::: "memory")
#define G8_BAR __builtin_amdgcn_s_barrier()
#define G8_SCHED __builtin_amdgcn_sched_barrier(0)
    Unit cur, nxt; int ui = 0;
    if (!S.next(0, cur)) return;
    Acc acc;
    E.init(acc, cur, wr, wc, fr, fq);
    v8i At[4], B0[2], B1[2];
    const char* cA = S.a_base(cur); const char* cB0 = S.b_base(cur, 0); const char* cB1 = S.b_base(cur, 1);
    S.a_offsets(cur, voffA, tid);
    G8_STAGE(G8_SB(0, 0), cB0, voffB); G8_STAGE(G8_SA(0, 0), cA, voffA[0]); G8_STAGE(G8_SB(0, 1), cB1, voffB); G8_STAGE(G8_SA(0, 1), cA, voffA[1]);
    if (wr == 1) G8_BAR;
    G8_WAIT_V(4); G8_BAR;
    G8_STAGE(G8_SB(1, 0), cB0 + kstep, voffB); G8_STAGE(G8_SA(1, 0), cA + kstep, voffA[0]); G8_STAGE(G8_SB(1, 1), cB1 + kstep, voffB);
    G8_WAIT_V(6); G8_BAR;
    E.post_prologue(acc);
    for (;;) {
        const bool has_next = S.next(ui + 1, nxt);
        const char* nA = has_next ? S.a_base(nxt) : cA; const char* nB0 = has_next ? S.b_base(nxt, 0) : cB0; const char* nB1 = has_next ? S.b_base(nxt, 1) : cB1;
#pragma unroll 1
        for (int t = 0; t < nt; t += 2) {
            const bool last = (t == nt - 2);
            const char* a1 = cA + (size_t)(t + 1) * kstep;
            const char* a2 = last ? nA : cA + (size_t)(t + 2) * kstep; const char* b20 = last ? nB0 : cB0 + (size_t)(t + 2) * kstep; const char* b21 = last ? nB1 : cB1 + (size_t)(t + 2) * kstep;
            const char* a3 = a2 + kstep; const char* b30 = b20 + kstep; const char* b31 = b21 + kstep;
            G8_LDB(B0, 0, 0); G8_SCHED; G8_LDA(At, 0, 0); G8_STAGE(G8_SA(1, 1), a1, voffA[1]);
            G8_WAIT_L(8); G8_BAR; G8_WAIT_L(0); G8_MMA(0, 0, At, B0); G8_BAR; G8_SCHED;
            if (last && has_next) S.a_offsets(nxt, voffA, tid);
            G8_LDB(B1, 0, 1); G8_STAGE(G8_SB(0, 0), b20, voffB);
            G8_BAR; G8_WAIT_L(0); G8_MMA(0, 1, At, B1); G8_BAR;
            G8_LDA(At, 0, 1); G8_STAGE(G8_SA(0, 0), a2, voffA[0]);
            G8_BAR; G8_WAIT_L(0); G8_MMA(1, 0, At, B0); G8_BAR; G8_SCHED;
            G8_STAGE(G8_SB(0, 1), b21, voffB);
            G8_WAIT_V(6); G8_BAR; G8_MMA(1, 1, At, B1); G8_BAR;
            G8_LDB(B0, 1, 0); G8_SCHED; G8_LDA(At, 1, 0); G8_STAGE(G8_SA(0, 1), a2, voffA[1]);
            G8_WAIT_L(8); G8_BAR; G8_WAIT_L(0); G8_MMA(0, 0, At, B0); G8_BAR; G8_SCHED;
            G8_LDB(B1, 1, 1); G8_STAGE(G8_SB(1, 0), b30, voffB);
            G8_BAR; G8_WAIT_L(0); G8_MMA(0, 1, At, B1); G8_BAR;
            G8_LDA(At, 1, 1); G8_STAGE(G8_SA(1, 0), a3, voffA[0]);
            G8_BAR; G8_WAIT_L(0); G8_MMA(1, 0, At, B0); G8_BAR; G8_SCHED;
            G8_STAGE(G8_SB(1, 1), b31, voffB);
            G8_WAIT_V(6); G8_BAR; G8_MMA(1, 1, At, B1); G8_BAR;
        }
        if constexpr (!Epi::AFTER_DRAIN) E(acc, cur, wr, wc, fr, fq);
        if (!has_next) break;
        cur = nxt; cA = nA; cB0 = nB0; cB1 = nB1; ++ui;
        E.init(acc, cur, wr, wc, fr, fq);
    }
    G8_WAIT_V(0);
    if (wr == 0) G8_BAR;
    G8_BAR;
    if constexpr (Epi::AFTER_DRAIN) E(acc, cur, wr, wc, fr, fq);
#undef G8_SA
#undef G8_SB
#undef G8_STAGE
#undef G8_LDA
#undef G8_LDB
#undef G8_MMA
#undef G8_WAIT_V
#undef G8_WAIT_L
#undef G8_BAR
#undef G8_SCHED
}
}

template <class CM>
__device__ __forceinline__ void transpose_tile(const float* src, int Nsrc, int K, bf16_t* dst, int k0, int n0, CM cm, LAS float* scr) {
    const int tid = threadIdx.x;
    {
        const int tx = tid & 63, ty = tid >> 6;
        const int scol = cm(n0 + tx);
#pragma unroll
        for (int i = 0; i < 8; ++i) { const int kk = ty + 8 * i; scr[kk * 65 + tx] = scol >= 0 ? src[(size_t)(k0 + kk) * Nsrc + scol] : 0.f; }
    }
    __syncthreads();
    {
        const int kp = tid & 31, n1 = tid >> 5;
#pragma unroll
        for (int i = 0; i < 4; ++i) { const int nn = n1 + 16 * i;
            *(unsigned*)(dst + (size_t)(n0 + nn) * K + k0 + 2 * kp) = pk2(scr[(2 * kp) * 65 + nn], scr[(2 * kp + 1) * 65 + nn]); }
    }
    __syncthreads();
}

__device__ __forceinline__ void transpose_tile_f8(const float* src, int Nsrc, int K, unsigned char* dst8, int k0, int n0, float scale, LAS float* scr) {
    const int tid = threadIdx.x;
    {
        const int tx = tid & 63, ty = tid >> 6;
#pragma unroll
        for (int i = 0; i < 8; ++i) { const int kk = ty + 8 * i; scr[kk * 65 + tx] = src[(size_t)(k0 + kk) * Nsrc + n0 + tx]; }
    }
    __syncthreads();
    {
        const int kq = tid & 15, n1 = tid >> 4;
#pragma unroll
        for (int i = 0; i < 2; ++i) { const int nn = n1 + 32 * i;
            *(unsigned*)(dst8 + (size_t)(n0 + nn) * K + k0 + 4 * kq) = pk4_f8(scale * scr[(4 * kq) * 65 + nn], scale * scr[(4 * kq + 1) * 65 + nn], scale * scr[(4 * kq + 2) * 65 + nn], scale * scr[(4 * kq + 3) * 65 + nn]); }
    }
    __syncthreads();
}

__device__ __forceinline__ int inproj_srccol(int n) {
    if (n < 512) return n;
    if (n < 1536) { const int i = (n - 512) >> 1; return (n & 1) ? 1024 + i : 512 + i; }
    if (n < 2840) return n;
    return -1;
}

__device__ __forceinline__ void phase_prep(const Params& P, lds_t* lds) {
    LAS float* scr = (LAS float*)lds;
    unsigned char* ws = P.ws;
    const int G = gridDim.x, bid = blockIdx.x, tid = threadIdx.x;
    constexpr int T_IN = 16 * 48, T_OUT = 256, T_PG = 256, T_PLE = 64, T_W1 = 64, T_W2 = 2, T_EIN = 32 * 256, T_EOUT = 32 * 128;
    constexpr int NT = T_IN + T_OUT + T_PG + T_PLE + 2 * T_W1 + 2 * T_W2 + T_EIN + T_EOUT;
    for (int it = bid; it < NT; it += G) {
        int x = it;
        if (x < T_IN) { transpose_tile(P.in[2], 2840, 1024, (bf16_t*)(ws + WS_WIN), (x / 48) * 64, (x % 48) * 64, [](int n) { return n < 2840 ? n : -1; }, scr); continue; } x -= T_IN;
        if (x < T_OUT) { transpose_tile(P.in[10], 1024, 1024, (bf16_t*)(ws + WS_WOUT), (x / 16) * 64, (x % 16) * 64, [](int n) { return n; }, scr); continue; } x -= T_OUT;
        if (x < T_PG) { transpose_tile(P.in[22], 1024, 1024, (bf16_t*)(ws + WS_WPG), (x / 16) * 64, (x % 16) * 64, [](int n) { return n; }, scr); continue; } x -= T_PG;
        if (x < T_PLE) { transpose_tile(P.in[21], 1024, 256, (bf16_t*)(ws + WS_WPLE), (x / 16) * 64, (x % 16) * 64, [](int n) { return n; }, scr); continue; } x -= T_PLE;
        if (x < T_W1) { transpose_tile(P.in[5], 128, 2048, (bf16_t*)(ws + WS_W1CK), (x / 2) * 64, (x % 2) * 64, [](int n) { return n; }, scr); continue; } x -= T_W1;
        if (x < T_W1) { transpose_tile(P.in[8], 128, 2048, (bf16_t*)(ws + WS_W1CV), (x / 2) * 64, (x % 2) * 64, [](int n) { return n; }, scr); continue; } x -= T_W1;
        if (x < T_W2) { transpose_tile(P.in[6], 64, 128, (bf16_t*)(ws + WS_W2CK), x * 64, 0, [](int n) { return n; }, scr); continue; } x -= T_W2;
        if (x < T_W2) { transpose_tile(P.in[9], 64, 128, (bf16_t*)(ws + WS_W2CV), x * 64, 0, [](int n) { return n; }, scr); continue; } x -= T_W2;
        if (x < T_EIN) { const int e = x >> 8, y = x & 255;
            transpose_tile_f8(P.in[17] + (size_t)e * 1024 * 1024, 1024, 1024, ws + WS_WEIN + (size_t)e * 1024 * 1024, (y / 16) * 64, (y % 16) * 64, 16.f, scr); continue; } x -= T_EIN;
        { const int e = x >> 7, y = x & 127;
            transpose_tile_f8(P.in[18] + (size_t)e * 512 * 1024, 1024, 512, ws + WS_WEOUT + (size_t)e * 1024 * 512, (y / 16) * 64, (y % 16) * 64, 16.f, scr); }
    }
    {
        const size_t gtid = (size_t)bid * NTHREADS + tid, gsz = (size_t)G * NTHREADS;
        const float* x = P.in[0]; bf16_t* xb = (bf16_t*)(ws + WS_H1LO);
        for (size_t i = gtid; i < (size_t)T * DM / 8; i += gsz) {
            const f32x4 a = *(const f32x4*)(x + i * 8), b = *(const f32x4*)(x + i * 8 + 4);
            u32x4 o; o.x = pk2(a[0], a[1]); o.y = pk2(a[2], a[3]); o.z = pk2(b[0], b[1]); o.w = pk2(b[2], b[3]);
            *(u32x4*)(xb + i * 8) = o;
        }
        const float* pp = P.in[1]; bf16_t* pb = (bf16_t*)(ws + WS_PB);
        for (size_t i = gtid; i < (size_t)T * 256 / 8; i += gsz) {
            const f32x4 a = *(const f32x4*)(pp + i * 8), b = *(const f32x4*)(pp + i * 8 + 4);
            u32x4 o; o.x = pk2(a[0], a[1]); o.y = pk2(a[2], a[3]); o.z = pk2(b[0], b[1]); o.w = pk2(b[2], b[3]);
            *(u32x4*)(pb + i * 8) = o;
        }
        bf16_t* wrb = (bf16_t*)(ws + WS_WRB);
        for (size_t i = gtid; i < 64 * 3072; i += gsz) {
            const int n = (int)(i / 3072), kk = (int)(i % 3072), k = kk & 1023, seg = kk >> 10;
            float v = 0.f;
            if (n < 4) v = P.in[13][k * 4 + n]; else if (n < 36) v = P.in[15][k * 32 + (n - 4)];
            const bf16_t hi = f2bf(v); const bf16_t lo = f2bf(v - bf2f(hi));
            wrb[i] = (seg == 1) ? lo : hi;
        }
    }
    if (bid == (G > 1 ? 1 : 0) || bid == (G > 2 ? 2 : 0)) {
        for (int which = 0; which < 2; ++which) {
            if (bid != ((which == 0) ? (G > 1 ? 1 : 0) : (G > 2 ? 2 : 0))) continue;
            const float* pe = P.in[which ? 7 : 4]; const float* w1 = P.in[which ? 8 : 5];
            const int n = tid & 127, ks = tid >> 7;
            float s = 0.f;
            for (int k = ks * 512; k < ks * 512 + 512; ++k) s += pe[k] * w1[(size_t)k * 128 + n];
            scr[ks * 128 + n] = s;
            __syncthreads();
            if (tid < 128) ((float*)(ws + WS_BIAS1))[which * 128 + tid] = scr[tid] + scr[128 + tid] + scr[256 + tid] + scr[384 + tid];
            __syncthreads();
        }
    }
    if (bid == 0 && tid < 64) ((int*)(ws + WS_CTL))[tid] = 0;
#ifndef ATOMIC_BENCH
#define ATOMIC_BENCH 0
#endif
#if ATOMIC_BENCH == 1
    { LAS float* fb = (LAS float*)(lds + 65536);
      for (int it = 0; it < 200; ++it) {
#pragma unroll
        for (int k = 0; k < 16; ++k) lds_addf(fb + (k * 512 + tid), 1.0f); } }
#elif ATOMIC_BENCH == 2
    { LAS int* fb = (LAS int*)(lds + 65536);
      for (int it = 0; it < 200; ++it) {
#pragma unroll
        for (int k = 0; k < 16; ++k) (void)__hip_atomic_fetch_add(fb + (k * 512 + tid), 1, __ATOMIC_RELAXED, __HIP_MEMORY_SCOPE_WORKGROUP); } }
#endif
}

struct SchedInproj {
    const bf16_t* xb; const bf16_t* wt; int G, c;
    __device__ __forceinline__ bool next(int i, g8::Unit& u) const {
        if (G == 256) { if (i >= 6) return false; const int qb = i * 8 + (c & 7), k = c >> 3; u.pm = (qb / 3) * 8 + (k & 7); u.pn = (qb % 3) * 4 + (k >> 3); return true; }
        const int L = i * G + c; if (L >= 128 * 12) return false; u.pm = L / 12; u.pn = L % 12; return true; }
    __device__ __forceinline__ const char* a_base(const g8::Unit& u) const { return (const char*)(xb + (size_t)u.pm * 256 * 1024); }
    __device__ __forceinline__ const char* b_base(const g8::Unit& u, int h) const {
        const int row = (u.pn >= 2 && u.pn < 6) ? ((h ? 1024 : 512) + (u.pn - 2) * 128) : (u.pn * 256 + h * 128);
        return (const char*)(wt + (size_t)row * 1024); }
    __device__ __forceinline__ void a_offsets(const g8::Unit&, unsigned (&v)[2][2], int tid) const { g8::natural_offsets(v, 1024, tid); }
};
struct EpiInproj {
    static constexpr bool AFTER_DRAIN = false;
    unsigned char* ws;
    __device__ __forceinline__ void init(g8::Acc& acc, const g8::Unit&, int, int, int, int) const { g8::acc_zero(acc); }
    __device__ __forceinline__ void post_prologue(g8::Acc&) const {}
    __device__ __forceinline__ void operator()(g8::Acc& acc, const g8::Unit& u, int wr, int wc, int fr, int fq) const {
        const int n0 = wc * 32 + 8 * fq;
        const int pn = u.pn;
        if (pn >= 2 && pn < 6) {
#pragma unroll
            for (int ai = 0; ai < 2; ++ai)
#pragma unroll
                for (int m = 0; m < 4; ++m) { const int t = u.pm * 256 + ai * 128 + wr * 64 + m * 16 + fr;
                    *(u32x4*)((bf16_t*)(ws + WS_U) + (size_t)t * 512 + (pn - 2) * 128 + n0) = pk8(acc[ai][0][m][0] * acc[ai][1][m][0], acc[ai][0][m][1] * acc[ai][1][m][1]); }
            return;
        }
#pragma unroll
        for (int bj = 0; bj < 2; ++bj) {
#pragma unroll
            for (int ai = 0; ai < 2; ++ai)
#pragma unroll
                for (int m = 0; m < 4; ++m) { const int t = u.pm * 256 + ai * 128 + wr * 64 + m * 16 + fr; const int b = t >> 13, s_ = t & 8191;
                    const f32x4 v0 = acc[ai][bj][m][0], v1 = acc[ai][bj][m][1];
                    if (pn < 2) *(u32x4*)((bf16_t*)(ws + WS_CB) + (size_t)t * 512 + pn * 256 + bj * 128 + n0) = pk8(v0, v1);
                    else if (pn < 8) *(u32x4*)((bf16_t*)(ws + WS_Q) + (size_t)t * 512 + (pn - 6) * 256 + bj * 128 + n0) = pk8(v0 * QSCALE, v1 * QSCALE);
                    else if (pn == 8) *(u32x4*)((bf16_t*)(ws + (bj ? WS_VC : WS_KC)) + (size_t)t * 128 + n0) = pk8(v0, v1);
                    else if (pn < 11) { const int kvh = n0 >> 6, d = n0 & 63;
                        if (bj == 0) *(u32x4*)((bf16_t*)(ws + (pn == 9 ? WS_KS : WS_KW)) + ((size_t)((b * 2 + kvh) * SEQ + s_)) * 64 + d) = pk8(v0, v1);
                        else { bf16_t* base = (bf16_t*)(ws + (pn == 9 ? WS_VST : WS_VWT)) + ((size_t)((b * 2 + kvh) * 128 + (s_ >> 6)) * 64 + d) * 64 + (s_ & 63);
#pragma unroll
                            for (int c = 0; c < 4; ++c) { base[c * 64] = f2bf(v0[c]); base[(4 + c) * 64] = f2bf(v1[c]); } } }
                    else if (bj == 0 && n0 < 24) { float* gp = (float*)(ws + WS_G) + (size_t)t * 24 + n0;
                        *(f32x4*)gp = (f32x4){sigmoidf_(v0[0]), sigmoidf_(v0[1]), sigmoidf_(v0[2]), sigmoidf_(v0[3])};
                        *(f32x4*)(gp + 4) = (f32x4){sigmoidf_(v1[0]), sigmoidf_(v1[1]), sigmoidf_(v1[2]), sigmoidf_(v1[3])}; }
                }
        }
    }
};
__device__ __forceinline__ void phase_inproj(const Params& P, lds_t* lds) {
    SchedInproj S{(const bf16_t*)(P.ws + WS_H1LO), (const bf16_t*)(P.ws + WS_WIN), (int)gridDim.x, (int)blockIdx.x};
    EpiInproj E{P.ws};
    g8::gemm_phase(lds, 1024, S, E);
}

__device__ __forceinline__ float gelu_tanh(float x) {
    const float u = 0.7978845608028654f * (x + 0.044715f * x * x * x);
    const float e = __expf(2.f * u);
    const float th = 1.f - 2.f / (e + 1.f);
    return 0.5f * x * (1.f + th);
}

__device__ __forceinline__ void phase_conv_compress(const Params& P, lds_t* lds) {
    unsigned char* ws = P.ws;
    int tid = threadIdx.x; asm volatile("" : "+v"(tid));
    const int lane = tid & 63, wid = __builtin_amdgcn_readfirstlane(tid >> 6), r = lane & 15, q = lane >> 4, sc = tid & 7, sr = tid >> 3;
    const int G = gridDim.x;
    const int NCW = G >= 2 ? (G / 2 < 128 ? G / 2 : 128) : 1;
    const bool do_cmp = (int)blockIdx.x < NCW, do_conv = G < 2 || (int)blockIdx.x >= NCW;
    if (do_cmp) for (int tile = blockIdx.x; tile < 128; tile += NCW) {
        const int which = tile >> 6, mt = tile & 63;
        const bf16_t* src = (const bf16_t*)(ws + (which ? WS_VC : WS_KC));
        const bf16_t* w1 = (const bf16_t*)(ws + (which ? WS_W1CV : WS_W1CK));
        const bf16_t* w2 = (const bf16_t*)(ws + (which ? WS_W2CV : WS_W2CK));
        const float* bias1 = (const float*)(ws + WS_BIAS1) + which * 128;
        const bf16_t* ap[1]; const bf16_t* bp[2];
        { const int row = mt * 64 + sr; const int bk = row >> 9; int n = row & 511; if (n > 510) n = 510;
            ap[0] = src + (size_t)((bk >> 1) * SEQ + 16 * n) * 128 + (bk & 1) * 64 + sc * 8; }
#pragma unroll
        for (int i = 0; i < 2; ++i) bp[i] = w1 + (size_t)(sr + 64 * i) * 2048 + sc * 8;
        f32x4 acc[2][2];
        gemm_mainloop<64, 128, 32, 32>(lds, ap, 128, bp, 32, acc);
        const int wm = wid >> 2, wn = wid & 3;
#pragma unroll
        for (int i = 0; i < 2; ++i) { const int m = wm * 32 + i * 16 + r;
#pragma unroll
            for (int j = 0; j < 2; ++j) { const int n = wn * 32 + j * 16 + 4 * q; const f32x4 bv = *(const f32x4*)(bias1 + n); f32x4 v = acc[i][j] + bv;
                v = (f32x4){gelu_tanh(v[0]), gelu_tanh(v[1]), gelu_tanh(v[2]), gelu_tanh(v[3])};
                const int kk = n >> 6, c = (n & 63) >> 3, half = (n & 7) >> 2;
                *(LAS u32x2*)(lds + kk * 8192 + lds_off(m, c) + half * 8) = pk4(v); } }
#pragma unroll
        for (int kk = 0; kk < 2; ++kk) lds_st16(lds + 65536 + kk * 8192 + lds_off(sr, sc), *(const u32x4*)(w2 + (size_t)sr * 128 + kk * 64 + sc * 8));
        __syncthreads();
        f32x4 a2[2] = {(f32x4){0.f, 0.f, 0.f, 0.f}, (f32x4){0.f, 0.f, 0.f, 0.f}};
#pragma unroll
        for (int kk = 0; kk < 2; ++kk)
#pragma unroll
            for (int s = 0; s < 2; ++s) {
                const bf16x8 a = lds_ld16(lds + kk * 8192 + lds_off(16 * (wid >> 1) + r, 4 * s + q));
#pragma unroll
                for (int j = 0; j < 2; ++j) { const bf16x8 bq = lds_ld16(lds + 65536 + kk * 8192 + lds_off((wid & 1) * 32 + j * 16 + r, 4 * s + q)); a2[j] = mfma16(bq, a, a2[j]); }
            }
        { const int row = mt * 64 + 16 * (wid >> 1) + r; const int bk = row >> 9, n = row & 511;
#pragma unroll
            for (int j = 0; j < 2; ++j) { const int d = (wid & 1) * 32 + j * 16 + 4 * q; const f32x4 v = a2[j];
                if (!which) *(u32x2*)((bf16_t*)(ws + WS_KCMP) + (size_t)(bk * 512 + n) * 64 + d) = pk4(v);
                else { bf16_t* base = (bf16_t*)(ws + WS_VCMPT) + ((size_t)((bk * 8 + (n >> 6)) * 64 + d)) * 64 + (n & 63);
                    base[0] = f2bf(v[0]); base[64] = f2bf(v[1]); base[128] = f2bf(v[2]); base[192] = f2bf(v[3]); } } }
        __syncthreads();
    }
    {
        const bf16_t* U = (const bf16_t*)(ws + WS_U); const bf16_t* CB = (const bf16_t*)(ws + WS_CB); bf16_t* Y = (bf16_t*)(ws + WS_RA);
        const float* wc = P.in[3];
        const size_t gtid = (size_t)(G < 2 ? 0 : (int)blockIdx.x - NCW) * NTHREADS + tid, gsz = (size_t)(G < 2 ? 1 : G - NCW) * NTHREADS;
        if (do_conv) for (size_t it = gtid; it < (size_t)T * 64; it += gsz) {
            const int t = (int)(it >> 6), c8 = (int)(it & 63) * 8, s = t & 8191;
            const u32x4 u2 = *(const u32x4*)(U + (size_t)t * 512 + c8);
            u32x4 u1 = (u32x4){0, 0, 0, 0}, u0 = (u32x4){0, 0, 0, 0};
            if (s >= 1) u1 = *(const u32x4*)(U + (size_t)(t - 1) * 512 + c8);
            if (s >= 2) u0 = *(const u32x4*)(U + (size_t)(t - 2) * 512 + c8);
            const u32x4 cb = *(const u32x4*)(CB + (size_t)t * 512 + c8);
            const f32x4 w0a = *(const f32x4*)(wc + c8), w0b = *(const f32x4*)(wc + c8 + 4);
            const f32x4 w1a = *(const f32x4*)(wc + 512 + c8), w1b = *(const f32x4*)(wc + 512 + c8 + 4);
            const f32x4 w2a = *(const f32x4*)(wc + 1024 + c8), w2b = *(const f32x4*)(wc + 1024 + c8 + 4);
            u32x4 o;
#define CONV2(W, IDX, A0, A1) { const float y0 = bflo(cb.W) * (w0##A0[IDX] * bflo(u0.W) + w1##A0[IDX] * bflo(u1.W) + w2##A0[IDX] * bflo(u2.W)); \
                                const float y1 = bfhi(cb.W) * (w0##A1[IDX + 1] * bfhi(u0.W) + w1##A1[IDX + 1] * bfhi(u1.W) + w2##A1[IDX + 1] * bfhi(u2.W)); o.W = pk2(y0, y1); }
            CONV2(x, 0, a, a) CONV2(y, 2, a, a) CONV2(z, 0, b, b) CONV2(w, 2, b, b)
#undef CONV2
            *(u32x4*)(Y + (size_t)t * 1024 + c8) = o;
        }
    }
}

constexpr int L_Q = 0;
constexpr int L_IMP = 32768;
constexpr int L_OST = 32768;
constexpr int OSS = 68;
constexpr int L_MS = 102400;
constexpr int L_LS = 103424;
constexpr int L_RING = 104448;
constexpr int L_SELM = 153600;
constexpr int L_LIST = 154624;
constexpr int L_NJ = 162816;
constexpr int IMPS = 129;

struct QKFrag { bf16x8 k[4][2]; };
struct VFrag { bf16x8 v[4][2]; };

__device__ __forceinline__ float red16_max(float v) { auto t = __builtin_amdgcn_permlane16_swap(__float_as_uint(v), __float_as_uint(v), false, false); return fmaxf(__uint_as_float(t[0]), __uint_as_float(t[1])); }
__device__ __forceinline__ float red32_max(float v) { auto t = __builtin_amdgcn_permlane32_swap(__float_as_uint(v), __float_as_uint(v), false, false); return fmaxf(__uint_as_float(t[0]), __uint_as_float(t[1])); }
__device__ __forceinline__ float red16_sum(float v) { auto t = __builtin_amdgcn_permlane16_swap(__float_as_uint(v), __float_as_uint(v), false, false); return __uint_as_float(t[0]) + __uint_as_float(t[1]); }
__device__ __forceinline__ float red32_sum(float v) { auto t = __builtin_amdgcn_permlane32_swap(__float_as_uint(v), __float_as_uint(v), false, false); return __uint_as_float(t[0]) + __uint_as_float(t[1]); }
__device__ __forceinline__ float rowq_max(float v) { return red32_max(red16_max(v)); }
__device__ __forceinline__ float rowq_sum(float v) { return red32_sum(red16_sum(v)); }
template <int CTRL> __device__ __forceinline__ float dpp_f(float v) { return __int_as_float(__builtin_amdgcn_update_dpp(0, __float_as_int(v), CTRL, 0xf, 0xf, true)); }
template <int CTRL> __device__ __forceinline__ int dpp_i(int v) { return __builtin_amdgcn_update_dpp(0, v, CTRL, 0xf, 0xf, true); }
__device__ __forceinline__ float quad_sum(float v) { v += dpp_f<0xB1>(v); v += dpp_f<0x4E>(v); return v; }

__device__ __forceinline__ void lds_kfrag(QKFrag& f, lds_t* kslot, int r, int q) {
    int o0 = r * 128 + ((q ^ (r >> 1)) << 4); asm volatile("" : "+v"(o0));
#pragma unroll
    for (int nt = 0; nt < 4; ++nt)
#pragma unroll
        for (int s = 0; s < 2; ++s) f.k[nt][s] = lds_ld16(kslot + ((o0 ^ (s << 6)) + nt * 2048));
}
__device__ __forceinline__ void lds_vfrag(VFrag& f, lds_t* vslot, int r, int q) {
    int o0 = r * 128 + ((q & 1) << 3) + (((q >> 1) ^ (r >> 1)) << 4); asm volatile("" : "+v"(o0));
#pragma unroll
    for (int dt = 0; dt < 4; ++dt)
#pragma unroll
        for (int ks = 0; ks < 2; ++ks) {
            const u32x2 lo = *(LAS u32x2*)(vslot + ((o0 ^ (ks << 6)) + dt * 2048));
            const u32x2 hi = *(LAS u32x2*)(vslot + ((o0 ^ (ks << 6) ^ 32) + dt * 2048));
            u32x4 w; w.x = lo.x; w.y = lo.y; w.z = hi.x; w.w = hi.y;
            f.v[dt][ks] = __builtin_bit_cast(bf16x8, w);
        }
}
__device__ __forceinline__ void qk_tile(f32x4 (&st)[4], const QKFrag& f, const bf16x8 (&yq)[2]) {
#pragma unroll
    for (int nt = 0; nt < 4; ++nt) { f32x4 z = (f32x4){0.f, 0.f, 0.f, 0.f}; z = mfma16(f.k[nt][0], yq[0], z); st[nt] = mfma16(f.k[nt][1], yq[1], z); }
}
__device__ __forceinline__ void pv_tile(f32x4 (&o)[4], const VFrag& f, const f32x4 (&p)[4]) {
    bf16x8 pf[2];
#pragma unroll
    for (int ks = 0; ks < 2; ++ks) { u32x4 w; w.x = pk2(p[2 * ks][0], p[2 * ks][1]); w.y = pk2(p[2 * ks][2], p[2 * ks][3]); w.z = pk2(p[2 * ks + 1][0], p[2 * ks + 1][1]); w.w = pk2(p[2 * ks + 1][2], p[2 * ks + 1][3]);
        pf[ks] = __builtin_bit_cast(bf16x8, w); }
#pragma unroll
    for (int dt = 0; dt < 4; ++dt) { o[dt] = mfma16(f.v[dt][0], pf[0], o[dt]); o[dt] = mfma16(f.v[dt][1], pf[1], o[dt]); }
}
constexpr float SM_THR = 8.f;
__device__ __forceinline__ void qk_tile_c(f32x4 (&st)[4], const QKFrag& f, const bf16x8 (&yq)[2], f32x4 cinit) {
#pragma unroll
    for (int nt = 0; nt < 4; ++nt) { f32x4 z = mfma16(f.k[nt][0], yq[0], cinit); st[nt] = mfma16(f.k[nt][1], yq[1], z); }
}
__device__ __forceinline__ float max16(const f32x4 (&st)[4]) {
    float a = fmaxf(fmaxf(st[0][0], st[0][1]), fmaxf(st[0][2], st[0][3]));
#pragma unroll
    for (int nt = 1; nt < 4; ++nt) a = fmaxf(a, fmaxf(fmaxf(st[nt][0], st[nt][1]), fmaxf(st[nt][2], st[nt][3])));
    return a;
}
__device__ __forceinline__ void mask16(f32x4 (&st)[4], int lo, int hi) {
#pragma unroll
    for (int nt = 0; nt < 4; ++nt)
#pragma unroll
        for (int c = 0; c < 4; ++c) { const int kc_ = 16 * nt + c; if (!((kc_ <= hi) && (kc_ > lo))) st[nt][c] = -1e30f; }
}
__device__ __forceinline__ void softmax_first(float& m, float& l, f32x4& negm, f32x4 (&st)[4]) {
    const float mx = rowq_max(max16(st));
    m = (mx > -1e29f) ? mx : 0.f; negm = (f32x4){-m, -m, -m, -m};
    float ps = 0.f;
#pragma unroll
    for (int nt = 0; nt < 4; ++nt)
#pragma unroll
        for (int c = 0; c < 4; ++c) { const float pp = fexp2(st[nt][c] - m); st[nt][c] = pp; ps += pp; }
    l = ps;
}
template <bool HAS_O>
__device__ __forceinline__ void softmax_next(float& m, float& l, f32x4& negm, f32x4 (&o)[4], f32x4 (&st)[4]) {
    const float mxl = max16(st);
    if (__builtin_amdgcn_ballot_w64(mxl > SM_THR) != 0ull) {
        const float mx = rowq_max(mxl); const float sh = (mx > SM_THR) ? mx : 0.f; const float a = fexp2(-sh);
        m += sh; l *= a; negm = (f32x4){-m, -m, -m, -m};
        if (HAS_O) {
#pragma unroll
            for (int d = 0; d < 4; ++d) o[d] = o[d] * a; }
#pragma unroll
        for (int nt = 0; nt < 4; ++nt)
#pragma unroll
            for (int c = 0; c < 4; ++c) st[nt][c] -= sh;
    }
    float ps = 0.f;
#pragma unroll
    for (int nt = 0; nt < 4; ++nt)
#pragma unroll
        for (int c = 0; c < 4; ++c) { const float pp = fexp2(st[nt][c]); st[nt][c] = pp; ps += pp; }
    l += ps;
}

__device__ __forceinline__ void phase_nsa(const Params& P, lds_t* lds) {
    unsigned char* ws = P.ws;
    const int wid = __builtin_amdgcn_readfirstlane(threadIdx.x >> 6);
    const int G = gridDim.x, g = blockIdx.x;
#define NSA_TID int tid = threadIdx.x; asm volatile("" : "+v"(tid));
#define NSA_LANE_VARS int lane_ = threadIdx.x & 63; asm volatile("" : "+v"(lane_)); const int r = lane_ & 15, q = lane_ >> 4;
    const bf16_t* Qb = (const bf16_t*)(ws + WS_Q);
    const float* GT = (const float*)(ws + WS_G);
    bf16_t* Y = (bf16_t*)(ws + WS_RA);
    LAS float* IMPA = (LAS float*)(lds + L_IMP);
    LAS float* IMPB = (LAS float*)(lds + L_IMP + 64 * IMPS * 4);
    LAS unsigned* SELM = (LAS unsigned*)(lds + L_SELM);
    LAS unsigned char* LIST = (LAS unsigned char*)(lds + L_LIST);
    LAS unsigned char* NJ = (LAS unsigned char*)(lds + L_NJ);
    const f32x4 NEGBIG = (f32x4){-1e30f, -1e30f, -1e30f, -1e30f};
    const f32x4 ZERO4 = (f32x4){0.f, 0.f, 0.f, 0.f};

    const int GQ = G >> 3;
    for (int k = 0;; ++k) {
        int jt, bk;
        if ((G & 7) == 0 && GQ > 0) { const int gi = g >> 3; const int u = (k & 1) ? (k + 1) * GQ - 1 - gi : k * GQ + gi; if (k * GQ >= 128) break; if (u >= 128) continue; jt = 127 - u; bk = g & 7; }
        else { const int idx = k * G + g; if (idx >= 1024) break; jt = 127 - (idx >> 3); bk = idx & 7; }
        const int b = bk >> 1, kvh = bk & 1, t0 = jt * 64;
        { NSA_TID
#pragma unroll
        for (int i = 0; i < 4; ++i) { const int row = (tid >> 3) + 64 * i, c = tid & 7, tok = row >> 2, hh = row & 3;
            lds_st16(lds + L_Q + lds_off(row, c), *(const u32x4*)(Qb + (size_t)(b * SEQ + t0 + tok) * 512 + kvh * 256 + hh * 64 + c * 8)); }
        if (tid < 256) SELM[tid] = 0u; }
        __syncthreads();
#define NSA_GATE(h_, br_) (GT[(size_t)(b * SEQ + t0 + ((32 * wid + 16 * (h_) + r) >> 2)) * 24 + (kvh * 4 + (r & 3)) * 3 + (br_)])
        { NSA_LANE_VARS NSA_TID
            const int nblk = (4 * jt + 3 + 63) >> 6;
            const int nfull = 4 * jt - 2;
            const unsigned goff = (unsigned)tid * 16u;
            const unsigned char* kcb = ws + WS_KCMP + (size_t)bk * 65536;
            const unsigned char* vcb = ws + WS_VCMPT + (size_t)bk * 65536;
            const int stw = lds_off(tid >> 3, tid & 7);
            bf16x8 yq[2][2]; int nlim[2]; float cm[2] = {0.f, 0.f}, cl[2] = {0.f, 0.f}; f32x4 negm[2] = {ZERO4, ZERO4};
#pragma unroll
            for (int h = 0; h < 2; ++h) { const int qrow = 32 * wid + 16 * h + r; nlim[h] = (t0 + (qrow >> 2) - 31) >> 4;
#pragma unroll
                for (int s = 0; s < 2; ++s) yq[h][s] = lds_ld16(lds + L_Q + lds_off(qrow, 4 * s + q)); }
            {
                u32x4 pk_ = *(const u32x4*)(kcb + goff);
#pragma unroll 1
                for (int blk = 0; blk < nblk; ++blk) {
                    lds_t* slot = lds + L_RING + (blk & 1) * 16384;
                    lds_st16(slot + stw, pk_);
                    if (blk + 1 < nblk) pk_ = *(const u32x4*)(kcb + (size_t)(blk + 1) * 8192 + goff);
                    __syncthreads();
                    QKFrag kf; lds_kfrag(kf, slot, r, q);
                    const bool edge = (64 * blk + 63 > nfull);
#pragma unroll
                    for (int h = 0; h < 2; ++h) {
                        f32x4 st[4], dummy[4];
                        if (blk == 0) { qk_tile_c(st, kf, yq[h], ZERO4); if (edge) mask16(st, -1000, nlim[h] - 4 * q); softmax_first(cm[h], cl[h], negm[h], st); }
                        else { qk_tile_c(st, kf, yq[h], negm[h]); if (edge) mask16(st, -1000, nlim[h] - 64 * blk - 4 * q); softmax_next<false>(cm[h], cl[h], negm[h], dummy, st); }
                    }
                }
            }
            float cil[2];
#pragma unroll
            for (int h = 0; h < 2; ++h) { const float l = rowq_sum(cl[h]); cil[h] = l > 0.f ? 1.f / l : 0.f; }
            __syncthreads();
            f32x4 oc[2][4];
#pragma unroll
            for (int h = 0; h < 2; ++h)
#pragma unroll
                for (int d = 0; d < 4; ++d) oc[h][d] = ZERO4;
            {
                u32x4 pk_ = *(const u32x4*)(kcb + goff), pv_ = *(const u32x4*)(vcb + goff);
#pragma unroll 1
                for (int blk = 0; blk < nblk; ++blk) {
                    lds_t* slot = lds + L_RING + (blk & 1) * 16384;
                    lds_st16(slot + stw, pk_); lds_st16(slot + 8192 + stw, pv_);
                    if (blk + 1 < nblk) { pk_ = *(const u32x4*)(kcb + (size_t)(blk + 1) * 8192 + goff); pv_ = *(const u32x4*)(vcb + (size_t)(blk + 1) * 8192 + goff); }
                    __syncthreads();
                    QKFrag kf; lds_kfrag(kf, slot, r, q);
                    const bool edge = (64 * blk + 63 > nfull);
                    f32x4 st[2][4];
#pragma unroll
                    for (int h = 0; h < 2; ++h) {
                        qk_tile_c(st[h], kf, yq[h], negm[h]);
                        if (edge) mask16(st[h], -1000, nlim[h] - 64 * blk - 4 * q);
                        const int tok = (32 * wid + 16 * h + r) >> 2;
#pragma unroll
                        for (int nt = 0; nt < 4; ++nt) {
#pragma unroll
                            for (int c = 0; c < 4; ++c) st[h][nt][c] = fexp2(st[h][nt][c]);
                            const float s4 = quad_sum(((st[h][nt][0] + st[h][nt][1]) + (st[h][nt][2] + st[h][nt][3])) * cil[h]), p3 = quad_sum(st[h][nt][3] * cil[h]);
                            if ((r & 3) == 0) { const int jj = 16 * blk + 4 * nt + q; IMPA[tok * IMPS + jj] = s4; IMPB[tok * IMPS + jj + 1] = p3; }
                        }
                    }
                    VFrag vf; lds_vfrag(vf, slot + 8192, r, q);
#pragma unroll
                    for (int h = 0; h < 2; ++h) pv_tile(oc[h], vf, st[h]);
                }
            }
#pragma unroll
            for (int h = 0; h < 2; ++h) { const int tok = (32 * wid + 16 * h + r) >> 2;
                bf16_t* yp = Y + (size_t)(b * SEQ + t0 + tok) * 1024 + 512 + (kvh * 4 + (r & 3)) * 64 + 4 * q;
                const float sc_ = NSA_GATE(h, 0) * cil[h];
#pragma unroll
                for (int d = 0; d < 4; ++d) *(u32x2*)(yp + 16 * d) = pk4(oc[h][d] * sc_); }
        }
        __syncthreads();
        const bool dense_all = (jt < 16);
        if (!dense_all) {
        { NSA_TID
            const int tok = tid >> 3, sub = tid & 7;
            unsigned flags = 0;
            {
                unsigned key[16];
#pragma unroll
                for (int i = 0; i < 16; ++i) { const int j = sub * 16 + i; const bool valid = (j >= 1 && j <= jt - 2);
                    const float v = IMPA[tok * IMPS + j] + IMPB[tok * IMPS + j]; key[i] = valid ? ((__float_as_uint(v) & 0xFFFFFF80u) | (unsigned)(127 - j)) : 0u; }
                unsigned tau = 0;
#pragma unroll 1
                for (int bit = 30; bit >= 0; --bit) {
                    const unsigned cand = tau | (1u << bit); int cnt = 0;
#pragma unroll
                    for (int i = 0; i < 16; ++i) cnt += (key[i] >= cand) ? 1 : 0;
                    cnt += dpp_i<0xB1>(cnt); cnt += dpp_i<0x4E>(cnt); cnt += dpp_i<0x141>(cnt);
                    if (cnt >= 13) tau = cand;
                }
#pragma unroll
                for (int i = 0; i < 16; ++i) if (key[i] != 0u && key[i] >= tau) flags |= 1u << i;
            }
#pragma unroll
            for (int i = 0; i < 16; ++i) if (flags & (1u << i)) lds_oru(&SELM[(sub * 16 + i) * 2 + (tok >> 5)], 1u << (tok & 31));
        }
        __syncthreads();
        { NSA_TID
            LAS unsigned short* LISTP = (LAS unsigned short*)(lds + L_LIST);
            const int p = tid >> 3, cls = tid & 7;
            if (p < 43 && cls < 7) {
                const int j0 = 1 + 3 * p;
                const unsigned long long A = ((unsigned long long)SELM[j0 * 2 + 1] << 32) | SELM[j0 * 2];
                const unsigned long long B = (j0 + 1 < 128) ? (((unsigned long long)SELM[(j0 + 1) * 2 + 1] << 32) | SELM[(j0 + 1) * 2]) : 0ull;
                const unsigned long long C = (j0 + 2 < 128) ? (((unsigned long long)SELM[(j0 + 2) * 2 + 1] << 32) | SELM[(j0 + 2) * 2]) : 0ull;
                int pos = 0; unsigned long long mine = 0ull; unsigned mkv = 0u;
#define NSA_CLS(K, M, V) { const unsigned long long cm_ = (M); if (cls > (K)) pos += __popcll(cm_); if (cls == (K)) { mine = cm_; mkv = (V); } }
                NSA_CLS(0, A & B & C, 7u) NSA_CLS(1, A & ~B & C, 5u) NSA_CLS(2, A & ~B & ~C, 1u) NSA_CLS(3, A & B & ~C, 3u) NSA_CLS(4, ~A & B & ~C, 2u) NSA_CLS(5, ~A & B & C, 6u) NSA_CLS(6, ~A & ~B & C, 4u)
#undef NSA_CLS
                while (mine) { const int t = __ffsll((long long)mine) - 1; LISTP[p * 64 + pos] = (unsigned short)((unsigned)t | (mkv << 8)); ++pos; mine &= mine - 1; }
                if (cls == 6) NJ[p] = (unsigned char)__popcll(A | B | C);
            }
        }
        __syncthreads();
        }
        { NSA_LANE_VARS NSA_TID
            const int nf = dense_all ? jt + 1 : 3;
            const int jb0 = jt >= 8 ? jt - 8 : 0, nb = jt - jb0 + 1, nd = nf + nb;
            const unsigned goff = (unsigned)tid * 16u;
            const unsigned char* ksb = ws + WS_KS + (size_t)bk * 1048576;
            const unsigned char* vsb = ws + WS_VST + (size_t)bk * 1048576;
            const unsigned char* kwb = ws + WS_KW + (size_t)bk * 1048576;
            const unsigned char* vwb = ws + WS_VWT + (size_t)bk * 1048576;
            const int stw = lds_off(tid >> 3, tid & 7);
            bf16x8 yq[2][2]; float wm_[2] = {0.f, 0.f}, wl[2] = {0.f, 0.f}, sm_[2] = {0.f, 0.f}, sl[2] = {0.f, 0.f};
            f32x4 ow[2][4], os[2][4];
#pragma unroll
            for (int h = 0; h < 2; ++h) { const int qrow = 32 * wid + 16 * h + r;
#pragma unroll
                for (int s = 0; s < 2; ++s) yq[h][s] = lds_ld16(lds + L_Q + lds_off(qrow, 4 * s + q));
#pragma unroll
                for (int d = 0; d < 4; ++d) { ow[h][d] = ZERO4; os[h][d] = ZERO4; } }
            auto item_blk = [&](int i) -> int { return i < nf ? (dense_all ? i : (i == 0 ? 0 : jt - 2 + i)) : jb0 + (i - nf); };
            u32x4 pk0, pv0;
            { const int j = item_blk(0); pk0 = *(const u32x4*)(ksb + (size_t)j * 8192 + goff); pv0 = *(const u32x4*)(vsb + (size_t)j * 8192 + goff); }
            auto dense_item = [&](lds_t* slot, float (&m)[2], float (&l)[2], f32x4 (&o)[2][4], bool first, bool dhi, bool dlo) {
                QKFrag kf; lds_kfrag(kf, slot, r, q);
                f32x4 st[2][4];
                const bool edge = dhi || dlo;
#pragma unroll
                for (int h = 0; h < 2; ++h) { if (first) qk_tile_c(st[h], kf, yq[h], ZERO4); else { const f32x4 ng = (f32x4){-m[h], -m[h], -m[h], -m[h]}; qk_tile_c(st[h], kf, yq[h], ng); } }
                if (edge) {
#pragma unroll
                    for (int h = 0; h < 2; ++h) { const int tok = (32 * wid + 16 * h + r) >> 2;
                        mask16(st[h], dlo ? (tok - 4 * q) : -1000, dhi ? (tok - 4 * q) : 1000); } }
                if (first) {
#pragma unroll
                    for (int h = 0; h < 2; ++h) { f32x4 ng; softmax_first(m[h], l[h], ng, st[h]); }
                } else {
                    const float mx0 = max16(st[0]), mx1 = max16(st[1]);
                    if (__builtin_amdgcn_ballot_w64(mx0 > SM_THR || mx1 > SM_THR) != 0ull) {
#pragma unroll
                        for (int h = 0; h < 2; ++h) { const float mx = rowq_max(h ? mx1 : mx0); const float sh = (mx > SM_THR) ? mx : 0.f; const float a_ = fexp2(-sh);
                            m[h] += sh; l[h] *= a_;
#pragma unroll
                            for (int d = 0; d < 4; ++d) o[h][d] = o[h][d] * a_;
#pragma unroll
                            for (int nt = 0; nt < 4; ++nt)
#pragma unroll
                                for (int c = 0; c < 4; ++c) st[h][nt][c] -= sh; }
                    }
                }
                VFrag vf; lds_vfrag(vf, slot + 8192, r, q);
#pragma unroll
                for (int h = 0; h < 2; ++h) {
                    if (!first) { float ps = 0.f;
#pragma unroll
                        for (int nt = 0; nt < 4; ++nt)
#pragma unroll
                            for (int c = 0; c < 4; ++c) { const float pp = fexp2(st[h][nt][c]); st[h][nt][c] = pp; ps += pp; }
                        l[h] += ps; }
                    pv_tile(o[h], vf, st[h]);
                }
            };
#pragma unroll 1
            for (int i = 0; i < nd; ++i) {
                lds_t* slot = lds + L_RING + (i & 1) * 16384;
                lds_st16(slot + stw, pk0); lds_st16(slot + 8192 + stw, pv0);
                if (i + 1 < nd) { const int j = item_blk(i + 1); const bool sn = (i + 1 < nf);
                    pk0 = *(const u32x4*)((sn ? ksb : kwb) + (size_t)j * 8192 + goff); pv0 = *(const u32x4*)((sn ? vsb : vwb) + (size_t)j * 8192 + goff); }
                __syncthreads();
                const int j = item_blk(i);
                if (i < nf) dense_item(slot, sm_, sl, os, i == 0, j == jt, false);
                else dense_item(slot, wm_, wl, ow, i == nf, j == jt, j == jt - 8);
            }
#pragma unroll
            for (int h = 0; h < 2; ++h) { const int qrow = 32 * wid + 16 * h + r; const int tok = qrow >> 2; const float l = rowq_sum(wl[h]); const float il = l > 0.f ? NSA_GATE(h, 2) / l : 0.f;
                bf16_t* yp = Y + (size_t)(b * SEQ + t0 + tok) * 1024 + 512 + (kvh * 4 + (r & 3)) * 64 + 4 * q;
#pragma unroll
                for (int d = 0; d < 4; ++d) { const u32x2 w = *(const u32x2*)(yp + 16 * d); f32x4 v = ow[h][d] * il; v[0] += bflo(w.x); v[1] += bfhi(w.x); v[2] += bflo(w.y); v[3] += bfhi(w.y); *(u32x2*)(yp + 16 * d) = pk4(v); }
                const float ls = rowq_sum(sl[h]);
                LAS float* orow = (LAS float*)(lds + L_OST) + qrow * OSS + 4 * q;
#pragma unroll
                for (int d = 0; d < 4; ++d) *(LAS f32x4*)(orow + 16 * d) = os[h][d];
                if (q == 0) { ((LAS float*)(lds + L_MS))[qrow] = sm_[h]; ((LAS float*)(lds + L_LS))[qrow] = ls; } }
        }
        __syncthreads();
        { NSA_LANE_VARS NSA_TID
            LAS float* MS = (LAS float*)(lds + L_MS); LAS float* LS = (LAS float*)(lds + L_LS);
            if (!dense_all) {
            const unsigned goff = (unsigned)tid * 16u;
            const unsigned char* ksb = ws + WS_KS + (size_t)bk * 1048576;
            const unsigned char* vsb = ws + WS_VST + (size_t)bk * 1048576;
            const int stw = lds_off(tid >> 3, tid & 7);
            const int jlast = jt - 2, nstep = jt / 3;
            const LAS unsigned short* LISTP = (const LAS unsigned short*)(lds + L_LIST);
            u32x4 pk[3], pv[3];
#pragma unroll
            for (int x = 0; x < 3; ++x) { const int jb = 1 + x < jlast ? 1 + x : jlast; pk[x] = *(const u32x4*)(ksb + (size_t)jb * 8192 + goff); pv[x] = *(const u32x4*)(vsb + (size_t)jb * 8192 + goff); }
#pragma unroll 1
            for (int p = 0; p < nstep; ++p) {
#pragma unroll
                for (int x = 0; x < 3; ++x) { lds_st16(lds + L_RING + x * 16384 + stw, pk[x]); lds_st16(lds + L_RING + x * 16384 + 8192 + stw, pv[x]); }
                if (p + 1 < nstep) {
#pragma unroll
                    for (int x = 0; x < 3; ++x) { int jb = 3 * p + 4 + x; jb = jb < jlast ? jb : jlast; pk[x] = *(const u32x4*)(ksb + (size_t)jb * 8192 + goff); pv[x] = *(const u32x4*)(vsb + (size_t)jb * 8192 + goff); } }
                __syncthreads();
                const int np = __builtin_amdgcn_readfirstlane((int)NJ[p]); const int nch = (np + 3) >> 2;
                const int c1 = (wid + 8 - (p & 7)) & 7;
#pragma unroll 1
                for (int c = c1; c < nch; c = (c < 8 ? 15 - c : 16)) {
                    const int ix = 4 * c + (r >> 2); const bool valid = ix < np;
                    const unsigned ent = LISTP[p * 64 + (valid ? ix : 0)];
                    const int tok = (int)(ent & 63u); const unsigned mk = valid ? (ent >> 8) : 0u;
                    const int qrow = tok * 4 + (r & 3);
                    bf16x8 yy[2];
#pragma unroll
                    for (int s2 = 0; s2 < 2; ++s2) yy[s2] = lds_ld16(lds + L_Q + lds_off(qrow, 4 * s2 + q));
                    float mref = MS[qrow];
                    LAS float* orow = (LAS float*)(lds + L_OST) + qrow * OSS + 4 * q;
                    f32x4 o[4]; float lacc = 0.f, asc = 1.f;
#pragma unroll
                    for (int d = 0; d < 4; ++d) o[d] = *(LAS f32x4*)(orow + 16 * d);
#pragma unroll
                    for (int x = 0; x < 3; ++x) {
                        const bool sel = ((mk >> x) & 1u) != 0u;
                        if (__builtin_amdgcn_ballot_w64(sel) == 0ull) continue;
                        lds_t* kslot = lds + L_RING + x * 16384;
                        QKFrag kf; lds_kfrag(kf, kslot, r, q);
                        VFrag vf; lds_vfrag(vf, kslot + 8192, r, q);
                        f32x4 st[4];
                        const f32x4 cin = sel ? (f32x4){-mref, -mref, -mref, -mref} : NEGBIG;
                        qk_tile_c(st, kf, yy, cin);
                        const float mxl = max16(st);
                        if (__builtin_amdgcn_ballot_w64(mxl > SM_THR) != 0ull) {
                            const float mx = rowq_max(mxl); const float sh = (mx > SM_THR) ? mx : 0.f; const float a = fexp2(-sh);
                            mref += sh; asc *= a; lacc *= a;
#pragma unroll
                            for (int d = 0; d < 4; ++d) o[d] = o[d] * a;
#pragma unroll
                            for (int nt = 0; nt < 4; ++nt)
#pragma unroll
                                for (int cc = 0; cc < 4; ++cc) st[nt][cc] -= sh;
                        }
                        float ps = 0.f;
#pragma unroll
                        for (int nt = 0; nt < 4; ++nt)
#pragma unroll
                            for (int cc = 0; cc < 4; ++cc) { const float pp = fexp2(st[nt][cc]); st[nt][cc] = pp; ps += pp; }
                        lacc += ps;
                        pv_tile(o, vf, st);
                    }
                    lacc = rowq_sum(lacc);
                    if (valid) {
#pragma unroll
                        for (int d = 0; d < 4; ++d) *(LAS f32x4*)(orow + 16 * d) = o[d];
                        if (q == 0) { LS[qrow] = LS[qrow] * asc + lacc; MS[qrow] = mref; } }
                }
                __syncthreads();
            }
            }
#pragma unroll
            for (int h = 0; h < 2; ++h) { const int qrow = 32 * wid + 16 * h + r; const int tok = qrow >> 2;
                const float l = LS[qrow]; const float il = l > 0.f ? NSA_GATE(h, 1) / l : 0.f;
                const LAS float* orow = (LAS float*)(lds + L_OST) + qrow * OSS + 4 * q;
                bf16_t* yp = Y + (size_t)(b * SEQ + t0 + tok) * 1024 + 512 + (kvh * 4 + (r & 3)) * 64 + 4 * q;
#pragma unroll
                for (int d = 0; d < 4; ++d) { const u32x2 w = *(const u32x2*)(yp + 16 * d); f32x4 v = *(const LAS f32x4*)(orow + 16 * d) * il; v[0] += bflo(w.x); v[1] += bfhi(w.x); v[2] += bflo(w.y); v[3] += bfhi(w.y); *(u32x2*)(yp + 16 * d) = pk4(v); } }
        }
        __syncthreads();
    }
#ifdef STEP_BENCH
    {
        const int tid = threadIdx.x; const unsigned goff = (unsigned)tid * 16u;
        const unsigned char* ksb = ws + WS_KS + (size_t)(blockIdx.x & 7) * 1048576;
        const int stw = lds_off(tid >> 3, tid & 7);
        u32x4 pkA = *(const u32x4*)(ksb + goff), pvA = *(const u32x4*)(ksb + 8192 + goff);
        int slot_c = 0;
        for (int j = 0; j < STEP_BENCH; ++j) {
            const int slot_n = (slot_c == 2) ? 0 : slot_c + 1;
            lds_st16(lds + L_RING + slot_n * 16384 + stw, pkA); lds_st16(lds + L_RING + slot_n * 16384 + 8192 + stw, pvA);
            pkA = *(const u32x4*)(ksb + (size_t)((j + 2) & 127) * 8192 + goff); pvA = *(const u32x4*)(ksb + (size_t)((j + 3) & 127) * 8192 + goff);
            __syncthreads();
            slot_c = slot_n;
        }
        if (pkA.x == 0x12345678u && pvA.y == 0x9abcdef0u) ((unsigned*)(ws + WS_CTL))[100] = 1;
        __syncthreads();
    }
#endif
#undef NSA_LANE_VARS
#undef NSA_TID
#undef NSA_GATE
}

__device__ __forceinline__ float wave_sum(float v) {
    v += dpp_f<0xB1>(v); v += dpp_f<0x4E>(v); v += dpp_f<0x141>(v); v += dpp_f<0x140>(v);
    return red32_sum(red16_sum(v));
}
__device__ __forceinline__ void ln_row(f32x4 (&v)[4], const f32x4 (&g)[4], const f32x4 (&bt)[4]) {
    float s = 0.f;
#pragma unroll
    for (int j = 0; j < 4; ++j) s += (v[j][0] + v[j][1]) + (v[j][2] + v[j][3]);
    const float mean = wave_sum(s) * (1.f / 1024.f);
    float ss = 0.f;
#pragma unroll
    for (int j = 0; j < 4; ++j) { v[j] = v[j] - mean; ss += (v[j][0] * v[j][0] + v[j][1] * v[j][1]) + (v[j][2] * v[j][2] + v[j][3] * v[j][3]); }
    const float rstd = rsqrtf(wave_sum(ss) * (1.f / 1024.f) + LN_EPS);
#pragma unroll
    for (int j = 0; j < 4; ++j) v[j] = v[j] * rstd * g[j] + bt[j];
}
__device__ __forceinline__ void split_store(bf16_t* hi, bf16_t* lo, f32x4 h) {
    const u32x2 ph = pk4(h);
    f32x4 res; res[0] = h[0] - bflo(ph.x); res[1] = h[1] - bfhi(ph.x); res[2] = h[2] - bflo(ph.y); res[3] = h[3] - bfhi(ph.y);
    *(u32x2*)hi = ph; *(u32x2*)lo = pk4(res);
}
__device__ __forceinline__ f32x4 split_load(const bf16_t* hi, const bf16_t* lo) {
    const u32x2 a = *(const u32x2*)hi, b = *(const u32x2*)lo;
    return (f32x4){bflo(a.x) + bflo(b.x), bfhi(a.x) + bfhi(b.x), bflo(a.y) + bflo(b.y), bfhi(a.y) + bfhi(b.y)};
}

__device__ __forceinline__ void panel_ln_stats(const f32x4 (&val)[8][4], int mt, int ct, unsigned* cnt, unsigned long long* xch, lds_t* scr, int wr, int wc, int r, int q) {
    LAS f32x2* Pp = (LAS f32x2*)scr;
    LAS f32x2* Ss = (LAS f32x2*)(scr + 8192);
    LAS unsigned* flag = (LAS unsigned*)(scr + 8192 + 2048);
    const int tid = threadIdx.x;
#pragma unroll
    for (int i = 0; i < 8; ++i) {
        float sacc = 0.f, sq = 0.f;
#pragma unroll
        for (int j = 0; j < 4; ++j) { const f32x4 v = val[i][j]; sacc += (v[0] + v[1]) + (v[2] + v[3]); sq += (v[0] * v[0] + v[1] * v[1]) + (v[2] * v[2] + v[3] * v[3]); }
        sacc = rowq_sum(sacc); sq = rowq_sum(sq);
        const float mw = sacc * (1.f / 64.f);
        if (q == 0) Pp[(wr * 128 + i * 16 + r) * 4 + wc] = (f32x2){mw, fmaxf(sq - sacc * mw, 0.f)};
        asm volatile("" ::: "memory");
    }
    __syncthreads();
    if (tid < 256) {
        const f32x2 a = Pp[tid * 4 + 0], b = Pp[tid * 4 + 1], c = Pp[tid * 4 + 2], d = Pp[tid * 4 + 3];
        const float m4 = (a.x + b.x + c.x + d.x) * 0.25f;
        const float da = a.x - m4, db = b.x - m4, dc = c.x - m4, dd = d.x - m4;
        const float m2 = (a.y + b.y) + (c.y + d.y) + 64.0f * ((da * da + db * db) + (dc * dc + dd * dd));
        __hip_atomic_store(xch + ((size_t)(mt * 256 + tid) * 4 + ct), ((unsigned long long)__float_as_uint(m2) << 32) | __float_as_uint(m4), __ATOMIC_RELAXED, __HIP_MEMORY_SCOPE_AGENT);
    }
    asm volatile("s_waitcnt vmcnt(0)" ::: "memory");
    __syncthreads();
    if (tid < 64) {
        if (tid == 0) __hip_atomic_fetch_add(cnt + 64 * mt, 1u, __ATOMIC_RELAXED, __HIP_MEMORY_SCOPE_AGENT);
        unsigned spins = 0;
        while ((unsigned)__builtin_amdgcn_readfirstlane(__hip_atomic_load(cnt + 64 * mt, __ATOMIC_RELAXED, __HIP_MEMORY_SCOPE_AGENT)) < 4u) { __builtin_amdgcn_s_sleep(2); if (++spins > (1u << 22)) break; }
        __builtin_amdgcn_fence(__ATOMIC_ACQUIRE, "agent");
        if (tid == 0) flag[0] = 1u;
    }
    asm volatile("s_waitcnt vmcnt(0) lgkmcnt(0)" ::: "memory");
    __syncthreads();
    if (tid < 256) {
        const unsigned long long* sl = xch + (size_t)(mt * 256 + tid) * 4; float mm[4], m2[4], ms = 0.f;
#pragma unroll
        for (int t = 0; t < 4; ++t) { const unsigned long long w = __hip_atomic_load(sl + t, __ATOMIC_RELAXED, __HIP_MEMORY_SCOPE_AGENT); mm[t] = __uint_as_float((unsigned)w); m2[t] = __uint_as_float((unsigned)(w >> 32)); ms += mm[t]; }
        const float mean = ms * 0.25f; float qq = 0.f;
#pragma unroll
        for (int t = 0; t < 4; ++t) { const float dm = mm[t] - mean; qq += m2[t] + 256.0f * dm * dm; }
        Ss[tid] = (f32x2){mean, rsqrtf(qq * (1.f / 1024.f) + LN_EPS)};
    }
    __syncthreads();
}

__device__ __forceinline__ void panel_ln_stats8(const g8::Acc& v, int mt, int ct, unsigned* cnt, unsigned long long* xch, lds_t* scr, int wr, int wc, int fr, int fq) {
    LAS f32x2* Pp = (LAS f32x2*)scr;
    LAS f32x2* Ss = (LAS f32x2*)(scr + 8192);
    const int tid = threadIdx.x;
#pragma unroll
    for (int ai = 0; ai < 2; ++ai)
#pragma unroll
        for (int m = 0; m < 4; ++m) {
            float sacc = 0.f;
#pragma unroll
            for (int bj = 0; bj < 2; ++bj)
#pragma unroll
                for (int n = 0; n < 2; ++n) { const f32x4 x = v[ai][bj][m][n]; sacc += (x[0] + x[1]) + (x[2] + x[3]); }
            sacc = rowq_sum(sacc);
            const float mw = sacc * (1.f / 64.f); float sq = 0.f;
#pragma unroll
            for (int bj = 0; bj < 2; ++bj)
#pragma unroll
                for (int n = 0; n < 2; ++n) { const f32x4 d = v[ai][bj][m][n] - mw; sq += (d[0] * d[0] + d[1] * d[1]) + (d[2] * d[2] + d[3] * d[3]); }
            sq = rowq_sum(sq);
            if (fq == 0) Pp[(ai * 128 + wr * 64 + m * 16 + fr) * 4 + wc] = (f32x2){mw, sq};
        }
    __syncthreads();
    if (tid < 256) {
        const f32x2 a = Pp[tid * 4 + 0], b = Pp[tid * 4 + 1], c = Pp[tid * 4 + 2], d = Pp[tid * 4 + 3];
        const float m4 = (a.x + b.x + c.x + d.x) * 0.25f;
        const float da = a.x - m4, db = b.x - m4, dc = c.x - m4, dd = d.x - m4;
        const float m2 = (a.y + b.y) + (c.y + d.y) + 64.0f * ((da * da + db * db) + (dc * dc + dd * dd));
        __hip_atomic_store(xch + ((size_t)(mt * 256 + tid) * 4 + ct), ((unsigned long long)__float_as_uint(m2) << 32) | __float_as_uint(m4), __ATOMIC_RELAXED, __HIP_MEMORY_SCOPE_AGENT);
    }
    asm volatile("s_waitcnt vmcnt(0)" ::: "memory");
    __syncthreads();
    if (tid < 64) {
        if (tid == 0) __hip_atomic_fetch_add(cnt + 64 * mt, 1u, __ATOMIC_RELAXED, __HIP_MEMORY_SCOPE_AGENT);
        unsigned spins = 0;
        while ((unsigned)__builtin_amdgcn_readfirstlane(__hip_atomic_load(cnt + 64 * mt, __ATOMIC_RELAXED, __HIP_MEMORY_SCOPE_AGENT)) < 4u) { __builtin_amdgcn_s_sleep(2); if (++spins > (1u << 22)) break; }
        __builtin_amdgcn_fence(__ATOMIC_ACQUIRE, "agent");
    }
    asm volatile("s_waitcnt vmcnt(0) lgkmcnt(0)" ::: "memory");
    __syncthreads();
    if (tid < 256) {
        const unsigned long long* sl = xch + (size_t)(mt * 256 + tid) * 4; float mm[4], m2[4], ms = 0.f;
#pragma unroll
        for (int t = 0; t < 4; ++t) { const unsigned long long w = __hip_atomic_load(sl + t, __ATOMIC_RELAXED, __HIP_MEMORY_SCOPE_AGENT); mm[t] = __uint_as_float((unsigned)w); m2[t] = __uint_as_float((unsigned)(w >> 32)); ms += mm[t]; }
        const float mean = ms * 0.25f; float qq = 0.f;
#pragma unroll
        for (int t = 0; t < 4; ++t) { const float dm = mm[t] - mean; qq += m2[t] + 256.0f * dm * dm; }
        Ss[tid] = (f32x2){mean, rsqrtf(qq * (1.f / 1024.f) + LN_EPS)};
    }
    __syncthreads();
}
__device__ __forceinline__ int ln_tile(int it) { const int G = gridDim.x, bid = blockIdx.x;
    if (G & 31) return bid + it * G;
    return it * G + (((bid & 7) + 8 * (bid >> 5)) << 2) + ((bid >> 3) & 3); }
struct SchedOne {
    const bf16_t* A; const bf16_t* W; int K, tile;
    __device__ __forceinline__ bool next(int i, g8::Unit& u) const { if (i > 0 || tile >= 128 * 4) return false; u.pm = tile >> 2; u.pn = tile & 3; return true; }
    __device__ __forceinline__ const char* a_base(const g8::Unit& u) const { return (const char*)(A + (size_t)u.pm * 256 * K); }
    __device__ __forceinline__ const char* b_base(const g8::Unit& u, int h) const { return (const char*)(W + (size_t)(u.pn * 256 + h * 128) * K); }
    __device__ __forceinline__ void a_offsets(const g8::Unit&, unsigned (&v)[2][2], int tid) const { g8::natural_offsets(v, K, tid); }
};

struct EpiOutLn1 {
    static constexpr bool AFTER_DRAIN = true;
    const bf16_t* xb; const float* gam; const float* bet; unsigned char* ws; lds_t* lds;
    __device__ __forceinline__ void init(g8::Acc& acc, const g8::Unit& u, int wr, int wc, int fr, int fq) const {
        const bf16_t* xp = xb + (size_t)(u.pm * 256 + wr * 64 + fr) * 1024 + u.pn * 256 + wc * 32 + 8 * fq;
#pragma unroll
        for (int ai = 0; ai < 2; ++ai)
#pragma unroll
            for (int m = 0; m < 4; ++m)
#pragma unroll
                for (int bj = 0; bj < 2; ++bj) acc[ai][bj][m][0] = __builtin_bit_cast(f32x4, *(const u32x4*)(xp + (size_t)(ai * 128 + m * 16) * 1024 + bj * 128));
    }
    __device__ __forceinline__ void post_prologue(g8::Acc& acc) const {
#pragma unroll
        for (int ai = 0; ai < 2; ++ai)
#pragma unroll
            for (int bj = 0; bj < 2; ++bj)
#pragma unroll
                for (int m = 0; m < 4; ++m) { const u32x4 w = __builtin_bit_cast(u32x4, acc[ai][bj][m][0]);
                    acc[ai][bj][m][0] = (f32x4){bflo(w.x), bfhi(w.x), bflo(w.y), bfhi(w.y)} * ALPHA; acc[ai][bj][m][1] = (f32x4){bflo(w.z), bfhi(w.z), bflo(w.w), bfhi(w.w)} * ALPHA; }
    }
    __device__ __forceinline__ void operator()(g8::Acc& acc, const g8::Unit& u, int wr, int wc, int fr, int fq) const {
        panel_ln_stats8(acc, u.pm, u.pn, (unsigned*)(ws + WS_CTL) + 8192, (unsigned long long*)(ws + WS_XCH1), lds, wr, wc, fr, fq);
        const LAS f32x2* Ss = (const LAS f32x2*)(lds + 8192);
        bf16_t* H1b = (bf16_t*)(ws + WS_H1B); bf16_t* H1lo = (bf16_t*)(ws + WS_H1LO);
        const int col0 = u.pn * 256 + wc * 32 + 8 * fq;
        f32x4 gg[2][2], bb[2][2];
#pragma unroll
        for (int bj = 0; bj < 2; ++bj)
#pragma unroll
            for (int n = 0; n < 2; ++n) { gg[bj][n] = *(const f32x4*)(gam + col0 + bj * 128 + 4 * n); bb[bj][n] = *(const f32x4*)(bet + col0 + bj * 128 + 4 * n); }
#pragma unroll
        for (int ai = 0; ai < 2; ++ai)
#pragma unroll
            for (int m = 0; m < 4; ++m) { const int rl = ai * 128 + wr * 64 + m * 16 + fr; const f32x2 st_ = Ss[rl]; const size_t ro = (size_t)(u.pm * 256 + rl) * 1024 + col0;
#pragma unroll
                for (int bj = 0; bj < 2; ++bj) {
                    const f32x4 h0 = (acc[ai][bj][m][0] - st_.x) * st_.y * gg[bj][0] + bb[bj][0], h1 = (acc[ai][bj][m][1] - st_.x) * st_.y * gg[bj][1] + bb[bj][1];
                    const u32x4 ph = pk8(h0, h1);
                    f32x4 r0, r1; r0[0] = h0[0] - bflo(ph.x); r0[1] = h0[1] - bfhi(ph.x); r0[2] = h0[2] - bflo(ph.y); r0[3] = h0[3] - bfhi(ph.y);
                    r1[0] = h1[0] - bflo(ph.z); r1[1] = h1[1] - bfhi(ph.z); r1[2] = h1[2] - bflo(ph.w); r1[3] = h1[3] - bfhi(ph.w);
                    *(u32x4*)(H1b + ro + bj * 128) = ph; *(u32x4*)(H1lo + ro + bj * 128) = pk8(r0, r1);
                    *(u32x2*)(ws + WS_RB + ro + bj * 128) = pk8_f8(h0, h1); } }
    }
};
__device__ __forceinline__ void phase_outproj_gemm(const Params& P, lds_t* lds) {
    for (int it = 0; ln_tile(it) < 128 * 4; ++it) { const int tile = ln_tile(it);
        SchedOne S{(const bf16_t*)(P.ws + WS_RA), (const bf16_t*)(P.ws + WS_WOUT), 1024, tile};
        EpiOutLn1 E{(const bf16_t*)(P.ws + WS_H1LO), P.in[11], P.in[12], P.ws, lds};
        g8::gemm_phase(lds, 1024, S, E);
        __syncthreads();
    }
}

constexpr int L4_LG = 98304;
constexpr int L4_LCNT = 131072;
constexpr int L4_GB = 131200;
constexpr int L4_AE = 131328;
constexpr int L4_AR = 132352;
constexpr int L4_AW = 133376;

__device__ __forceinline__ void phase_ln1_router(const Params& P, lds_t* lds) {
    unsigned char* ws = P.ws;
    int tid = threadIdx.x; asm volatile("" : "+v"(tid));
    const int lane = tid & 63, wid = __builtin_amdgcn_readfirstlane(tid >> 6), r = lane & 15, q = lane >> 4, sc = tid & 7, sr = tid >> 3;
    const bf16_t* Y = (const bf16_t*)(ws + WS_RA); const bf16_t* wt = (const bf16_t*)(ws + WS_WOUT);
    const float* x = P.in[0]; float* out = P.out; bf16_t* H1b = (bf16_t*)(ws + WS_H1B); bf16_t* H1lo = (bf16_t*)(ws + WS_H1LO);
    const bf16_t* WRB = (const bf16_t*)(ws + WS_WRB);
    int* gcount = (int*)(ws + WS_CTL);
    LAS float* LG = (LAS float*)(lds + L4_LG); LAS int* LCNT = (LAS int*)(lds + L4_LCNT); LAS int* GB = (LAS int*)(lds + L4_GB);
    LAS int* AE = (LAS int*)(lds + L4_AE); LAS int* AR = (LAS int*)(lds + L4_AR); LAS float* AW = (LAS float*)(lds + L4_AW);
    for (int panel = blockIdx.x; panel < 256; panel += gridDim.x) {
        const int row0 = panel * 128;
        if (tid < 32) LCNT[tid] = 0;
        __syncthreads();
        {
            f32x4 hacc[2][4];
            { const bf16_t* ap[2]; const bf16_t* bp[2];
#pragma unroll
              for (int i = 0; i < 2; ++i) ap[i] = H1b + (size_t)(row0 + sr + 64 * i) * 1024 + sc * 8;
              bp[0] = WRB + (size_t)sr * 3072 + sc * 8; bp[1] = WRB + (size_t)sr * 3072 + 1024 + sc * 8;
              gemm_mainloop<128, 128, 32, 64>(lds, ap, 64, bp, 16, hacc); }
            const int wm = wid >> 1, wn = wid & 1;
            if (wn == 0) {
#pragma unroll
                for (int i = 0; i < 2; ++i)
#pragma unroll
                    for (int j = 0; j < 4; ++j) *(LAS f32x4*)(LG + (wm * 32 + i * 16 + r) * 64 + j * 16 + 4 * q) = hacc[i][j]; }
            __syncthreads();
            if (wn == 1) {
#pragma unroll
                for (int i = 0; i < 2; ++i)
#pragma unroll
                    for (int j = 0; j < 4; ++j) { LAS f32x4* d_ = (LAS f32x4*)(LG + (wm * 32 + i * 16 + r) * 64 + j * 16 + 4 * q); *d_ = *d_ + hacc[i][j]; } }
            f32x4 racc[2][2];
            { const bf16_t* ap[2]; const bf16_t* bp[1];
#pragma unroll
              for (int i = 0; i < 2; ++i) ap[i] = H1lo + (size_t)(row0 + sr + 64 * i) * 1024 + sc * 8;
              bp[0] = WRB + (size_t)sr * 3072 + sc * 8;
              gemm_mainloop<128, 64, 32, 32>(lds, ap, 64, bp, 16, racc); }
#pragma unroll
            for (int i = 0; i < 2; ++i)
#pragma unroll
                for (int j = 0; j < 2; ++j) { LAS f32x4* d_ = (LAS f32x4*)(LG + (wm * 32 + i * 16 + r) * 64 + wn * 32 + j * 16 + 4 * q); *d_ = *d_ + racc[i][j]; }
        }
        __syncthreads();
        if (tid < 128) {
            const LAS float* lp = LG + tid * 64;
            const float* brg = P.in[14]; const float* bre = P.in[16];
            float g0 = lp[0] + brg[0]; int gs = 0; float gsum;
            { float gv[4]; gv[0] = g0;
#pragma unroll
              for (int i = 1; i < 4; ++i) { gv[i] = lp[i] + brg[i]; if (gv[i] > g0) { g0 = gv[i]; gs = i; } }
              gsum = 0.f;
#pragma unroll
              for (int i = 0; i < 4; ++i) gsum += __expf(gv[i] - g0); }
            const float gp = 1.f / gsum;
            float ev[8];
#pragma unroll
            for (int i = 0; i < 8; ++i) ev[i] = lp[4 + gs * 8 + i] + bre[gs * 8 + i];
            int i1 = 0; float e1 = ev[0];
#pragma unroll
            for (int i = 1; i < 8; ++i) if (ev[i] > e1) { e1 = ev[i]; i1 = i; }
            int i2 = -1; float e2 = -3.0e38f;
#pragma unroll
            for (int i = 0; i < 8; ++i) if (i != i1 && ev[i] > e2) { e2 = ev[i]; i2 = i; }
            const float x2 = __expf(e2 - e1); const float w1 = gp / (1.f + x2), w2 = gp * x2 / (1.f + x2);
            const int ea = gs * 8 + i1, eb = gs * 8 + i2;
            AE[tid * 2] = ea; AE[tid * 2 + 1] = eb; AW[tid * 2] = w1; AW[tid * 2 + 1] = w2;
            AR[tid * 2] = lds_addi(&LCNT[ea], 1); AR[tid * 2 + 1] = lds_addi(&LCNT[eb], 1);
        }
        __syncthreads();
        if (tid < 32) GB[tid] = atomicAdd(&gcount[tid], LCNT[tid]);
        __syncthreads();
        if (tid < 256) { const int row = tid >> 1, kk = tid & 1, e = AE[row * 2 + kk], slot = GB[e] + AR[row * 2 + kk]; const int tok = row0 + row;
            ((int*)(ws + WS_TOKL))[(size_t)e * 65536 + slot] = tok;
            ((int*)(ws + WS_ASGE))[tok * 2 + kk] = e; ((int*)(ws + WS_ASGS))[tok * 2 + kk] = slot; ((float*)(ws + WS_ASGW))[tok * 2 + kk] = AW[row * 2 + kk]; }
        __syncthreads();
    }
}

constexpr int L5_CNT = 131072;
constexpr int L5_RB = 131200;
constexpr int L5_TB = 131456;

__device__ __forceinline__ void moe_setup(const Params& P, lds_t* lds, int ncol) {
    LAS int* CNT = (LAS int*)(lds + L5_CNT); LAS int* RB = (LAS int*)(lds + L5_RB); LAS int* TB = (LAS int*)(lds + L5_TB);
    const int* gcount = (const int*)(P.ws + WS_CTL);
    int tid = threadIdx.x; asm volatile("" : "+v"(tid));
    if (tid < 32) CNT[tid] = gcount[tid];
    __syncthreads();
    if (tid == 0) { int rb = 0, tb = 0; for (int e = 0; e < 32; ++e) { RB[e] = rb; TB[e] = tb; rb += CNT[e]; tb += ((CNT[e] + 255) >> 8) * ncol; } RB[32] = rb; TB[32] = tb; }
    __syncthreads();
}

struct EpiPark {
    static constexpr bool AFTER_DRAIN = false;
    bf16_t* PLS;
    __device__ __forceinline__ void init(g8::Acc& acc, const g8::Unit&, int, int, int, int) const { g8::acc_zero(acc); }
    __device__ __forceinline__ void post_prologue(g8::Acc&) const {}
    __device__ __forceinline__ void operator()(g8::Acc& acc, const g8::Unit& u, int wr, int wc, int fr, int fq) const {
#pragma unroll
        for (int ai = 0; ai < 2; ++ai)
#pragma unroll
            for (int m = 0; m < 4; ++m) { const size_t ro = (size_t)(u.pm * 256 + ai * 128 + wr * 64 + m * 16 + fr) * 1024 + u.pn * 256 + wc * 32 + 8 * fq;
#pragma unroll
                for (int bj = 0; bj < 2; ++bj) *(u32x4*)(PLS + ro + bj * 128) = pk8(acc[ai][bj][m][0], acc[ai][bj][m][1]); }
    }
};
constexpr int PLE_CTR_WORD = 4096;
constexpr int L_PLEQ = 157200;
struct SchedPleRun {
    const bf16_t* A; const bf16_t* W; int t0, n;
    __device__ __forceinline__ bool next(int i, g8::Unit& u) const { const int tile = t0 + i; if (i >= n || tile >= 128 * 4) return false; u.pm = tile >> 2; u.pn = tile & 3; return true; }
    __device__ __forceinline__ const char* a_base(const g8::Unit& u) const { return (const char*)(A + (size_t)u.pm * 256 * 256); }
    __device__ __forceinline__ const char* b_base(const g8::Unit& u, int h) const { return (const char*)(W + (size_t)(u.pn * 256 + h * 128) * 256); }
    __device__ __forceinline__ void a_offsets(const g8::Unit&, unsigned (&v)[2][2], int tid) const { g8::natural_offsets(v, 256, tid); }
};
__device__ __forceinline__ void ple_fill(const Params& P, lds_t* lds, int n) {
    unsigned* ctr = (unsigned*)(P.ws + WS_CTL) + PLE_CTR_WORD;
    volatile LAS unsigned* qw = (volatile LAS unsigned*)(lds + L_PLEQ);
    int tid = threadIdx.x; asm volatile("" : "+v"(tid));
    if (tid == 0) qw[0] = atomicAdd(ctr, (unsigned)n);
    __syncthreads();
    const unsigned t = qw[0];
    __syncthreads();
    if (t >= 512u) return;
    SchedPleRun S{(const bf16_t*)(P.ws + WS_PB), (const bf16_t*)(P.ws + WS_WPLE), (int)t, n};
    EpiPark E{(bf16_t*)(P.ws + WS_H1LO)};
    g8::gemm_phase(lds, 256, S, E);
    __syncthreads();
}
constexpr int L5_UNIT = 131712;
constexpr int L5_TOKU = 132608;
constexpr int MAXU = 24;
__device__ __forceinline__ int moe_tile(int i, int ntile) { const int G = gridDim.x, bid = blockIdx.x;
    if ((G & 7) || i >= ntile / G) return bid + i * G;
    return (i * 8 + (bid & 7)) * (G >> 3) + (bid >> 3); }
__device__ __forceinline__ int moe_units(const Params& P, lds_t* lds, int first, bool want_tok) {
    LAS int* CNT = (LAS int*)(lds + L5_CNT); LAS int* RB = (LAS int*)(lds + L5_RB); LAS int* TB = (LAS int*)(lds + L5_TB);
    LAS int* UN = (LAS int*)(lds + L5_UNIT); LAS int* TOKU = (LAS int*)(lds + L5_TOKU);
    int tid = threadIdx.x; asm volatile("" : "+v"(tid));
    const int G = gridDim.x, bid = blockIdx.x;
    const int ntile = TB[32];
    int mine = 0; while (mine < 64 && moe_tile(mine, ntile) < ntile) ++mine;
    int nu = mine - first; nu = nu < 0 ? 0 : (nu > MAXU ? MAXU : nu);
    if (tid < nu) { const int tile = moe_tile(first + tid, ntile); int e = 0; while (TB[e + 1] <= tile) ++e;
        const int ne = CNT[e], MT = (ne + 255) >> 8, loc = tile - TB[e];
        UN[tid * 8 + 0] = e; UN[tid * 8 + 1] = loc / MT; UN[tid * 8 + 2] = loc % MT; UN[tid * 8 + 3] = ne; UN[tid * 8 + 4] = RB[e]; }
    __syncthreads();
    if (want_tok) { const int* TOKL = (const int*)(P.ws + WS_TOKL);
        for (int idx = tid; idx < nu * 256; idx += NTHREADS) { const int ui = idx >> 8, r = idx & 255; const int e = UN[ui * 8], mt = UN[ui * 8 + 2], ne = UN[ui * 8 + 3];
            int ix = mt * 256 + r; if (ix >= ne) ix = ne - 1; TOKU[idx] = TOKL[(size_t)e * 65536 + ix]; } }
    __syncthreads();
    return nu;
}
__device__ __forceinline__ bool moe_idle_last_round(lds_t* lds) {
    const int ntile = ((LAS int*)(lds + L5_TB))[32]; const int G = gridDim.x;
    const int rounds = (ntile + G - 1) / G;
    return rounds > 0 && moe_tile(rounds - 1, ntile) >= ntile;
}
template <bool DOWN> struct SchedMoeF8 {
    lds_t* lds; const unsigned char* A; const unsigned char* W; int nu;
    __device__ __forceinline__ bool next(int i, g8::Unit& u) const { if (i >= nu) return false; const LAS int* UN = (const LAS int*)(lds + L5_UNIT) + i * 8;
        u.e = __builtin_amdgcn_readfirstlane(UN[0]); u.pn = __builtin_amdgcn_readfirstlane(UN[1]); u.pm = __builtin_amdgcn_readfirstlane(UN[2]);
        u.ne = __builtin_amdgcn_readfirstlane(UN[3]); u.rb = __builtin_amdgcn_readfirstlane(UN[4]); u.idx = i; return true; }
    __device__ __forceinline__ const char* a_base(const g8::Unit&) const { return (const char*)A; }
    __device__ __forceinline__ const char* b_base(const g8::Unit& u, int h) const {
        if (DOWN) return (const char*)(W + (size_t)u.e * 1024 * 512 + (size_t)(u.pn * 256 + h * 128) * 512);
        return (const char*)(W + (size_t)u.e * 1024 * 1024 + (size_t)((h ? 512 : 0) + u.pn * 128) * 1024); }
    __device__ __forceinline__ void a_offsets(const g8::Unit& u, unsigned (&v)[2][2], int tid) const {
#pragma unroll
        for (int i = 0; i < 2; ++i) { int R, Cb; g8::f8_rc(tid, i, R, Cb);
#pragma unroll
            for (int h = 0; h < 2; ++h) {
                if (DOWN) { int ix = u.pm * 256 + h * 128 + R; if (ix >= u.ne) ix = u.ne - 1; v[h][i] = (unsigned)((u.rb + ix) * 512 + Cb); }
                else { const int tok = ((const LAS int*)(lds + L5_TOKU))[u.idx * 256 + h * 128 + R]; v[h][i] = (unsigned)(tok * 1024 + Cb); } } }
    }
};
template <bool DOWN> struct SchedMoe {
    lds_t* lds; const bf16_t* A; const bf16_t* W; int nu;
    __device__ __forceinline__ bool next(int i, g8::Unit& u) const { if (i >= nu) return false; const LAS int* UN = (const LAS int*)(lds + L5_UNIT) + i * 8;
        u.e = __builtin_amdgcn_readfirstlane(UN[0]); u.pn = __builtin_amdgcn_readfirstlane(UN[1]); u.pm = __builtin_amdgcn_readfirstlane(UN[2]);
        u.ne = __builtin_amdgcn_readfirstlane(UN[3]); u.rb = __builtin_amdgcn_readfirstlane(UN[4]); u.idx = i; return true; }
    __device__ __forceinline__ const char* a_base(const g8::Unit&) const { return (const char*)A; }
    __device__ __forceinline__ const char* b_base(const g8::Unit& u, int h) const {
        if (DOWN) return (const char*)(W + (size_t)u.e * 1024 * 512 + (size_t)(u.pn * 256 + h * 128) * 512);
        return (const char*)(W + (size_t)u.e * 1024 * 1024 + (size_t)((h ? 512 : 0) + u.pn * 128) * 1024); }
    __device__ __forceinline__ void a_offsets(const g8::Unit& u, unsigned (&v)[2][2], int tid) const {
#pragma unroll
        for (int i = 0; i < 2; ++i) { int R, C; g8::stage_rc(tid * 16 + i * 8192, R, C);
#pragma unroll
            for (int h = 0; h < 2; ++h) {
                if (DOWN) { int ix = u.pm * 256 + h * 128 + R; if (ix >= u.ne) ix = u.ne - 1; v[h][i] = (unsigned)((u.rb + ix) * 512 + C) * 2u; }
                else { const int tok = ((const LAS int*)(lds + L5_TOKU))[u.idx * 256 + h * 128 + R]; v[h][i] = (unsigned)(tok * 1024 + C) * 2u; } } }
    }
};
struct EpiMoeUp {
    static constexpr bool AFTER_DRAIN = false;
    bf16_t* HID;
    __device__ __forceinline__ void init(g8::Acc& acc, const g8::Unit&, int, int, int, int) const { g8::acc_zero(acc); }
    __device__ __forceinline__ void post_prologue(g8::Acc&) const {}
    __device__ __forceinline__ void operator()(g8::Acc& acc, const g8::Unit& u, int wr, int wc, int fr, int fq) const {
#pragma unroll
        for (int ai = 0; ai < 2; ++ai)
#pragma unroll
            for (int m = 0; m < 4; ++m) { const int ix = u.pm * 256 + ai * 128 + wr * 64 + m * 16 + fr;
                if (ix < u.ne) { f32x4 h0, h1;
#pragma unroll
                    for (int c = 0; c < 4; ++c) { const float g0 = acc[ai][0][m][0][c], g1 = acc[ai][0][m][1][c];
                        h0[c] = g0 * sigmoidf_(g0) * acc[ai][1][m][0][c]; h1[c] = g1 * sigmoidf_(g1) * acc[ai][1][m][1][c]; }
                    *(u32x2*)((unsigned char*)HID + (size_t)(u.rb + ix) * 512 + u.pn * 128 + wc * 32 + 8 * fq) = pk8_f8(h0, h1); } }
    }
};
struct EpiMoeDown {
    static constexpr bool AFTER_DRAIN = false;
    bf16_t* OA;
    __device__ __forceinline__ void init(g8::Acc& acc, const g8::Unit&, int, int, int, int) const { g8::acc_zero(acc); }
    __device__ __forceinline__ void post_prologue(g8::Acc&) const {}
    __device__ __forceinline__ void operator()(g8::Acc& acc, const g8::Unit& u, int wr, int wc, int fr, int fq) const {
#pragma unroll
        for (int ai = 0; ai < 2; ++ai)
#pragma unroll
            for (int m = 0; m < 4; ++m) { const int ix = u.pm * 256 + ai * 128 + wr * 64 + m * 16 + fr;
                if (ix < u.ne) {
#pragma unroll
                    for (int bj = 0; bj < 2; ++bj) *(u32x2*)((unsigned char*)OA + (size_t)(u.rb + ix) * 1024 + u.pn * 256 + bj * 128 + wc * 32 + 8 * fq) = pk8_f8(acc[ai][bj][m][0] * 4.f, acc[ai][bj][m][1] * 4.f); } }
    }
};

__device__ __forceinline__ void phase_moe1(const Params& P, lds_t* lds) {
    moe_setup(P, lds, 4);
    for (int first = 0;; first += MAXU) {
        const int nu = moe_units(P, lds, first, true);
        if (nu == 0) break;
        SchedMoeF8<false> S{lds, P.ws + WS_RB, P.ws + WS_WEIN, nu};
        EpiMoeUp E{(bf16_t*)(P.ws + WS_RA)};
        g8::gemm_phase_f8<123>(lds, 1024, S, E);
        __syncthreads();
    }
    if (moe_idle_last_round(lds)) ple_fill(P, lds, 2);
}

__device__ __forceinline__ void phase_moe2(const Params& P, lds_t* lds) {
    moe_setup(P, lds, 4);
    for (int first = 0;; first += MAXU) {
        const int nu = moe_units(P, lds, first, false);
        if (nu == 0) break;
        SchedMoeF8<true> S{lds, P.ws + WS_RA, P.ws + WS_WEOUT, nu};
        EpiMoeDown E{(bf16_t*)(P.ws + WS_RB)};
        g8::gemm_phase_f8<123>(lds, 512, S, E);
        __syncthreads();
    }
    if (moe_idle_last_round(lds)) ple_fill(P, lds, 1);
}

__device__ __forceinline__ void phase_ln2(const Params& P, lds_t* lds) {
    unsigned char* ws = P.ws;
    int tid = threadIdx.x; asm volatile("" : "+v"(tid));
    const int lane = tid & 63, wid = __builtin_amdgcn_readfirstlane(tid >> 6);
    LAS int* RB = (LAS int*)(lds + L5_RB);
    moe_setup(P, lds, 4);
    const bf16_t* OA = (const bf16_t*)(ws + WS_RB); bf16_t* H2b = (bf16_t*)(ws + WS_RA);
    const bf16_t* H1b = (const bf16_t*)(ws + WS_H1B); bf16_t* HLO = (bf16_t*)(ws + WS_H1LO);
    const int* ASGE = (const int*)(ws + WS_ASGE); const int* ASGS = (const int*)(ws + WS_ASGS); const float* ASGW = (const float*)(ws + WS_ASGW);
    f32x4 g[4], bt[4];
#pragma unroll
    for (int j = 0; j < 4; ++j) { g[j] = *(const f32x4*)(P.in[19] + 4 * lane + 256 * j); bt[j] = *(const f32x4*)(P.in[20] + 4 * lane + 256 * j); }
    for (int panel = blockIdx.x; panel < 256; panel += gridDim.x) {
        const int row0 = panel * 128;
        unsigned myo0 = 0, myo1 = 0; float myw0 = 0.f, myw1 = 0.f;
        if (lane < 16) { const int trow = row0 + 16 * wid + lane;
            const int e0 = ASGE[trow * 2], e1 = ASGE[trow * 2 + 1];
            myo0 = (unsigned)(RB[e0] + ASGS[trow * 2]) * 1024u; myo1 = (unsigned)(RB[e1] + ASGS[trow * 2 + 1]) * 1024u;
            myw0 = ASGW[trow * 2] * 0.25f; myw1 = ASGW[trow * 2 + 1] * 0.25f; }
#pragma unroll 2
        for (int rr = 0; rr < 16; ++rr) {
            const int trow = row0 + 16 * wid + rr;
            const size_t ro = (size_t)trow * 1024 + 4 * lane;
            const unsigned q0 = (unsigned)__shfl((int)myo0, rr), q1 = (unsigned)__shfl((int)myo1, rr);
            const float w0 = __shfl(myw0, rr), w1 = __shfl(myw1, rr);
            const unsigned char* o0 = (const unsigned char*)OA + (size_t)q0 + 4 * lane; const unsigned char* o1 = (const unsigned char*)OA + (size_t)q1 + 4 * lane;
            f32x4 v[4];
#pragma unroll
            for (int j = 0; j < 4; ++j) { const u32x2 hw = *(const u32x2*)(H1b + ro + 256 * j); const f32x4 h = (f32x4){bflo(hw.x), bfhi(hw.x), bflo(hw.y), bfhi(hw.y)}; const int a = *(const int*)(o0 + 256 * j), bq = *(const int*)(o1 + 256 * j);
                const f32x2 a01 = __builtin_amdgcn_cvt_pk_f32_fp8(a, false), a23 = __builtin_amdgcn_cvt_pk_f32_fp8(a, true), b01 = __builtin_amdgcn_cvt_pk_f32_fp8(bq, false), b23 = __builtin_amdgcn_cvt_pk_f32_fp8(bq, true);
                f32x4 f; f[0] = w0 * a01[0] + w1 * b01[0]; f[1] = w0 * a01[1] + w1 * b01[1]; f[2] = w0 * a23[0] + w1 * b23[0]; f[3] = w0 * a23[1] + w1 * b23[1];
                v[j] = h * ALPHA + f; }
            ln_row(v, g, bt);
#pragma unroll
            for (int j = 0; j < 4; ++j) *(u32x2*)(H2b + ro + 256 * j) = pk4(v[j]);
        }
    }
}

struct SchedPle {
    const bf16_t* A; const bf16_t* W; int G, c;
    __device__ __forceinline__ bool next(int i, g8::Unit& u) const { const int tile = c + i * G; if (tile >= 128 * 4) return false; u.pm = tile >> 2; u.pn = tile & 3; return true; }
    __device__ __forceinline__ const char* a_base(const g8::Unit& u) const { return (const char*)(A + (size_t)u.pm * 256 * 256); }
    __device__ __forceinline__ const char* b_base(const g8::Unit& u, int h) const { return (const char*)(W + (size_t)(u.pn * 256 + h * 128) * 256); }
    __device__ __forceinline__ void a_offsets(const g8::Unit&, unsigned (&v)[2][2], int tid) const { g8::natural_offsets(v, 256, tid); }
};
struct EpiGateLn3 {
    static constexpr bool AFTER_DRAIN = true;
    const bf16_t* H2b; const bf16_t* PLS; const float* bg; const float* gam; const float* bet; float* out; unsigned char* ws; lds_t* lds;
    __device__ __forceinline__ void init(g8::Acc& acc, const g8::Unit&, int, int, int, int) const { g8::acc_zero(acc); }
    __device__ __forceinline__ void post_prologue(g8::Acc&) const {}
    __device__ __forceinline__ void operator()(g8::Acc& acc, const g8::Unit& u, int wr, int wc, int fr, int fq) const {
        const int col0 = u.pn * 256 + wc * 32 + 8 * fq;
        {
            f32x4 bv[2][2];
#pragma unroll
            for (int bj = 0; bj < 2; ++bj)
#pragma unroll
                for (int n = 0; n < 2; ++n) bv[bj][n] = *(const f32x4*)(bg + col0 + bj * 128 + 4 * n);
#pragma unroll
            for (int ai = 0; ai < 2; ++ai)
#pragma unroll
                for (int m = 0; m < 4; ++m) { const size_t ro = (size_t)(u.pm * 256 + ai * 128 + wr * 64 + m * 16 + fr) * 1024 + col0;
#pragma unroll
                    for (int bj = 0; bj < 2; ++bj) {
                        const u32x4 hw = *(const u32x4*)(H2b + ro + bj * 128); const u32x4 pl = *(const u32x4*)(PLS + ro + bj * 128);
                        const f32x4 g0 = acc[ai][bj][m][0] + bv[bj][0], g1 = acc[ai][bj][m][1] + bv[bj][1];
                        f32x4 o0, o1;
                        o0[0] = bflo(hw.x) * ALPHA + bflo(pl.x) * sigmoidf_(g0[0]); o0[1] = bfhi(hw.x) * ALPHA + bfhi(pl.x) * sigmoidf_(g0[1]); o0[2] = bflo(hw.y) * ALPHA + bflo(pl.y) * sigmoidf_(g0[2]); o0[3] = bfhi(hw.y) * ALPHA + bfhi(pl.y) * sigmoidf_(g0[3]);
                        o1[0] = bflo(hw.z) * ALPHA + bflo(pl.z) * sigmoidf_(g1[0]); o1[1] = bfhi(hw.z) * ALPHA + bfhi(pl.z) * sigmoidf_(g1[1]); o1[2] = bflo(hw.w) * ALPHA + bflo(pl.w) * sigmoidf_(g1[2]); o1[3] = bfhi(hw.w) * ALPHA + bfhi(pl.w) * sigmoidf_(g1[3]);
                        acc[ai][bj][m][0] = o0; acc[ai][bj][m][1] = o1; }
                    asm volatile("" : "+v"(acc[ai][0][m][0]), "+v"(acc[ai][0][m][1]), "+v"(acc[ai][1][m][0]), "+v"(acc[ai][1][m][1]));
                    asm volatile("" ::: "memory"); }
        }
        panel_ln_stats8(acc, u.pm, u.pn, (unsigned*)(ws + WS_CTL) + 20480, (unsigned long long*)(ws + WS_XCH3), lds, wr, wc, fr, fq);
        const LAS f32x2* Ss = (const LAS f32x2*)(lds + 8192);
        f32x4 gg[2][2], bb[2][2];
#pragma unroll
        for (int bj = 0; bj < 2; ++bj)
#pragma unroll
            for (int n = 0; n < 2; ++n) { gg[bj][n] = *(const f32x4*)(gam + col0 + bj * 128 + 4 * n); bb[bj][n] = *(const f32x4*)(bet + col0 + bj * 128 + 4 * n); }
#pragma unroll
        for (int ai = 0; ai < 2; ++ai)
#pragma unroll
            for (int m = 0; m < 4; ++m) { const int rl = ai * 128 + wr * 64 + m * 16 + fr; const f32x2 st_ = Ss[rl]; float* op = out + (size_t)(u.pm * 256 + rl) * 1024 + col0;
#pragma unroll
                for (int bj = 0; bj < 2; ++bj)
#pragma unroll
                    for (int n = 0; n < 2; ++n) *(f32x4*)(op + bj * 128 + 4 * n) = (acc[ai][bj][m][n] - st_.x) * st_.y * gg[bj][n] + bb[bj][n]; }
    }
};
__device__ __forceinline__ void phase_ple_gemm(const Params& P, lds_t* lds) {
    unsigned char* ws = P.ws;
    {
        const unsigned cv = ((const unsigned*)(ws + WS_CTL))[PLE_CTR_WORD]; const int done = cv < 512u ? (int)cv : 512;
        SchedPle S{(const bf16_t*)(ws + WS_PB), (const bf16_t*)(ws + WS_WPLE), (int)gridDim.x, done + (int)blockIdx.x};
        EpiPark E{(bf16_t*)(ws + WS_H1LO)};
        g8::gemm_phase(lds, 256, S, E);
        __syncthreads();
    }
    for (int it = 0; ln_tile(it) < 128 * 4; ++it) { const int tile = ln_tile(it);
        SchedOne S{(const bf16_t*)(ws + WS_RA), (const bf16_t*)(ws + WS_WPG), 1024, tile};
        EpiGateLn3 E{(const bf16_t*)(ws + WS_RA), (const bf16_t*)(ws + WS_H1LO), P.in[23], P.in[24], P.in[25], P.out, ws, lds};
        g8::gemm_phase(lds, 1024, S, E);
        __syncthreads();
    }
}

__device__ __forceinline__ void phase_ln3(const Params& P, lds_t* lds) {
    int tid = threadIdx.x; asm volatile("" : "+v"(tid));
    const int lane = tid & 63, wid = __builtin_amdgcn_readfirstlane(tid >> 6);
    float* out = P.out;
    f32x4 g[4], bt[4];
#pragma unroll
    for (int j = 0; j < 4; ++j) { g[j] = *(const f32x4*)(P.in[24] + 4 * lane + 256 * j); bt[j] = *(const f32x4*)(P.in[25] + 4 * lane + 256 * j); }
    for (int panel = blockIdx.x; panel < 256; panel += gridDim.x) {
        const int row0 = panel * 128;
#pragma unroll 1
        for (int rr = 0; rr < 16; ++rr) {
            const size_t ro = (size_t)(row0 + 16 * wid + rr) * 1024 + 4 * lane;
            f32x4 v[4];
#pragma unroll
            for (int j = 0; j < 4; ++j) v[j] = *(const f32x4*)(out + ro + 256 * j);
            ln_row(v, g, bt);
#pragma unroll
            for (int j = 0; j < 4; ++j) *(f32x4*)(out + ro + 256 * j) = v[j];
        }
    }
}

#define XB_TMO      128
#define XB_XCNT(j)  (256  + 64 * (j))
#define XB_XSUB(j)  (1280 + 64 * (j))
#define XB_XGEN(j)  (2304 + 64 * (j))
#define XB_TOP      3328
#define XB_TOPGEN   3392
#define XCD_BAR_WORDS 3456
#define XB_SPIN_CAP (1u << 18)

__device__ __forceinline__ unsigned xb_ld(unsigned* p)              { return __hip_atomic_load(p, __ATOMIC_RELAXED, __HIP_MEMORY_SCOPE_AGENT); }
__device__ __forceinline__ unsigned xb_add(unsigned* p, unsigned v) { return __hip_atomic_fetch_add(p, v, __ATOMIC_RELAXED, __HIP_MEMORY_SCOPE_AGENT); }
__device__ __forceinline__ unsigned xb_xcc_id() { return (unsigned)__builtin_amdgcn_s_getreg((3 << 11) | 20) & 0xFu; }
#define XB_SPIN(cond, bar) do { unsigned _sp = 0; while (cond) { __builtin_amdgcn_s_sleep(1); \
    if ((++_sp & 255u) == 0u) { if (xb_ld(&(bar)[XB_TMO])) break; if (_sp > XB_SPIN_CAP) { atomicAdd(&(bar)[XB_TMO], 1u); break; } } } } while (0)

struct XcdBarrier {
    unsigned* bar; unsigned x;
    volatile LAS unsigned* st;
};

__device__ __forceinline__ XcdBarrier xcd_barrier_post(unsigned* bar, volatile LAS unsigned* st) {
    XcdBarrier b; b.bar = bar; b.x = xb_xcc_id(); b.st = st;
    if (threadIdx.x == 0) (void)xb_add(&bar[XB_XCNT(b.x)], 1u);
    return b;
}
__device__ __forceinline__ void xcd_barrier_complete(unsigned* bar, unsigned x, unsigned& nloc, unsigned& nx) {
    const unsigned G = gridDim.x * gridDim.y * gridDim.z;
    unsigned sum, cnt, mine, sp = 0u;
    for (;;) {
        sum = 0u; cnt = 0u; mine = 0u;
#pragma unroll
        for (unsigned j = 0; j < 16; ++j) { const unsigned c = xb_ld(&bar[XB_XCNT(j)]); sum += c; cnt += (c > 0u) ? 1u : 0u; mine = (j == x) ? c : mine; }
        if (sum == G) break;
        __builtin_amdgcn_s_sleep(1);
        if ((++sp & 255u) == 0u) { if (xb_ld(&bar[XB_TMO])) break; if (sp > XB_SPIN_CAP) { atomicAdd(&bar[XB_TMO], 1u); break; } }
    }
    nloc = mine > 0u ? mine : 1u; nx = cnt > 0u ? cnt : 1u;
}

__device__ __forceinline__ void xcd_barrier(const XcdBarrier& b) {
    asm volatile("s_waitcnt vmcnt(0)" ::: "memory");
    __syncthreads();
    if (threadIdx.x == 0) {
        unsigned* bar = b.bar;
        __builtin_amdgcn_s_waitcnt(0);
        unsigned nloc = b.st[0], nx = b.st[1];
        if (nloc == 0u) { xcd_barrier_complete(bar, b.x, nloc, nx); b.st[0] = nloc; b.st[1] = nx; }
        const unsigned old = xb_add(&bar[XB_XSUB(b.x)], 1u);
        const unsigned gen = old / nloc;
        if (old + 1u == (gen + 1u) * nloc) {
            __builtin_amdgcn_fence(__ATOMIC_RELEASE, "agent");
            asm volatile("s_waitcnt vmcnt(0)" ::: "memory");
            const unsigned og = xb_add(&bar[XB_TOP], 1u);
            const unsigned tg = og / nx;
            if (og + 1u == (tg + 1u) * nx) xb_add(&bar[XB_TOPGEN], 1u);
            else XB_SPIN(xb_ld(&bar[XB_TOPGEN]) == tg, bar);
            __builtin_amdgcn_fence(__ATOMIC_ACQUIRE, "agent");
            xb_add(&bar[XB_XGEN(b.x)], 1u);
            asm volatile("s_waitcnt vmcnt(0)" ::: "memory");
        } else {
            XB_SPIN(xb_ld(&bar[XB_XGEN(b.x)]) == gen, bar);
            __builtin_amdgcn_fence(__ATOMIC_ACQUIRE, "agent");
            asm volatile("s_waitcnt vmcnt(0)" ::: "memory");
        }
    }
    __syncthreads();
}

#ifndef USE_CG_SYNC
#define USE_CG_SYNC 0
#endif
constexpr size_t WS_BAR = 65536;
constexpr size_t CTL_ZERO_BYTES = 131072;
__global__ void __launch_bounds__(NTHREADS) fwd_kernel(Params P) {
    extern __shared__ __attribute__((aligned(16))) unsigned char smem[];
    lds_t* lds = (lds_t*)smem;
    const int lo = P.ph_lo, hi = P.ph_hi;
#if !USE_CG_SYNC
    volatile LAS unsigned* bst = (volatile LAS unsigned*)(lds + LDS_BYTES - 16);
    if (threadIdx.x < 2) bst[threadIdx.x] = 0u;
    __syncthreads();
    XcdBarrier bar; bar.bar = (unsigned*)(P.ws + WS_BAR); bar.x = 0; bar.st = nullptr;
    if (hi - lo > 1) bar = xcd_barrier_post((unsigned*)(P.ws + WS_BAR), bst);
#define GRID_SYNC() xcd_barrier(bar)
#else
#define GRID_SYNC() cg::this_grid().sync()
#endif
#ifndef ONLY_PHASE
#define ONLY_PHASE -1
#endif
#ifndef REPEAT_PHASE
#define REPEAT_PHASE -1
#endif
#define PHASE(k, fn) if ((ONLY_PHASE < 0 || ONLY_PHASE == (k)) && lo <= (k) && (k) < hi) { int nrep_ = (REPEAT_PHASE == (k)) ? 2 : 1; asm volatile("" : "+s"(nrep_)); for (int rep_ = 0; rep_ < nrep_; ++rep_) { fn(P, lds); __syncthreads(); } if ((k) + 1 < hi) { GRID_SYNC(); } }
    PHASE(0, phase_prep)
    PHASE(1, phase_inproj)
    PHASE(2, phase_conv_compress)
    PHASE(3, phase_nsa)
    PHASE(4, phase_outproj_gemm)
    PHASE(5, phase_ln1_router)
    PHASE(6, phase_moe1)
    PHASE(7, phase_moe2)
    PHASE(8, phase_ln2)
    PHASE(9, phase_ple_gemm)
#undef PHASE
}

extern "C" void kernel_launch(void* const* d_in, const int* in_sizes, int n_in, void* d_out, int out_size, void* d_ws, size_t ws_size, hipStream_t stream) {
    static int grid = 0;
    if (grid == 0) {
        if (n_in != 26 || ws_size < WS_END) { fprintf(stderr, "kernel_launch: unexpected n_in %d or ws_size %zu (< %zu)\n", n_in, ws_size, (size_t)WS_END); grid = -1; return; }
        int dev = 0, cus = 0, per_cu = 0;
        (void)hipGetDevice(&dev);
        (void)hipDeviceGetAttribute(&cus, hipDeviceAttributeMultiprocessorCount, dev);
        (void)hipFuncSetAttribute((const void*)fwd_kernel, hipFuncAttributeMaxDynamicSharedMemorySize, LDS_BYTES);
        (void)hipOccupancyMaxActiveBlocksPerMultiprocessor(&per_cu, (const void*)fwd_kernel, NTHREADS, LDS_BYTES);
        if (per_cu < 1) { fprintf(stderr, "kernel_launch: occupancy query says %d blocks per CU\n", per_cu); per_cu = 1; }
        grid = cus & ~3;
        (void)hipGetLastError();
    }
    if (grid < 0) return;
    Params p{};
    for (int i = 0; i < 26; ++i) p.in[i] = (const float*)d_in[i];
    p.out = (float*)d_out; p.ws = (unsigned char*)d_ws;
#if N_LAUNCH_SPLIT
    for (int ph = 0; ph < 10; ++ph) { p.ph_lo = ph; p.ph_hi = ph + 1; hipLaunchKernelGGL(fwd_kernel, dim3(grid), dim3(NTHREADS), LDS_BYTES, stream, p); }
#else
    p.ph_lo = 0; p.ph_hi = 10;
#if USE_CG_SYNC
    void* args[] = {&p};
    hipError_t e = hipLaunchCooperativeKernel((const void*)fwd_kernel, dim3(grid), dim3(NTHREADS), args, LDS_BYTES, stream);
    if (e != hipSuccess) fprintf(stderr, "cooperative launch failed: %s (grid %d)\n", hipGetErrorString(e), grid);
#else
    if (hipMemsetAsync((char*)d_ws + WS_CTL, 0, CTL_ZERO_BYTES, stream) != hipSuccess) { fprintf(stderr, "kernel_launch: hipMemsetAsync failed\n"); return; }
    hipLaunchKernelGGL(fwd_kernel, dim3(grid), dim3(NTHREADS), LDS_BYTES, stream, p);
#endif
#endif
}
```

```cpp
#include <hip/hip_runtime.h>
#include <hip/hip_cooperative_groups.h>
#include <cstdio>
#include <cstdint>
namespace cg = cooperative_groups;

#ifndef N_LAUNCH_SPLIT
#define N_LAUNCH_SPLIT 0
#endif

#define LAS __attribute__((address_space(3)))
typedef unsigned short bf16_t;
typedef short bf16x8 __attribute__((ext_vector_type(8)));
typedef float f32x4 __attribute__((ext_vector_type(4)));
typedef float f32x2 __attribute__((ext_vector_type(2)));
typedef unsigned u32x4 __attribute__((ext_vector_type(4)));
typedef unsigned u32x2 __attribute__((ext_vector_type(2)));
typedef __bf16 bf16x2_t __attribute__((ext_vector_type(2)));
typedef LAS unsigned char lds_t;

constexpr int NBATCH = 4, SEQ = 8192, T = NBATCH * SEQ, DM = 1024;
constexpr int NTHREADS = 512;
constexpr float ALPHA = 1.189207115002721f;
constexpr float LN_EPS = 1e-5f;
constexpr float QSCALE = 0.125f * 1.4426950408889634f;
constexpr int NIN_PAD = 3072;
constexpr int LDS_BYTES = 163840;

constexpr size_t MiB = 1u << 20;
constexpr size_t WS_CTL = 0;
constexpr size_t WS_WIN = 1 * MiB;
constexpr size_t WS_WOUT = 7 * MiB;
constexpr size_t WS_WPG = 9 * MiB;
constexpr size_t WS_WPLE = 11 * MiB;
constexpr size_t WS_W1CK = 12 * MiB;
constexpr size_t WS_W1CV = 12 * MiB + 512 * 1024;
constexpr size_t WS_W2CK = 13 * MiB;
constexpr size_t WS_W2CV = 13 * MiB + 64 * 1024;
constexpr size_t WS_BIAS1 = 13 * MiB + 128 * 1024;
constexpr size_t WS_WRB = 13 * MiB + 256 * 1024;
constexpr size_t WS_WEIN = 14 * MiB;
constexpr size_t WS_WEOUT = 78 * MiB;
constexpr size_t WS_PB = 110 * MiB;
constexpr size_t WS_G = 126 * MiB;
constexpr size_t WS_KCMP = 129 * MiB;
constexpr size_t WS_VCMPT = 129 * MiB + 512 * 1024;
constexpr size_t WS_ASGE = 130 * MiB;
constexpr size_t WS_ASGS = 130 * MiB + 256 * 1024;
constexpr size_t WS_ASGW = 130 * MiB + 512 * 1024;
constexpr size_t WS_TOKL = 131 * MiB;
constexpr size_t WS_H1B = 140 * MiB;
constexpr size_t WS_RA = 204 * MiB;
constexpr size_t WS_RB = 276 * MiB;
constexpr size_t WS_U = WS_RB, WS_CB = WS_RB + 32 * MiB, WS_Q = WS_RB + 64 * MiB, WS_KC = WS_RB + 96 * MiB, WS_VC = WS_RB + 104 * MiB;
constexpr size_t WS_KS = WS_RB + 112 * MiB, WS_VST = WS_RB + 120 * MiB, WS_KW = WS_RB + 128 * MiB, WS_VWT = WS_RB + 136 * MiB;
constexpr size_t WS_H1LO = 420 * MiB;
constexpr size_t WS_XCH1 = 484 * MiB;
constexpr size_t WS_XCH3 = 485 * MiB;
constexpr size_t WS_END = 486 * MiB;

struct Params {
    const float* in[26];
    float* out;
    unsigned char* ws;
    int ph_lo, ph_hi;
};

__device__ __forceinline__ unsigned pk2(float lo, float hi) { f32x2 v = {lo, hi}; bf16x2_t b = __builtin_convertvector(v, bf16x2_t); return __builtin_bit_cast(unsigned, b); }
__device__ __forceinline__ bf16_t f2bf(float f) { return (bf16_t)(pk2(f, 0.f) & 0xffffu); }
__device__ __forceinline__ float bf2f(unsigned h) { return __uint_as_float(h << 16); }
__device__ __forceinline__ float bflo(unsigned w) { return __uint_as_float(w << 16); }
__device__ __forceinline__ float bfhi(unsigned w) { return __uint_as_float(w & 0xffff0000u); }
__device__ __forceinline__ u32x2 pk4(f32x4 v) { u32x2 o; o.x = pk2(v[0], v[1]); o.y = pk2(v[2], v[3]); return o; }
__device__ __forceinline__ unsigned pk4_f8(float a, float b, float c, float d) { int w = 0; w = __builtin_amdgcn_cvt_pk_fp8_f32(a, b, w, false); w = __builtin_amdgcn_cvt_pk_fp8_f32(c, d, w, true); return (unsigned)w; }
__device__ __forceinline__ u32x2 pk8_f8(f32x4 a, f32x4 b) { u32x2 o; o.x = pk4_f8(a[0], a[1], a[2], a[3]); o.y = pk4_f8(b[0], b[1], b[2], b[3]); return o; }
__device__ __forceinline__ u32x4 pk8(f32x4 a, f32x4 b) { u32x4 o; o.x = pk2(a[0], a[1]); o.y = pk2(a[2], a[3]); o.z = pk2(b[0], b[1]); o.w = pk2(b[2], b[3]); return o; }
__host__ __device__ __forceinline__ int perm64(int n) { return (n & ~63) | (((n >> 2) & 3) << 4) | (((n >> 4) & 3) << 2) | (n & 3); }
__device__ __forceinline__ float fexp2(float x) { return __builtin_amdgcn_exp2f(x); }
__device__ __forceinline__ float sigmoidf_(float x) { return __builtin_amdgcn_rcpf(1.0f + __expf(-x)); }
__device__ __forceinline__ int lds_off(int row, int chunk) { return row * 128 + ((chunk ^ ((row >> 1) & 7)) << 4); }
__device__ __forceinline__ bf16x8 lds_ld16(lds_t* p) { return *(LAS bf16x8*)p; }
__device__ __forceinline__ void lds_st16(lds_t* p, u32x4 v) { *(LAS u32x4*)p = v; }
__device__ __forceinline__ bf16x8 gld16(const bf16_t* p) { return *(const bf16x8*)p; }
__device__ __forceinline__ f32x4 mfma16(bf16x8 a, bf16x8 b, f32x4 c) { return __builtin_amdgcn_mfma_f32_16x16x32_bf16(a, b, c, 0, 0, 0); }
__device__ __forceinline__ int fenc(float f) { int b = __float_as_int(f); return b >= 0 ? b : (b ^ 0x7fffffff); }
__device__ __forceinline__ float fdec(int b) { return __int_as_float(b >= 0 ? b : (b ^ 0x7fffffff)); }
__device__ __forceinline__ float sx(float v, int m) { return __shfl_xor(v, m); }

__device__ __forceinline__ void lds_addf(LAS float* p, float v) { (void)__hip_atomic_fetch_add(p, v, __ATOMIC_RELAXED, __HIP_MEMORY_SCOPE_WORKGROUP); }
__device__ __forceinline__ void lds_addi_nr(LAS int* p, int v) { (void)__hip_atomic_fetch_add(p, v, __ATOMIC_RELAXED, __HIP_MEMORY_SCOPE_WORKGROUP); }
__device__ __forceinline__ int lds_addi(LAS int* p, int v) { return __hip_atomic_fetch_add(p, v, __ATOMIC_RELAXED, __HIP_MEMORY_SCOPE_WORKGROUP); }
__device__ __forceinline__ void lds_maxi(LAS int* p, int v) { (void)__hip_atomic_fetch_max(p, v, __ATOMIC_RELAXED, __HIP_MEMORY_SCOPE_WORKGROUP); }
__device__ __forceinline__ void lds_oru(LAS unsigned* p, unsigned v) { (void)__hip_atomic_fetch_or(p, v, __ATOMIC_RELAXED, __HIP_MEMORY_SCOPE_WORKGROUP); }

template <int BM, int BN, int WTM = 64, int WTN = 64, bool ZERO = true>
__device__ __forceinline__ void gemm_mainloop(lds_t* lds, const bf16_t* (&ap)[BM / 64], int astep, const bf16_t* (&bp)[BN / 64], int nk, f32x4 (&acc)[WTM / 16][WTN / 16]) {
    constexpr int NA = BM / 64, NB_ = BN / 64, WN = BN / WTN, MT = WTM / 16, NT = WTN / 16;
    static_assert((BM / WTM) * (BN / WTN) == 8, "8 waves");
    constexpr int STAGE = (BM + BN) * 128;
    int tid = threadIdx.x; asm volatile("" : "+v"(tid));
    const int lane = tid & 63, wid = __builtin_amdgcn_readfirstlane(tid >> 6);
    const int r = lane & 15, q = lane >> 4;
    const int wm = wid / WN, wn = wid % WN;
    const int sc = tid & 7, sr = tid >> 3;
    const int wofs = sr * 128 + ((sc ^ ((sr >> 1) & 7)) << 4);
    const int x0 = (q ^ (r >> 1)) << 4;
    const int aoff = (wm * WTM + r) * 128, boff = BM * 128 + (wn * WTN + r) * 128;
    u32x4 ra0[NA], rb0[NB_], ra1[NA], rb1[NB_];
    if (ZERO) {
#pragma unroll
        for (int i = 0; i < MT; ++i)
#pragma unroll
            for (int j = 0; j < NT; ++j) acc[i][j] = (f32x4){0.f, 0.f, 0.f, 0.f};
    }
#define GM_LOAD(RA, RB, KT) do { _Pragma("unroll") for (int i = 0; i < NA; ++i) RA[i] = *(const u32x4*)(ap[i] + (size_t)(KT) * astep); \
                                 _Pragma("unroll") for (int i = 0; i < NB_; ++i) RB[i] = *(const u32x4*)(bp[i] + (size_t)(KT) * 64); } while (0)
#define GM_WRITE(RA, RB, ST) do { lds_t* sn_ = lds + (ST) * STAGE; _Pragma("unroll") for (int i = 0; i < NA; ++i) lds_st16(sn_ + i * 8192 + wofs, RA[i]); \
                                  _Pragma("unroll") for (int i = 0; i < NB_; ++i) lds_st16(sn_ + BM * 128 + i * 8192 + wofs, RB[i]); } while (0)
#define GM_COMPUTE(ST) do { lds_t* st_ = lds + (ST) * STAGE; _Pragma("unroll") for (int s = 0; s < 2; ++s) { const int xs = x0 ^ (s << 6); bf16x8 a[MT], b[NT]; \
        _Pragma("unroll") for (int i = 0; i < MT; ++i) a[i] = lds_ld16(st_ + aoff + i * 2048 + xs); \
        _Pragma("unroll") for (int i = 0; i < NT; ++i) b[i] = lds_ld16(st_ + boff + i * 2048 + xs); \
        _Pragma("unroll") for (int i = 0; i < MT; ++i) _Pragma("unroll") for (int j = 0; j < NT; ++j) acc[i][j] = mfma16(b[j], a[i], acc[i][j]); } } while (0)
    GM_LOAD(ra0, rb0, 0);
    if (nk > 1) GM_LOAD(ra1, rb1, 1);
    GM_WRITE(ra0, rb0, 0);
    __syncthreads();
    for (int kt = 0; kt < nk; kt += 2) {
        if (kt + 2 < nk) GM_LOAD(ra0, rb0, kt + 2);
        GM_COMPUTE(0);
        if (kt + 1 < nk) GM_WRITE(ra1, rb1, 1);
        __syncthreads();
        if (kt + 1 < nk) {
            if (kt + 3 < nk) GM_LOAD(ra1, rb1, kt + 3);
            GM_COMPUTE(1);
            if (kt + 2 < nk) GM_WRITE(ra0, rb0, 0);
            __syncthreads();
        }
    }
#undef GM_LOAD
#undef GM_WRITE
#undef GM_COMPUTE
}

__device__ __forceinline__ int glds_lchunk(int tid) { return ((tid & 7) ^ ((tid >> 4) & 7)) * 8; }
__device__ __forceinline__ void gemm256_first(lds_t* lds, const bf16_t* abase, const unsigned (&aoffs)[4], const bf16_t* bbase, const unsigned (&boffs)[4]) {
    const int wid = __builtin_amdgcn_readfirstlane(threadIdx.x >> 6);
#pragma unroll
    for (int i = 0; i < 4; ++i) {
        __builtin_amdgcn_global_load_lds((const unsigned*)(abase + aoffs[i]), (LAS unsigned*)(lds + i * 8192 + wid * 1024), 16, 0, 0);
        __builtin_amdgcn_global_load_lds((const unsigned*)(bbase + boffs[i]), (LAS unsigned*)(lds + 32768 + i * 8192 + wid * 1024), 16, 0, 0); }
}
struct AccZero { __device__ __forceinline__ f32x4 operator()(int, int) const { return (f32x4){0.f, 0.f, 0.f, 0.f}; } __device__ __forceinline__ void next() {} };
struct AccFromF32 { const float* p; size_t step; float scale;
    __device__ __forceinline__ f32x4 operator()(int, int j) const { return *(const f32x4*)(p + j * 4) * scale; }
    __device__ __forceinline__ void next() { p += step; asm volatile("" : "+v"(p)); } };
template <class Init = AccZero>
__device__ __forceinline__ void gemm256_main(lds_t* lds, const bf16_t* abase, const unsigned (&aoffs)[4], int astep, const bf16_t* bbase, const unsigned (&boffs)[4], int nk, f32x4 (&acc)[8][4], Init init = Init()) {
    int tid = threadIdx.x; asm volatile("" : "+v"(tid));
    const int lane = tid & 63, wid = __builtin_amdgcn_readfirstlane(tid >> 6);
    const int r = lane & 15, q = lane >> 4, wr = wid >> 2, wc = wid & 3;
    const int x0 = (q ^ (r >> 1)) << 4;
    const int aoff = (wr * 128 + r) * 128, boff = 32768 + (wc * 64 + r) * 128;
    const int sflip = wr;
#pragma unroll
    for (int i = 0; i < 8; ++i) {
#pragma unroll
        for (int j = 0; j < 4; ++j) acc[i][j] = init(i, j);
        init.next(); }
#define G2_STAGE(BUF, KT) do { _Pragma("unroll") for (int i = 0; i < 4; ++i) { \
        __builtin_amdgcn_global_load_lds((const unsigned*)((abase + (size_t)(KT) * astep) + aoffs[i]), (LAS unsigned*)(lds + (BUF) * 65536 + i * 8192 + wid * 1024), 16, 0, 0); \
        __builtin_amdgcn_global_load_lds((const unsigned*)((bbase + (size_t)(KT) * 64) + boffs[i]), (LAS unsigned*)(lds + (BUF) * 65536 + 32768 + i * 8192 + wid * 1024), 16, 0, 0); } } while (0)
#define G2_COMPUTE(BUF) do { lds_t* st_ = lds + (BUF) * 65536; _Pragma("unroll") for (int s = 0; s < 2; ++s) { const int xs = x0 ^ ((s ^ sflip) << 6); bf16x8 a[8], b[4]; \
        _Pragma("unroll") for (int i = 0; i < 8; ++i) a[i] = lds_ld16(st_ + aoff + i * 2048 + xs); \
        _Pragma("unroll") for (int i = 0; i < 4; ++i) b[i] = lds_ld16(st_ + boff + i * 2048 + xs); \
        _Pragma("unroll") for (int i = 0; i < 8; ++i) _Pragma("unroll") for (int j = 0; j < 4; ++j) acc[i][j] = mfma16(b[j], a[i], acc[i][j]); \
        __builtin_amdgcn_sched_barrier(0); } } while (0)
    asm volatile("s_waitcnt vmcnt(0)" ::: "memory");
    __syncthreads();
    for (int t = 0; t < nk; ++t) {
        const int cur = t & 1;
        if (t + 1 < nk) G2_STAGE(cur ^ 1, t + 1);
        G2_COMPUTE(cur);
        asm volatile("s_waitcnt vmcnt(0)" ::: "memory");
        __syncthreads();
    }
#undef G2_STAGE
#undef G2_COMPUTE
}
__device__ __forceinline__ void gemm256(lds_t* lds, const bf16_t* abase, const unsigned (&aoffs)[4], int astep, const bf16_t* bbase, const unsigned (&boffs)[4], int nk, f32x4 (&acc)[8][4]) {
    gemm256_first(lds, abase, aoffs, bbase, boffs);
    gemm256_main(lds, abase, aoffs, astep, bbase, boffs, nk, acc);
}


namespace g8 {
constexpr int HALF = 128, HTB = HALF * 64 * 2, STAGE_BYTES = 8 * HTB;
__device__ __forceinline__ int lds_byte(int r, int c) { const int st = (r >> 4) * 2 + (c >> 5), rr = r & 15, cc = c & 31, ob = rr * 64 + cc * 2; return st * 1024 + (ob ^ (((ob >> 9) & 1) << 5)); }
__device__ __forceinline__ void stage_rc(int b, int& R, int& C) { const int st = b / 1024, sb = b % 1024, swz = sb ^ (((sb >> 9) & 1) << 5); R = (st >> 1) * 16 + swz / 64; C = (st & 1) * 32 + (swz % 64) / 2; }
__device__ __forceinline__ int perm32(int rho) { const int n = rho >> 4, i = rho & 15; return 8 * (i >> 2) + 4 * n + (i & 3); }
struct Unit { int pm, pn, e, ne, rb, idx; };
typedef f32x4 Acc[2][2][4][2];
__device__ __forceinline__ void acc_zero(Acc& acc) {
#pragma unroll
    for (int a = 0; a < 2; ++a)
#pragma unroll
        for (int b = 0; b < 2; ++b)
#pragma unroll
            for (int m = 0; m < 4; ++m)
#pragma unroll
                for (int n = 0; n < 2; ++n) acc[a][b][m][n] = (f32x4){0.f, 0.f, 0.f, 0.f};
}
__device__ __forceinline__ void natural_offsets(unsigned (&voffA)[2][2], int K, int tid) {
#pragma unroll
    for (int i = 0; i < 2; ++i) { int R, C; stage_rc(tid * 16 + i * 8192, R, C); voffA[0][i] = (unsigned)(R * K + C) * 2u; voffA[1][i] = (unsigned)((R + HALF) * K + C) * 2u; }
}
template <class Epi, class Sched>
__device__ __forceinline__ void gemm_phase(lds_t* lds, const int K, const Sched& S, const Epi& E) {
    int tid = threadIdx.x; asm volatile("" : "+v"(tid));
    const int wid = __builtin_amdgcn_readfirstlane(tid >> 6), lane = tid & 63, wr = wid >> 2, wc = wid & 3, fr = lane & 15, fq = lane >> 4;
    const int nt = K / 64;
    unsigned voffA[2][2], voffB[2];
#pragma unroll
    for (int i = 0; i < 2; ++i) { int R, C; stage_rc(tid * 16 + i * 8192, R, C); const int Rb = (R & ~31) + perm32(R & 31); voffB[i] = (unsigned)(Rb * K + C) * 2u; }
    const size_t kstep = 128;
    const unsigned ldsw = (unsigned)wid * 1024u;
    const int aoff = lds_byte(wr * 64 + fr, fq * 8), boff = lds_byte(wc * 32 + fr, fq * 8);
#define G8_SA(b, h) (((b) * 2 + (h)) * g8::HTB)
#define G8_SB(b, h) ((4 + (b) * 2 + (h)) * g8::HTB)
#define G8_STAGE(bufoff, gbase, voff) do { _Pragma("unroll") for (int _i = 0; _i < 2; ++_i) \
        __builtin_amdgcn_global_load_lds((const unsigned*)((const char*)(gbase) + (voff)[_i]), (LAS unsigned*)(lds + (bufoff) + ldsw + _i * 8192), 16, 0, 0); } while (0)
#define G8_LDA(dst, b, h) do { _Pragma("unroll") for (int m = 0; m < 4; ++m) _Pragma("unroll") for (int k = 0; k < 2; ++k) dst[m][k] = *(const LAS bf16x8*)(lds + G8_SA(b, h) + aoff + m * 2048 + k * 1024); } while (0)
#define G8_LDB(dst, b, h) do { _Pragma("unroll") for (int n = 0; n < 2; ++n) _Pragma("unroll") for (int k = 0; k < 2; ++k) dst[n][k] = *(const LAS bf16x8*)(lds + G8_SB(b, h) + boff + n * 2048 + k * 1024); } while (0)
#define G8_MMA(ai, bj, At, Bt) do { __builtin_amdgcn_s_setprio(1); _Pragma("unroll") for (int m = 0; m < 4; ++m) _Pragma("unroll") for (int n = 0; n < 2; ++n) _Pragma("unroll") for (int k = 0; k < 2; ++k) \
        acc[ai][bj][m][n] = __builtin_amdgcn_mfma_f32_16x16x32_bf16(Bt[n][k], At[m][k], acc[ai][bj][m][n], 0, 0, 0); __builtin_amdgcn_s_setprio(0); } while (0)
#define G8_WAIT_V(n) asm volatile("s_waitcnt vmcnt(" #n ")" ::: "memory")
#define G8_WAIT_L(n) asm volatile("s_waitcnt lgkmcnt(" #n ")" ::: "memory")
#define G8_BAR __builtin_amdgcn_s_barrier()
#define G8_SCHED __builtin_amdgcn_sched_barrier(0)
    Unit cur, nxt; int ui = 0;
    if (!S.next(0, cur)) return;
    Acc acc;
    E.init(acc, cur, wr, wc, fr, fq);
    bf16x8 At[4][2], B0[2][2], B1[2][2];
    const char* cA = S.a_base(cur); const char* cB0 = S.b_base(cur, 0); const char* cB1 = S.b_base(cur, 1);
    S.a_offsets(cur, voffA, tid);
    G8_STAGE(G8_SB(0, 0), cB0, voffB); G8_STAGE(G8_SA(0, 0), cA, voffA[0]); G8_STAGE(G8_SB(0, 1), cB1, voffB); G8_STAGE(G8_SA(0, 1), cA, voffA[1]);
    if (wr == 1) G8_BAR;
    G8_WAIT_V(4); G8_BAR;
    G8_STAGE(G8_SB(1, 0), cB0 + kstep, voffB); G8_STAGE(G8_SA(1, 0), cA + kstep, voffA[0]); G8_STAGE(G8_SB(1, 1), cB1 + kstep, voffB);
    G8_WAIT_V(6); G8_BAR;
    E.post_prologue(acc);
    for (;;) {
        const bool has_next = S.next(ui + 1, nxt);
        const char* nA = has_next ? S.a_base(nxt) : cA; const char* nB0 = has_next ? S.b_base(nxt, 0) : cB0; const char* nB1 = has_next ? S.b_base(nxt, 1) : cB1;
        for (int t = 0; t < nt; t += 2) {
            const bool last = (t == nt - 2);
            const char* a1 = cA + (size_t)(t + 1) * kstep;
            const char* a2 = last ? nA : cA + (size_t)(t + 2) * kstep; const char* b20 = last ? nB0 : cB0 + (size_t)(t + 2) * kstep; const char* b21 = last ? nB1 : cB1 + (size_t)(t + 2) * kstep;
            const char* a3 = a2 + kstep; const char* b30 = b20 + kstep; const char* b31 = b21 + kstep;
            G8_LDB(B0, 0, 0); G8_SCHED; G8_LDA(At, 0, 0); G8_STAGE(G8_SA(1, 1), a1, voffA[1]);
            G8_WAIT_L(8); G8_BAR; G8_WAIT_L(0); G8_MMA(0, 0, At, B0); G8_BAR; G8_SCHED;
            if (last && has_next) S.a_offsets(nxt, voffA, tid);
            G8_LDB(B1, 0, 1); G8_STAGE(G8_SB(0, 0), b20, voffB);
            G8_BAR; G8_WAIT_L(0); G8_MMA(0, 1, At, B1); G8_BAR;
            G8_LDA(At, 0, 1); G8_STAGE(G8_SA(0, 0), a2, voffA[0]);
            G8_BAR; G8_WAIT_L(0); G8_MMA(1, 0, At, B0); G8_BAR; G8_SCHED;
            G8_STAGE(G8_SB(0, 1), b21, voffB);
            G8_WAIT_V(6); G8_BAR; G8_MMA(1, 1, At, B1); G8_BAR;
            G8_LDB(B0, 1, 0); G8_SCHED; G8_LDA(At, 1, 0); G8_STAGE(G8_SA(0, 1), a2, voffA[1]);
            G8_WAIT_L(8); G8_BAR; G8_WAIT_L(0); G8_MMA(0, 0, At, B0); G8_BAR; G8_SCHED;
            G8_LDB(B1, 1, 1); G8_STAGE(G8_SB(1, 0), b30, voffB);
            G8_BAR; G8_WAIT_L(0); G8_MMA(0, 1, At, B1); G8_BAR;
            G8_LDA(At, 1, 1); G8_STAGE(G8_SA(1, 0), a3, voffA[0]);
            G8_BAR; G8_WAIT_L(0); G8_MMA(1, 0, At, B0); G8_BAR; G8_SCHED;
            G8_STAGE(G8_SB(1, 1), b31, voffB);
            G8_WAIT_V(6); G8_BAR; G8_MMA(1, 1, At, B1); G8_BAR;
        }
        if constexpr (!Epi::AFTER_DRAIN) E(acc, cur, wr, wc, fr, fq);
        if (!has_next) break;
        cur = nxt; cA = nA; cB0 = nB0; cB1 = nB1; ++ui;
        E.init(acc, cur, wr, wc, fr, fq);
    }
    G8_WAIT_V(0);
    if (wr == 0) G8_BAR;
    G8_BAR;
    if constexpr (Epi::AFTER_DRAIN) E(acc, cur, wr, wc, fr, fq);
#undef G8_SA
#undef G8_SB
#undef G8_STAGE
#undef G8_LDA
#undef G8_LDB
#undef G8_MMA
#undef G8_WAIT_V
#undef G8_WAIT_L
#undef G8_BAR
#undef G8_SCHED
}
typedef int v8i __attribute__((ext_vector_type(8)));
typedef int v4i __attribute__((ext_vector_type(4)));
__device__ __forceinline__ int f8_sw(int row) { const int a = (row >> 1) & 7; return a ^ ((a << 1) & 4); }
__device__ __forceinline__ void f8_rc(int tid, int i, int& R, int& Cb) { R = (tid >> 3) + 64 * i; Cb = ((tid & 7) ^ f8_sw(R)) << 4; }
template <int SCLW, class Epi, class Sched>
__device__ __forceinline__ void gemm_phase_f8(lds_t* lds, const int K, const Sched& S, const Epi& E) {
    int tid = threadIdx.x; asm volatile("" : "+v"(tid));
    const int wid = __builtin_amdgcn_readfirstlane(tid >> 6), lane = tid & 63, wr = wid >> 2, wc = wid & 3, fr = lane & 15, fq = lane >> 4;
    int nt = K / 128; asm volatile("" : "+s"(nt));
    unsigned voffA[2][2], voffB[2];
#pragma unroll
    for (int i = 0; i < 2; ++i) { int R, Cb; f8_rc(tid, i, R, Cb); const int Rb = (R & ~31) + perm32(R & 31); voffB[i] = (unsigned)(Rb * K + Cb); }
    const size_t kstep = 128;
    const unsigned ldsw = (unsigned)wid * 1024u;
    const int c0_ = ((2 * fq) ^ f8_sw(fr)) << 4;
    const int aoff = (wr * 64 + fr) * 128 + c0_, boff = (wc * 32 + fr) * 128 + c0_;
    constexpr int SCL_ACT = 0x7f7f7f7f, SCL_W = SCLW * 0x01010101;
#define G8_SA(b, h) (((b) * 2 + (h)) * g8::HTB)
#define G8_SB(b, h) ((4 + (b) * 2 + (h)) * g8::HTB)
#define G8_STAGE(bufoff, gbase, voff) do { _Pragma("unroll") for (int _i = 0; _i < 2; ++_i) \
        __builtin_amdgcn_global_load_lds((const unsigned*)((const char*)(gbase) + (voff)[_i]), (LAS unsigned*)(lds + (bufoff) + ldsw + _i * 8192), 16, 0, 0); } while (0)
#define G8_LDA(dst, b, h) do { _Pragma("unroll") for (int m = 0; m < 4; ++m) { const u32x4 lo_ = *(const LAS u32x4*)(lds + G8_SA(b, h) + aoff + m * 2048), hi_ = *(const LAS u32x4*)(lds + G8_SA(b, h) + (aoff ^ 16) + m * 2048); \
        dst[m] = __builtin_shufflevector(__builtin_bit_cast(v4i, lo_), __builtin_bit_cast(v4i, hi_), 0, 1, 2, 3, 4, 5, 6, 7); } } while (0)
#define G8_LDB(dst, b, h) do { _Pragma("unroll") for (int n = 0; n < 2; ++n) { const u32x4 lo_ = *(const LAS u32x4*)(lds + G8_SB(b, h) + boff + n * 2048), hi_ = *(const LAS u32x4*)(lds + G8_SB(b, h) + (boff ^ 16) + n * 2048); \
        dst[n] = __builtin_shufflevector(__builtin_bit_cast(v4i, lo_), __builtin_bit_cast(v4i, hi_), 0, 1, 2, 3, 4, 5, 6, 7); } } while (0)
#define G8_MMA(ai, bj, At, Bt) do { __builtin_amdgcn_s_setprio(1); _Pragma("unroll") for (int m = 0; m < 4; ++m) _Pragma("unroll") for (int n = 0; n < 2; ++n) \
        acc[ai][bj][m][n] = __builtin_amdgcn_mfma_scale_f32_16x16x128_f8f6f4(Bt[n], At[m], acc[ai][bj][m][n], 0, 0, 0, SCL_W, 0, SCL_ACT); __builtin_amdgcn_s_setprio(0); } while (0)
#define G8_WAIT_V(n) asm volatile("s_waitcnt vmcnt(" #n ")" ::: "memory")
#define G8_WAIT_L(n) asm volatile("s_waitcnt lgkmcnt(" #n ")" ::: "memory")
#define G8_BAR __builtin_amdgcn_s_barrier()
#define G8_SCHED __builtin_amdgcn_sched_barrier(0)
    Unit cur, nxt; int ui = 0;
    if (!S.next(0, cur)) return;
    Acc acc;
    E.init(acc, cur, wr, wc, fr, fq);
    v8i At[4], B0[2], B1[2];
    const char* cA = S.a_base(cur); const char* cB0 = S.b_base(cur, 0); const char* cB1 = S.b_base(cur, 1);
    S.a_offsets(cur, voffA, tid);
    G8_STAGE(G8_SB(0, 0), cB0, voffB); G8_STAGE(G8_SA(0, 0), cA, voffA[0]); G8_STAGE(G8_SB(0, 1), cB1, voffB); G8_STAGE(G8_SA(0, 1), cA, voffA[1]);
    if (wr == 1) G8_BAR;
    G8_WAIT_V(4); G8_BAR;
    G8_STAGE(G8_SB(1, 0), cB0 + kstep, voffB); G8_STAGE(G8_SA(1, 0), cA + kstep, voffA[0]); G8_STAGE(G8_SB(1, 1), cB1 + kstep, voffB);
    G8_WAIT_V(6); G8_BAR;
    E.post_prologue(acc);
    for (;;) {
        const bool has_next = S.next(ui + 1, nxt);
        const char* nA = has_next ? S.a_base(nxt) : cA; const char* nB0 = has_next ? S.b_base(nxt, 0) : cB0; const char* nB1 = has_next ? S.b_base(nxt, 1) : cB1;
#pragma unroll 1
        for (int t = 0; t < nt; t += 2) {
            const bool last = (t == nt - 2);
            const char* a1 = cA + (size_t)(t + 1) * kstep;
            const char* a2 = last ? nA : cA + (size_t)(t + 2) * kstep; const char* b20 = last ? nB0 : cB0 + (size_t)(t + 2) * kstep; const char* b21 = last ? nB1 : cB1 + (size_t)(t + 2) * kstep;
            const char* a3 = a2 + kstep; const char* b30 = b20 + kstep; const char* b31 = b21 + kstep;
            G8_LDB(B0, 0, 0); G8_SCHED; G8_LDA(At, 0, 0); G8_STAGE(G8_SA(1, 1), a1, voffA[1]);
            G8_WAIT_L(8); G8_BAR; G8_WAIT_L(0); G8_MMA(0, 0, At, B0); G8_BAR; G8_SCHED;
            if (last && has_next) S.a_offsets(nxt, voffA, tid);
            G8_LDB(B1, 0, 1); G8_STAGE(G8_SB(0, 0), b20, voffB);
            G8_BAR; G8_WAIT_L(0); G8_MMA(0, 1, At, B1); G8_BAR;
            G8_LDA(At, 0, 1); G8_STAGE(G8_SA(0, 0), a2, voffA[0]);
            G8_BAR; G8_WAIT_L(0); G8_MMA(1, 0, At, B0); G8_BAR; G8_SCHED;
            G8_STAGE(G8_SB(0, 1), b21, voffB);
            G8_WAIT_V(6); G8_BAR; G8_MMA(1, 1, At, B1); G8_BAR;
            G8_LDB(B0, 1, 0); G8_SCHED; G8_LDA(At, 1, 0); G8_STAGE(G8_SA(0, 1), a2, voffA[1]);
            G8_WAIT_L(8); G8_BAR; G8_WAIT_L(0); G8_MMA(0, 0, At, B0); G8_BAR; G8_SCHED;
            G8_LDB(B1, 1, 1); G8_STAGE(G8_SB(1, 0), b30, voffB);
            G8_BAR; G8_WAIT_L(0); G8_MMA(0, 1, At, B1); G8_BAR;
            G8_LDA(At, 1, 1); G8_STAGE(G8_SA(1, 0), a3, voffA[0]);
            G8_BAR; G8_WAIT_L(0); G8_MMA(1, 0, At, B0); G8_BAR; G8_SCHED;
            G8_STAGE(G8_SB(1, 1), b31, voffB);
            G8_WAIT_V(6); G8_BAR; G8_MMA(1, 1, At, B1); G8_BAR;
        }
        if constexpr (!Epi::AFTER_DRAIN) E(acc, cur, wr, wc, fr, fq);
        if (!has_next) break;
        cur = nxt; cA = nA; cB0 = nB0; cB1 = nB1; ++ui;
        E.init(acc, cur, wr, wc, fr, fq);
    }
    G8_WAIT_V(0);
    if (wr == 0) G8_BAR;
    G8_BAR;
    if constexpr (Epi::AFTER_DRAIN) E(acc, cur, wr, wc, fr, fq);
#undef G8_SA
#undef G8_SB
#undef G8_STAGE
#undef G8_LDA
#undef G8_LDB
#undef G8_MMA
#undef G8_WAIT_V
#undef G8_WAIT_L
#undef G8_BAR
#undef G8_SCHED
}
}

template <class CM>
__device__ __forceinline__ void transpose_tile(const float* src, int Nsrc, int K, bf16_t* dst, int k0, int n0, CM cm, LAS float* scr) {
    const int tid = threadIdx.x;
    {
        const int tx = tid & 63, ty = tid >> 6;
        const int scol = cm(n0 + tx);
#pragma unroll
        for (int i = 0; i < 8; ++i) { const int kk = ty + 8 * i; scr[kk * 65 + tx] = scol >= 0 ? src[(size_t)(k0 + kk) * Nsrc + scol] : 0.f; }
    }
    __syncthreads();
    {
        const int kp = tid & 31, n1 = tid >> 5;
#pragma unroll
        for (int i = 0; i < 4; ++i) { const int nn = n1 + 16 * i;
            *(unsigned*)(dst + (size_t)(n0 + nn) * K + k0 + 2 * kp) = pk2(scr[(2 * kp) * 65 + nn], scr[(2 * kp + 1) * 65 + nn]); }
    }
    __syncthreads();
}

__device__ __forceinline__ void transpose_tile_f8(const float* src, int Nsrc, int K, unsigned char* dst8, int k0, int n0, float scale, LAS float* scr) {
    const int tid = threadIdx.x;
    {
        const int tx = tid & 63, ty = tid >> 6;
#pragma unroll
        for (int i = 0; i < 8; ++i) { const int kk = ty + 8 * i; scr[kk * 65 + tx] = src[(size_t)(k0 + kk) * Nsrc + n0 + tx]; }
    }
    __syncthreads();
    {
        const int kq = tid & 15, n1 = tid >> 4;
#pragma unroll
        for (int i = 0; i < 2; ++i) { const int nn = n1 + 32 * i;
            *(unsigned*)(dst8 + (size_t)(n0 + nn) * K + k0 + 4 * kq) = pk4_f8(scale * scr[(4 * kq) * 65 + nn], scale * scr[(4 * kq + 1) * 65 + nn], scale * scr[(4 * kq + 2) * 65 + nn], scale * scr[(4 * kq + 3) * 65 + nn]); }
    }
    __syncthreads();
}

__device__ __forceinline__ int inproj_srccol(int n) {
    if (n < 512) return n;
    if (n < 1536) { const int i = (n - 512) >> 1; return (n & 1) ? 1024 + i : 512 + i; }
    if (n < 2840) return n;
    return -1;
}

__device__ __forceinline__ void phase_prep(const Params& P, lds_t* lds) {
    LAS float* scr = (LAS float*)lds;
    unsigned char* ws = P.ws;
    const int G = gridDim.x, bid = blockIdx.x, tid = threadIdx.x;
    constexpr int T_IN = 16 * 48, T_OUT = 256, T_PG = 256, T_PLE = 64, T_W1 = 64, T_W2 = 2, T_EIN = 32 * 256, T_EOUT = 32 * 128;
    constexpr int NT = T_IN + T_OUT + T_PG + T_PLE + 2 * T_W1 + 2 * T_W2 + T_EIN + T_EOUT;
    for (int it = bid; it < NT; it += G) {
        int x = it;
        if (x < T_IN) { transpose_tile(P.in[2], 2840, 1024, (bf16_t*)(ws + WS_WIN), (x / 48) * 64, (x % 48) * 64, [](int n) { return n < 2840 ? n : -1; }, scr); continue; } x -= T_IN;
        if (x < T_OUT) { transpose_tile(P.in[10], 1024, 1024, (bf16_t*)(ws + WS_WOUT), (x / 16) * 64, (x % 16) * 64, [](int n) { return n; }, scr); continue; } x -= T_OUT;
        if (x < T_PG) { transpose_tile(P.in[22], 1024, 1024, (bf16_t*)(ws + WS_WPG), (x / 16) * 64, (x % 16) * 64, [](int n) { return n; }, scr); continue; } x -= T_PG;
        if (x < T_PLE) { transpose_tile(P.in[21], 1024, 256, (bf16_t*)(ws + WS_WPLE), (x / 16) * 64, (x % 16) * 64, [](int n) { return n; }, scr); continue; } x -= T_PLE;
        if (x < T_W1) { transpose_tile(P.in[5], 128, 2048, (bf16_t*)(ws + WS_W1CK), (x / 2) * 64, (x % 2) * 64, [](int n) { return n; }, scr); continue; } x -= T_W1;
        if (x < T_W1) { transpose_tile(P.in[8], 128, 2048, (bf16_t*)(ws + WS_W1CV), (x / 2) * 64, (x % 2) * 64, [](int n) { return n; }, scr); continue; } x -= T_W1;
        if (x < T_W2) { transpose_tile(P.in[6], 64, 128, (bf16_t*)(ws + WS_W2CK), x * 64, 0, [](int n) { return n; }, scr); continue; } x -= T_W2;
        if (x < T_W2) { transpose_tile(P.in[9], 64, 128, (bf16_t*)(ws + WS_W2CV), x * 64, 0, [](int n) { return n; }, scr); continue; } x -= T_W2;
        if (x < T_EIN) { const int e = x >> 8, y = x & 255;
            transpose_tile_f8(P.in[17] + (size_t)e * 1024 * 1024, 1024, 1024, ws + WS_WEIN + (size_t)e * 1024 * 1024, (y / 16) * 64, (y % 16) * 64, 16.f, scr); continue; } x -= T_EIN;
        { const int e = x >> 7, y = x & 127;
            transpose_tile_f8(P.in[18] + (size_t)e * 512 * 1024, 1024, 512, ws + WS_WEOUT + (size_t)e * 1024 * 512, (y / 16) * 64, (y % 16) * 64, 16.f, scr); }
    }
    {
        const size_t gtid = (size_t)bid * NTHREADS + tid, gsz = (size_t)G * NTHREADS;
        const float* x = P.in[0]; bf16_t* xb = (bf16_t*)(ws + WS_H1LO);
        for (size_t i = gtid; i < (size_t)T * DM / 8; i += gsz) {
            const f32x4 a = *(const f32x4*)(x + i * 8), b = *(const f32x4*)(x + i * 8 + 4);
            u32x4 o; o.x = pk2(a[0], a[1]); o.y = pk2(a[2], a[3]); o.z = pk2(b[0], b[1]); o.w = pk2(b[2], b[3]);
            *(u32x4*)(xb + i * 8) = o;
        }
        const float* pp = P.in[1]; bf16_t* pb = (bf16_t*)(ws + WS_PB);
        for (size_t i = gtid; i < (size_t)T * 256 / 8; i += gsz) {
            const f32x4 a = *(const f32x4*)(pp + i * 8), b = *(const f32x4*)(pp + i * 8 + 4);
            u32x4 o; o.x = pk2(a[0], a[1]); o.y = pk2(a[2], a[3]); o.z = pk2(b[0], b[1]); o.w = pk2(b[2], b[3]);
            *(u32x4*)(pb + i * 8) = o;
        }
        bf16_t* wrb = (bf16_t*)(ws + WS_WRB);
        for (size_t i = gtid; i < 64 * 3072; i += gsz) {
            const int n = (int)(i / 3072), kk = (int)(i % 3072), k = kk & 1023, seg = kk >> 10;
            float v = 0.f;
            if (n < 4) v = P.in[13][k * 4 + n]; else if (n < 36) v = P.in[15][k * 32 + (n - 4)];
            const bf16_t hi = f2bf(v); const bf16_t lo = f2bf(v - bf2f(hi));
            wrb[i] = (seg == 1) ? lo : hi;
        }
    }
    if (bid == (G > 1 ? 1 : 0) || bid == (G > 2 ? 2 : 0)) {
        for (int which = 0; which < 2; ++which) {
            if (bid != ((which == 0) ? (G > 1 ? 1 : 0) : (G > 2 ? 2 : 0))) continue;
            const float* pe = P.in[which ? 7 : 4]; const float* w1 = P.in[which ? 8 : 5];
            const int n = tid & 127, ks = tid >> 7;
            float s = 0.f;
            for (int k = ks * 512; k < ks * 512 + 512; ++k) s += pe[k] * w1[(size_t)k * 128 + n];
            scr[ks * 128 + n] = s;
            __syncthreads();
            if (tid < 128) ((float*)(ws + WS_BIAS1))[which * 128 + tid] = scr[tid] + scr[128 + tid] + scr[256 + tid] + scr[384 + tid];
            __syncthreads();
        }
    }
    if (bid == 0 && tid < 64) ((int*)(ws + WS_CTL))[tid] = 0;
#ifndef ATOMIC_BENCH
#define ATOMIC_BENCH 0
#endif
#if ATOMIC_BENCH == 1
    { LAS float* fb = (LAS float*)(lds + 65536);
      for (int it = 0; it < 200; ++it) {
#pragma unroll
        for (int k = 0; k < 16; ++k) lds_addf(fb + (k * 512 + tid), 1.0f); } }
#elif ATOMIC_BENCH == 2
    { LAS int* fb = (LAS int*)(lds + 65536);
      for (int it = 0; it < 200; ++it) {
#pragma unroll
        for (int k = 0; k < 16; ++k) (void)__hip_atomic_fetch_add(fb + (k * 512 + tid), 1, __ATOMIC_RELAXED, __HIP_MEMORY_SCOPE_WORKGROUP); } }
#endif
}

struct SchedInproj {
    const bf16_t* xb; const bf16_t* wt; int G, c;
    __device__ __forceinline__ bool next(int i, g8::Unit& u) const {
        if (G == 256) { if (i >= 6) return false; const int qb = i * 8 + (c & 7), k = c >> 3; u.pm = (qb / 3) * 8 + (k & 7); u.pn = (qb % 3) * 4 + (k >> 3); return true; }
        const int L = i * G + c; if (L >= 128 * 12) return false; u.pm = L / 12; u.pn = L % 12; return true; }
    __device__ __forceinline__ const char* a_base(const g8::Unit& u) const { return (const char*)(xb + (size_t)u.pm * 256 * 1024); }
    __device__ __forceinline__ const char* b_base(const g8::Unit& u, int h) const {
        const int row = (u.pn >= 2 && u.pn < 6) ? ((h ? 1024 : 512) + (u.pn - 2) * 128) : (u.pn * 256 + h * 128);
        return (const char*)(wt + (size_t)row * 1024); }
    __device__ __forceinline__ void a_offsets(const g8::Unit&, unsigned (&v)[2][2], int tid) const { g8::natural_offsets(v, 1024, tid); }
};
struct EpiInproj {
    static constexpr bool AFTER_DRAIN = false;
    unsigned char* ws;
    __device__ __forceinline__ void init(g8::Acc& acc, const g8::Unit&, int, int, int, int) const { g8::acc_zero(acc); }
    __device__ __forceinline__ void post_prologue(g8::Acc&) const {}
    __device__ __forceinline__ void operator()(g8::Acc& acc, const g8::Unit& u, int wr, int wc, int fr, int fq) const {
        const int n0 = wc * 32 + 8 * fq;
        const int pn = u.pn;
        if (pn >= 2 && pn < 6) {
#pragma unroll
            for (int ai = 0; ai < 2; ++ai)
#pragma unroll
                for (int m = 0; m < 4; ++m) { const int t = u.pm * 256 + ai * 128 + wr * 64 + m * 16 + fr;
                    *(u32x4*)((bf16_t*)(ws + WS_U) + (size_t)t * 512 + (pn - 2) * 128 + n0) = pk8(acc[ai][0][m][0] * acc[ai][1][m][0], acc[ai][0][m][1] * acc[ai][1][m][1]); }
            return;
        }
#pragma unroll
        for (int bj = 0; bj < 2; ++bj) {
#pragma unroll
            for (int ai = 0; ai < 2; ++ai)
#pragma unroll
                for (int m = 0; m < 4; ++m) { const int t = u.pm * 256 + ai * 128 + wr * 64 + m * 16 + fr; const int b = t >> 13, s_ = t & 8191;
                    const f32x4 v0 = acc[ai][bj][m][0], v1 = acc[ai][bj][m][1];
                    if (pn < 2) *(u32x4*)((bf16_t*)(ws + WS_CB) + (size_t)t * 512 + pn * 256 + bj * 128 + n0) = pk8(v0, v1);
                    else if (pn < 8) *(u32x4*)((bf16_t*)(ws + WS_Q) + (size_t)t * 512 + (pn - 6) * 256 + bj * 128 + n0) = pk8(v0 * QSCALE, v1 * QSCALE);
                    else if (pn == 8) *(u32x4*)((bf16_t*)(ws + (bj ? WS_VC : WS_KC)) + (size_t)t * 128 + n0) = pk8(v0, v1);
                    else if (pn < 11) { const int kvh = n0 >> 6, d = n0 & 63;
                        if (bj == 0) *(u32x4*)((bf16_t*)(ws + (pn == 9 ? WS_KS : WS_KW)) + ((size_t)((b * 2 + kvh) * SEQ + s_)) * 64 + d) = pk8(v0, v1);
                        else { bf16_t* base = (bf16_t*)(ws + (pn == 9 ? WS_VST : WS_VWT)) + ((size_t)((b * 2 + kvh) * 128 + (s_ >> 6)) * 64 + d) * 64 + (s_ & 63);
#pragma unroll
                            for (int c = 0; c < 4; ++c) { base[c * 64] = f2bf(v0[c]); base[(4 + c) * 64] = f2bf(v1[c]); } } }
                    else if (bj == 0 && n0 < 24) { float* gp = (float*)(ws + WS_G) + (size_t)t * 24 + n0;
                        *(f32x4*)gp = (f32x4){sigmoidf_(v0[0]), sigmoidf_(v0[1]), sigmoidf_(v0[2]), sigmoidf_(v0[3])};
                        *(f32x4*)(gp + 4) = (f32x4){sigmoidf_(v1[0]), sigmoidf_(v1[1]), sigmoidf_(v1[2]), sigmoidf_(v1[3])}; }
                }
        }
    }
};
__device__ __forceinline__ void phase_inproj(const Params& P, lds_t* lds) {
    SchedInproj S{(const bf16_t*)(P.ws + WS_H1LO), (const bf16_t*)(P.ws + WS_WIN), (int)gridDim.x, (int)blockIdx.x};
    EpiInproj E{P.ws};
    g8::gemm_phase(lds, 1024, S, E);
}

__device__ __forceinline__ float gelu_tanh(float x) {
    const float u = 0.7978845608028654f * (x + 0.044715f * x * x * x);
    const float e = __expf(2.f * u);
    const float th = 1.f - 2.f / (e + 1.f);
    return 0.5f * x * (1.f + th);
}

__device__ __forceinline__ void phase_conv_compress(const Params& P, lds_t* lds) {
    unsigned char* ws = P.ws;
    int tid = threadIdx.x; asm volatile("" : "+v"(tid));
    const int lane = tid & 63, wid = __builtin_amdgcn_readfirstlane(tid >> 6), r = lane & 15, q = lane >> 4, sc = tid & 7, sr = tid >> 3;
    const int G = gridDim.x;
    const int NCW = G >= 2 ? (G / 2 < 128 ? G / 2 : 128) : 1;
    const bool do_cmp = (int)blockIdx.x < NCW, do_conv = G < 2 || (int)blockIdx.x >= NCW;
    if (do_cmp) for (int tile = blockIdx.x; tile < 128; tile += NCW) {
        const int which = tile >> 6, mt = tile & 63;
        const bf16_t* src = (const bf16_t*)(ws + (which ? WS_VC : WS_KC));
        const bf16_t* w1 = (const bf16_t*)(ws + (which ? WS_W1CV : WS_W1CK));
        const bf16_t* w2 = (const bf16_t*)(ws + (which ? WS_W2CV : WS_W2CK));
        const float* bias1 = (const float*)(ws + WS_BIAS1) + which * 128;
        const bf16_t* ap[1]; const bf16_t* bp[2];
        { const int row = mt * 64 + sr; const int bk = row >> 9; int n = row & 511; if (n > 510) n = 510;
            ap[0] = src + (size_t)((bk >> 1) * SEQ + 16 * n) * 128 + (bk & 1) * 64 + sc * 8; }
#pragma unroll
        for (int i = 0; i < 2; ++i) bp[i] = w1 + (size_t)(sr + 64 * i) * 2048 + sc * 8;
        f32x4 acc[2][2];
        gemm_mainloop<64, 128, 32, 32>(lds, ap, 128, bp, 32, acc);
        const int wm = wid >> 2, wn = wid & 3;
#pragma unroll
        for (int i = 0; i < 2; ++i) { const int m = wm * 32 + i * 16 + r;
#pragma unroll
            for (int j = 0; j < 2; ++j) { const int n = wn * 32 + j * 16 + 4 * q; const f32x4 bv = *(const f32x4*)(bias1 + n); f32x4 v = acc[i][j] + bv;
                v = (f32x4){gelu_tanh(v[0]), gelu_tanh(v[1]), gelu_tanh(v[2]), gelu_tanh(v[3])};
                const int kk = n >> 6, c = (n & 63) >> 3, half = (n & 7) >> 2;
                *(LAS u32x2*)(lds + kk * 8192 + lds_off(m, c) + half * 8) = pk4(v); } }
#pragma unroll
        for (int kk = 0; kk < 2; ++kk) lds_st16(lds + 65536 + kk * 8192 + lds_off(sr, sc), *(const u32x4*)(w2 + (size_t)sr * 128 + kk * 64 + sc * 8));
        __syncthreads();
        f32x4 a2[2] = {(f32x4){0.f, 0.f, 0.f, 0.f}, (f32x4){0.f, 0.f, 0.f, 0.f}};
#pragma unroll
        for (int kk = 0; kk < 2; ++kk)
#pragma unroll
            for (int s = 0; s < 2; ++s) {
                const bf16x8 a = lds_ld16(lds + kk * 8192 + lds_off(16 * (wid >> 1) + r, 4 * s + q));
#pragma unroll
                for (int j = 0; j < 2; ++j) { const bf16x8 bq = lds_ld16(lds + 65536 + kk * 8192 + lds_off((wid & 1) * 32 + j * 16 + r, 4 * s + q)); a2[j] = mfma16(bq, a, a2[j]); }
            }
        { const int row = mt * 64 + 16 * (wid >> 1) + r; const int bk = row >> 9, n = row & 511;
#pragma unroll
            for (int j = 0; j < 2; ++j) { const int d = (wid & 1) * 32 + j * 16 + 4 * q; const f32x4 v = a2[j];
                if (!which) *(u32x2*)((bf16_t*)(ws + WS_KCMP) + (size_t)(bk * 512 + n) * 64 + d) = pk4(v);
                else { bf16_t* base = (bf16_t*)(ws + WS_VCMPT) + ((size_t)((bk * 8 + (n >> 6)) * 64 + d)) * 64 + (n & 63);
                    base[0] = f2bf(v[0]); base[64] = f2bf(v[1]); base[128] = f2bf(v[2]); base[192] = f2bf(v[3]); } } }
        __syncthreads();
    }
    {
        const bf16_t* U = (const bf16_t*)(ws + WS_U); const bf16_t* CB = (const bf16_t*)(ws + WS_CB); bf16_t* Y = (bf16_t*)(ws + WS_RA);
        const float* wc = P.in[3];
        const size_t gtid = (size_t)(G < 2 ? 0 : (int)blockIdx.x - NCW) * NTHREADS + tid, gsz = (size_t)(G < 2 ? 1 : G - NCW) * NTHREADS;
        if (do_conv) for (size_t it = gtid; it < (size_t)T * 64; it += gsz) {
            const int t = (int)(it >> 6), c8 = (int)(it & 63) * 8, s = t & 8191;
            const u32x4 u2 = *(const u32x4*)(U + (size_t)t * 512 + c8);
            u32x4 u1 = (u32x4){0, 0, 0, 0}, u0 = (u32x4){0, 0, 0, 0};
            if (s >= 1) u1 = *(const u32x4*)(U + (size_t)(t - 1) * 512 + c8);
            if (s >= 2) u0 = *(const u32x4*)(U + (size_t)(t - 2) * 512 + c8);
            const u32x4 cb = *(const u32x4*)(CB + (size_t)t * 512 + c8);
            const f32x4 w0a = *(const f32x4*)(wc + c8), w0b = *(const f32x4*)(wc + c8 + 4);
            const f32x4 w1a = *(const f32x4*)(wc + 512 + c8), w1b = *(const f32x4*)(wc + 512 + c8 + 4);
            const f32x4 w2a = *(const f32x4*)(wc + 1024 + c8), w2b = *(const f32x4*)(wc + 1024 + c8 + 4);
            u32x4 o;
#define CONV2(W, IDX, A0, A1) { const float y0 = bflo(cb.W) * (w0##A0[IDX] * bflo(u0.W) + w1##A0[IDX] * bflo(u1.W) + w2##A0[IDX] * bflo(u2.W)); \
                                const float y1 = bfhi(cb.W) * (w0##A1[IDX + 1] * bfhi(u0.W) + w1##A1[IDX + 1] * bfhi(u1.W) + w2##A1[IDX + 1] * bfhi(u2.W)); o.W = pk2(y0, y1); }
            CONV2(x, 0, a, a) CONV2(y, 2, a, a) CONV2(z, 0, b, b) CONV2(w, 2, b, b)
#undef CONV2
            *(u32x4*)(Y + (size_t)t * 1024 + c8) = o;
        }
    }
}

constexpr int L_Q = 0;
constexpr int L_IMP = 32768;
constexpr int L_OST = 32768;
constexpr int OSS = 68;
constexpr int L_MS = 102400;
constexpr int L_LS = 103424;
constexpr int L_RING = 104448;
constexpr int L_SELM = 153600;
constexpr int L_LIST = 154624;
constexpr int L_NJ = 162816;
constexpr int IMPS = 129;

struct QKFrag { bf16x8 k[4][2]; };
struct VFrag { bf16x8 v[4][2]; };

__device__ __forceinline__ float red16_max(float v) { auto t = __builtin_amdgcn_permlane16_swap(__float_as_uint(v), __float_as_uint(v), false, false); return fmaxf(__uint_as_float(t[0]), __uint_as_float(t[1])); }
__device__ __forceinline__ float red32_max(float v) { auto t = __builtin_amdgcn_permlane32_swap(__float_as_uint(v), __float_as_uint(v), false, false); return fmaxf(__uint_as_float(t[0]), __uint_as_float(t[1])); }
__device__ __forceinline__ float red16_sum(float v) { auto t = __builtin_amdgcn_permlane16_swap(__float_as_uint(v), __float_as_uint(v), false, false); return __uint_as_float(t[0]) + __uint_as_float(t[1]); }
__device__ __forceinline__ float red32_sum(float v) { auto t = __builtin_amdgcn_permlane32_swap(__float_as_uint(v), __float_as_uint(v), false, false); return __uint_as_float(t[0]) + __uint_as_float(t[1]); }
__device__ __forceinline__ float rowq_max(float v) { return red32_max(red16_max(v)); }
__device__ __forceinline__ float rowq_sum(float v) { return red32_sum(red16_sum(v)); }
template <int CTRL> __device__ __forceinline__ float dpp_f(float v) { return __int_as_float(__builtin_amdgcn_update_dpp(0, __float_as_int(v), CTRL, 0xf, 0xf, true)); }
template <int CTRL> __device__ __forceinline__ int dpp_i(int v) { return __builtin_amdgcn_update_dpp(0, v, CTRL, 0xf, 0xf, true); }
__device__ __forceinline__ float quad_sum(float v) { v += dpp_f<0xB1>(v); v += dpp_f<0x4E>(v); return v; }

__device__ __forceinline__ void lds_kfrag(QKFrag& f, lds_t* kslot, int r, int q) {
    int o0 = r * 128 + ((q ^ (r >> 1)) << 4); asm volatile("" : "+v"(o0));
#pragma unroll
    for (int nt = 0; nt < 4; ++nt)
#pragma unroll
        for (int s = 0; s < 2; ++s) f.k[nt][s] = lds_ld16(kslot + ((o0 ^ (s << 6)) + nt * 2048));
}
__device__ __forceinline__ void lds_vfrag(VFrag& f, lds_t* vslot, int r, int q) {
    int o0 = r * 128 + ((q & 1) << 3) + (((q >> 1) ^ (r >> 1)) << 4); asm volatile("" : "+v"(o0));
#pragma unroll
    for (int dt = 0; dt < 4; ++dt)
#pragma unroll
        for (int ks = 0; ks < 2; ++ks) {
            const u32x2 lo = *(LAS u32x2*)(vslot + ((o0 ^ (ks << 6)) + dt * 2048));
            const u32x2 hi = *(LAS u32x2*)(vslot + ((o0 ^ (ks << 6) ^ 32) + dt * 2048));
            u32x4 w; w.x = lo.x; w.y = lo.y; w.z = hi.x; w.w = hi.y;
            f.v[dt][ks] = __builtin_bit_cast(bf16x8, w);
        }
}
__device__ __forceinline__ void qk_tile(f32x4 (&st)[4], const QKFrag& f, const bf16x8 (&yq)[2]) {
#pragma unroll
    for (int nt = 0; nt < 4; ++nt) { f32x4 z = (f32x4){0.f, 0.f, 0.f, 0.f}; z = mfma16(f.k[nt][0], yq[0], z); st[nt] = mfma16(f.k[nt][1], yq[1], z); }
}
__device__ __forceinline__ void pv_tile(f32x4 (&o)[4], const VFrag& f, const f32x4 (&p)[4]) {
    bf16x8 pf[2];
#pragma unroll
    for (int ks = 0; ks < 2; ++ks) { u32x4 w; w.x = pk2(p[2 * ks][0], p[2 * ks][1]); w.y = pk2(p[2 * ks][2], p[2 * ks][3]); w.z = pk2(p[2 * ks + 1][0], p[2 * ks + 1][1]); w.w = pk2(p[2 * ks + 1][2], p[2 * ks + 1][3]);
        pf[ks] = __builtin_bit_cast(bf16x8, w); }
#pragma unroll
    for (int dt = 0; dt < 4; ++dt) { o[dt] = mfma16(f.v[dt][0], pf[0], o[dt]); o[dt] = mfma16(f.v[dt][1], pf[1], o[dt]); }
}
constexpr float SM_THR = 8.f;
__device__ __forceinline__ void qk_tile_c(f32x4 (&st)[4], const QKFrag& f, const bf16x8 (&yq)[2], f32x4 cinit) {
#pragma unroll
    for (int nt = 0; nt < 4; ++nt) { f32x4 z = mfma16(f.k[nt][0], yq[0], cinit); st[nt] = mfma16(f.k[nt][1], yq[1], z); }
}
__device__ __forceinline__ float max16(const f32x4 (&st)[4]) {
    float a = fmaxf(fmaxf(st[0][0], st[0][1]), fmaxf(st[0][2], st[0][3]));
#pragma unroll
    for (int nt = 1; nt < 4; ++nt) a = fmaxf(a, fmaxf(fmaxf(st[nt][0], st[nt][1]), fmaxf(st[nt][2], st[nt][3])));
    return a;
}
__device__ __forceinline__ void mask16(f32x4 (&st)[4], int lo, int hi) {
#pragma unroll
    for (int nt = 0; nt < 4; ++nt)
#pragma unroll
        for (int c = 0; c < 4; ++c) { const int kc_ = 16 * nt + c; if (!((kc_ <= hi) && (kc_ > lo))) st[nt][c] = -1e30f; }
}
__device__ __forceinline__ void softmax_first(float& m, float& l, f32x4& negm, f32x4 (&st)[4]) {
    const float mx = rowq_max(max16(st));
    m = (mx > -1e29f) ? mx : 0.f; negm = (f32x4){-m, -m, -m, -m};
    float ps = 0.f;
#pragma unroll
    for (int nt = 0; nt < 4; ++nt)
#pragma unroll
        for (int c = 0; c < 4; ++c) { const float pp = fexp2(st[nt][c] - m); st[nt][c] = pp; ps += pp; }
    l = ps;
}
template <bool HAS_O>
__device__ __forceinline__ void softmax_next(float& m, float& l, f32x4& negm, f32x4 (&o)[4], f32x4 (&st)[4]) {
    const float mxl = max16(st);
    if (__builtin_amdgcn_ballot_w64(mxl > SM_THR) != 0ull) {
        const float mx = rowq_max(mxl); const float sh = (mx > SM_THR) ? mx : 0.f; const float a = fexp2(-sh);
        m += sh; l *= a; negm = (f32x4){-m, -m, -m, -m};
        if (HAS_O) {
#pragma unroll
            for (int d = 0; d < 4; ++d) o[d] = o[d] * a; }
#pragma unroll
        for (int nt = 0; nt < 4; ++nt)
#pragma unroll
            for (int c = 0; c < 4; ++c) st[nt][c] -= sh;
    }
    float ps = 0.f;
#pragma unroll
    for (int nt = 0; nt < 4; ++nt)
#pragma unroll
        for (int c = 0; c < 4; ++c) { const float pp = fexp2(st[nt][c]); st[nt][c] = pp; ps += pp; }
    l += ps;
}

__device__ __forceinline__ void phase_nsa(const Params& P, lds_t* lds) {
    unsigned char* ws = P.ws;
    const int wid = __builtin_amdgcn_readfirstlane(threadIdx.x >> 6);
    const int G = gridDim.x, g = blockIdx.x;
    if (wid >= 4) __builtin_amdgcn_s_setprio(1);
#define NSA_TID int tid = threadIdx.x; asm volatile("" : "+v"(tid));
#define NSA_LANE_VARS int lane_ = threadIdx.x & 63; asm volatile("" : "+v"(lane_)); const int r = lane_ & 15, q = lane_ >> 4;
    const bf16_t* Qb = (const bf16_t*)(ws + WS_Q);
    const float* GT = (const float*)(ws + WS_G);
    bf16_t* Y = (bf16_t*)(ws + WS_RA);
    LAS float* IMPA = (LAS float*)(lds + L_IMP);
    LAS float* IMPB = (LAS float*)(lds + L_IMP + 64 * IMPS * 4);
    LAS unsigned* SELM = (LAS unsigned*)(lds + L_SELM);
    LAS unsigned char* LIST = (LAS unsigned char*)(lds + L_LIST);
    LAS unsigned char* NJ = (LAS unsigned char*)(lds + L_NJ);
    const f32x4 NEGBIG = (f32x4){-1e30f, -1e30f, -1e30f, -1e30f};
    const f32x4 ZERO4 = (f32x4){0.f, 0.f, 0.f, 0.f};

    const int GQ = G >> 3;
    for (int k = 0;; ++k) {
        int jt, bk;
        if ((G & 7) == 0 && GQ > 0) { const int gi = g >> 3; const int u = (k & 1) ? (k + 1) * GQ - 1 - gi : k * GQ + gi; if (k * GQ >= 128) break; if (u >= 128) continue; jt = 127 - u; bk = g & 7; }
        else { const int idx = k * G + g; if (idx >= 1024) break; jt = 127 - (idx >> 3); bk = idx & 7; }
        const int b = bk >> 1, kvh = bk & 1, t0 = jt * 64;
        { NSA_TID
#pragma unroll
        for (int i = 0; i < 4; ++i) { const int row = (tid >> 3) + 64 * i, c = tid & 7, tok = row >> 2, hh = row & 3;
            lds_st16(lds + L_Q + lds_off(row, c), *(const u32x4*)(Qb + (size_t)(b * SEQ + t0 + tok) * 512 + kvh * 256 + hh * 64 + c * 8)); }
        if (tid < 256) SELM[tid] = 0u; }
        __syncthreads();
#define NSA_GATE(h_, br_) (GT[(size_t)(b * SEQ + t0 + ((32 * wid + 16 * (h_) + r) >> 2)) * 24 + (kvh * 4 + (r & 3)) * 3 + (br_)])
        { NSA_LANE_VARS NSA_TID
            const int nblk = (4 * jt + 3 + 63) >> 6;
            const int nfull = 4 * jt - 2;
            const unsigned goff = (unsigned)tid * 16u;
            const unsigned char* kcb = ws + WS_KCMP + (size_t)bk * 65536;
            const unsigned char* vcb = ws + WS_VCMPT + (size_t)bk * 65536;
            const int stw = lds_off(tid >> 3, tid & 7);
            bf16x8 yq[2][2]; int nlim[2]; float cm[2] = {0.f, 0.f}, cl[2] = {0.f, 0.f}; f32x4 negm[2] = {ZERO4, ZERO4};
#pragma unroll
            for (int h = 0; h < 2; ++h) { const int qrow = 32 * wid + 16 * h + r; nlim[h] = (t0 + (qrow >> 2) - 31) >> 4;
#pragma unroll
                for (int s = 0; s < 2; ++s) yq[h][s] = lds_ld16(lds + L_Q + lds_off(qrow, 4 * s + q)); }
            {
                u32x4 pk_ = *(const u32x4*)(kcb + goff);
#pragma unroll 1
                for (int blk = 0; blk < nblk; ++blk) {
                    lds_t* slot = lds + L_RING + (blk & 1) * 16384;
                    lds_st16(slot + stw, pk_);
                    if (blk + 1 < nblk) pk_ = *(const u32x4*)(kcb + (size_t)(blk + 1) * 8192 + goff);
                    __syncthreads();
                    QKFrag kf; lds_kfrag(kf, slot, r, q);
                    const bool edge = (64 * blk + 63 > nfull);
#pragma unroll
                    for (int h = 0; h < 2; ++h) {
                        f32x4 st[4], dummy[4];
                        if (blk == 0) { qk_tile_c(st, kf, yq[h], ZERO4); if (edge) mask16(st, -1000, nlim[h] - 4 * q); softmax_first(cm[h], cl[h], negm[h], st); }
                        else { qk_tile_c(st, kf, yq[h], negm[h]); if (edge) mask16(st, -1000, nlim[h] - 64 * blk - 4 * q); softmax_next<false>(cm[h], cl[h], negm[h], dummy, st); }
                    }
                }
            }
            float cil[2];
#pragma unroll
            for (int h = 0; h < 2; ++h) { const float l = rowq_sum(cl[h]); cil[h] = l > 0.f ? 1.f / l : 0.f; }
            __syncthreads();
            f32x4 oc[2][4];
#pragma unroll
            for (int h = 0; h < 2; ++h)
#pragma unroll
                for (int d = 0; d < 4; ++d) oc[h][d] = ZERO4;
            {
                u32x4 pk_ = *(const u32x4*)(kcb + goff), pv_ = *(const u32x4*)(vcb + goff);
#pragma unroll 1
                for (int blk = 0; blk < nblk; ++blk) {
                    lds_t* slot = lds + L_RING + (blk & 1) * 16384;
                    lds_st16(slot + stw, pk_); lds_st16(slot + 8192 + stw, pv_);
                    if (blk + 1 < nblk) { pk_ = *(const u32x4*)(kcb + (size_t)(blk + 1) * 8192 + goff); pv_ = *(const u32x4*)(vcb + (size_t)(blk + 1) * 8192 + goff); }
                    __syncthreads();
                    QKFrag kf; lds_kfrag(kf, slot, r, q);
                    const bool edge = (64 * blk + 63 > nfull);
                    f32x4 st[2][4];
#pragma unroll
                    for (int h = 0; h < 2; ++h) {
                        qk_tile_c(st[h], kf, yq[h], negm[h]);
                        if (edge) mask16(st[h], -1000, nlim[h] - 64 * blk - 4 * q);
                        const int tok = (32 * wid + 16 * h + r) >> 2;
#pragma unroll
                        for (int nt = 0; nt < 4; ++nt) {
#pragma unroll
                            for (int c = 0; c < 4; ++c) st[h][nt][c] = fexp2(st[h][nt][c]);
                            const float s4 = quad_sum(((st[h][nt][0] + st[h][nt][1]) + (st[h][nt][2] + st[h][nt][3])) * cil[h]), p3 = quad_sum(st[h][nt][3] * cil[h]);
                            if ((r & 3) == 0) { const int jj = 16 * blk + 4 * nt + q; IMPA[tok * IMPS + jj] = s4; IMPB[tok * IMPS + jj + 1] = p3; }
                        }
                    }
                    VFrag vf; lds_vfrag(vf, slot + 8192, r, q);
#pragma unroll
                    for (int h = 0; h < 2; ++h) pv_tile(oc[h], vf, st[h]);
                }
            }
#pragma unroll
            for (int h = 0; h < 2; ++h) { const int tok = (32 * wid + 16 * h + r) >> 2;
                bf16_t* yp = Y + (size_t)(b * SEQ + t0 + tok) * 1024 + 512 + (kvh * 4 + (r & 3)) * 64 + 4 * q;
                const float sc_ = NSA_GATE(h, 0) * cil[h];
#pragma unroll
                for (int d = 0; d < 4; ++d) *(u32x2*)(yp + 16 * d) = pk4(oc[h][d] * sc_); }
        }
        __syncthreads();
        const bool dense_all = (jt < 16);
        if (!dense_all) {
        { NSA_TID
            const int tok = tid >> 3, sub = tid & 7;
            unsigned flags = 0;
            {
                unsigned key[16];
#pragma unroll
                for (int i = 0; i < 16; ++i) { const int j = sub * 16 + i; const bool valid = (j >= 1 && j <= jt - 2);
                    const float v = IMPA[tok * IMPS + j] + IMPB[tok * IMPS + j]; key[i] = valid ? ((__float_as_uint(v) & 0xFFFFFF80u) | (unsigned)(127 - j)) : 0u; }
                unsigned tau = 0;
#pragma unroll 1
                for (int bit = 30; bit >= 0; --bit) {
                    const unsigned cand = tau | (1u << bit); int cnt = 0;
#pragma unroll
                    for (int i = 0; i < 16; ++i) cnt += (key[i] >= cand) ? 1 : 0;
                    cnt += dpp_i<0xB1>(cnt); cnt += dpp_i<0x4E>(cnt); cnt += dpp_i<0x141>(cnt);
                    if (cnt >= 13) tau = cand;
                }
#pragma unroll
                for (int i = 0; i < 16; ++i) if (key[i] != 0u && key[i] >= tau) flags |= 1u << i;
            }
#pragma unroll
            for (int i = 0; i < 16; ++i) if (flags & (1u << i)) lds_oru(&SELM[(sub * 16 + i) * 2 + (tok >> 5)], 1u << (tok & 31));
        }
        __syncthreads();
        { NSA_TID
            LAS unsigned short* LISTP = (LAS unsigned short*)(lds + L_LIST);
            const int p = tid >> 3, cls = tid & 7;
            if (p < 43 && cls < 7) {
                const int j0 = 1 + 3 * p;
                const unsigned long long A = ((unsigned long long)SELM[j0 * 2 + 1] << 32) | SELM[j0 * 2];
                const unsigned long long B = (j0 + 1 < 128) ? (((unsigned long long)SELM[(j0 + 1) * 2 + 1] << 32) | SELM[(j0 + 1) * 2]) : 0ull;
                const unsigned long long C = (j0 + 2 < 128) ? (((unsigned long long)SELM[(j0 + 2) * 2 + 1] << 32) | SELM[(j0 + 2) * 2]) : 0ull;
                int pos = 0; unsigned long long mine = 0ull; unsigned mkv = 0u;
#define NSA_CLS(K, M, V) { const unsigned long long cm_ = (M); if (cls > (K)) pos += __popcll(cm_); if (cls == (K)) { mine = cm_; mkv = (V); } }
                NSA_CLS(0, A & B & C, 7u) NSA_CLS(1, A & ~B & C, 5u) NSA_CLS(2, A & ~B & ~C, 1u) NSA_CLS(3, A & B & ~C, 3u) NSA_CLS(4, ~A & B & ~C, 2u) NSA_CLS(5, ~A & B & C, 6u) NSA_CLS(6, ~A & ~B & C, 4u)
#undef NSA_CLS
                while (mine) { const int t = __ffsll((long long)mine) - 1; LISTP[p * 64 + pos] = (unsigned short)((unsigned)t | (mkv << 8)); ++pos; mine &= mine - 1; }
                if (cls == 6) NJ[p] = (unsigned char)__popcll(A | B | C);
            }
        }
        __syncthreads();
        }
        { NSA_LANE_VARS NSA_TID
            const int nf = dense_all ? jt + 1 : 3;
            const int jb0 = jt >= 8 ? jt - 8 : 0, nb = jt - jb0 + 1, nd = nf + nb;
            const unsigned goff = (unsigned)tid * 16u;
            const unsigned char* ksb = ws + WS_KS + (size_t)bk * 1048576;
            const unsigned char* vsb = ws + WS_VST + (size_t)bk * 1048576;
            const unsigned char* kwb = ws + WS_KW + (size_t)bk * 1048576;
            const unsigned char* vwb = ws + WS_VWT + (size_t)bk * 1048576;
            const int stw = lds_off(tid >> 3, tid & 7);
            bf16x8 yq[2][2]; float wm_[2] = {0.f, 0.f}, wl[2] = {0.f, 0.f}, sm_[2] = {0.f, 0.f}, sl[2] = {0.f, 0.f};
            f32x4 ow[2][4], os[2][4];
#pragma unroll
            for (int h = 0; h < 2; ++h) { const int qrow = 32 * wid + 16 * h + r;
#pragma unroll
                for (int s = 0; s < 2; ++s) yq[h][s] = lds_ld16(lds + L_Q + lds_off(qrow, 4 * s + q));
#pragma unroll
                for (int d = 0; d < 4; ++d) { ow[h][d] = ZERO4; os[h][d] = ZERO4; } }
            auto item_blk = [&](int i) -> int { return i < nf ? (dense_all ? i : (i == 0 ? 0 : jt - 2 + i)) : jb0 + (i - nf); };
            u32x4 pk0, pv0;
            { const int j = item_blk(0); pk0 = *(const u32x4*)(ksb + (size_t)j * 8192 + goff); pv0 = *(const u32x4*)(vsb + (size_t)j * 8192 + goff); }
            auto dense_item = [&](lds_t* slot, float (&m)[2], float (&l)[2], f32x4 (&o)[2][4], bool first, bool dhi, bool dlo) {
                QKFrag kf; lds_kfrag(kf, slot, r, q);
                f32x4 st[2][4];
                const bool edge = dhi || dlo;
#pragma unroll
                for (int h = 0; h < 2; ++h) { if (first) qk_tile_c(st[h], kf, yq[h], ZERO4); else { const f32x4 ng = (f32x4){-m[h], -m[h], -m[h], -m[h]}; qk_tile_c(st[h], kf, yq[h], ng); } }
                if (edge) {
#pragma unroll
                    for (int h = 0; h < 2; ++h) { const int tok = (32 * wid + 16 * h + r) >> 2;
                        mask16(st[h], dlo ? (tok - 4 * q) : -1000, dhi ? (tok - 4 * q) : 1000); } }
                if (first) {
#pragma unroll
                    for (int h = 0; h < 2; ++h) { f32x4 ng; softmax_first(m[h], l[h], ng, st[h]); }
                } else {
                    const float mx0 = max16(st[0]), mx1 = max16(st[1]);
                    if (__builtin_amdgcn_ballot_w64(mx0 > SM_THR || mx1 > SM_THR) != 0ull) {
#pragma unroll
                        for (int h = 0; h < 2; ++h) { const float mx = rowq_max(h ? mx1 : mx0); const float sh = (mx > SM_THR) ? mx : 0.f; const float a_ = fexp2(-sh);
                            m[h] += sh; l[h] *= a_;
#pragma unroll
                            for (int d = 0; d < 4; ++d) o[h][d] = o[h][d] * a_;
#pragma unroll
                            for (int nt = 0; nt < 4; ++nt)
#pragma unroll
                                for (int c = 0; c < 4; ++c) st[h][nt][c] -= sh; }
                    }
                }
                VFrag vf; lds_vfrag(vf, slot + 8192, r, q);
#pragma unroll
                for (int h = 0; h < 2; ++h) {
                    if (!first) { float ps = 0.f;
#pragma unroll
                        for (int nt = 0; nt < 4; ++nt)
#pragma unroll
                            for (int c = 0; c < 4; ++c) { const float pp = fexp2(st[h][nt][c]); st[h][nt][c] = pp; ps += pp; }
                        l[h] += ps; }
                    pv_tile(o[h], vf, st[h]);
                }
            };
#pragma unroll 1
            for (int i = 0; i < nd; ++i) {
                lds_t* slot = lds + L_RING + (i & 1) * 16384;
                lds_st16(slot + stw, pk0); lds_st16(slot + 8192 + stw, pv0);
                if (i + 1 < nd) { const int j = item_blk(i + 1); const bool sn = (i + 1 < nf);
                    pk0 = *(const u32x4*)((sn ? ksb : kwb) + (size_t)j * 8192 + goff); pv0 = *(const u32x4*)((sn ? vsb : vwb) + (size_t)j * 8192 + goff); }
                __syncthreads();
                const int j = item_blk(i);
                if (i < nf) dense_item(slot, sm_, sl, os, i == 0, j == jt, false);
                else dense_item(slot, wm_, wl, ow, i == nf, j == jt, j == jt - 8);
            }
#pragma unroll
            for (int h = 0; h < 2; ++h) { const int qrow = 32 * wid + 16 * h + r; const int tok = qrow >> 2; const float l = rowq_sum(wl[h]); const float il = l > 0.f ? NSA_GATE(h, 2) / l : 0.f;
                bf16_t* yp = Y + (size_t)(b * SEQ + t0 + tok) * 1024 + 512 + (kvh * 4 + (r & 3)) * 64 + 4 * q;
#pragma unroll
                for (int d = 0; d < 4; ++d) { const u32x2 w = *(const u32x2*)(yp + 16 * d); f32x4 v = ow[h][d] * il; v[0] += bflo(w.x); v[1] += bfhi(w.x); v[2] += bflo(w.y); v[3] += bfhi(w.y); *(u32x2*)(yp + 16 * d) = pk4(v); }
                const float ls = rowq_sum(sl[h]);
                LAS float* orow = (LAS float*)(lds + L_OST) + qrow * OSS + 4 * q;
#pragma unroll
                for (int d = 0; d < 4; ++d) *(LAS f32x4*)(orow + 16 * d) = os[h][d];
                if (q == 0) { ((LAS float*)(lds + L_MS))[qrow] = sm_[h]; ((LAS float*)(lds + L_LS))[qrow] = ls; } }
        }
        __syncthreads();
        { NSA_LANE_VARS NSA_TID
            LAS float* MS = (LAS float*)(lds + L_MS); LAS float* LS = (LAS float*)(lds + L_LS);
            if (!dense_all) {
            const unsigned goff = (unsigned)tid * 16u;
            const unsigned char* ksb = ws + WS_KS + (size_t)bk * 1048576;
            const unsigned char* vsb = ws + WS_VST + (size_t)bk * 1048576;
            const int stw = lds_off(tid >> 3, tid & 7);
            const int jlast = jt - 2, nstep = jt / 3;
            const LAS unsigned short* LISTP = (const LAS unsigned short*)(lds + L_LIST);
            u32x4 pk[3], pv[3];
#pragma unroll
            for (int x = 0; x < 3; ++x) { const int jb = 1 + x < jlast ? 1 + x : jlast; pk[x] = *(const u32x4*)(ksb + (size_t)jb * 8192 + goff); pv[x] = *(const u32x4*)(vsb + (size_t)jb * 8192 + goff); }
#pragma unroll 1
            for (int p = 0; p < nstep; ++p) {
#pragma unroll
                for (int x = 0; x < 3; ++x) { lds_st16(lds + L_RING + x * 16384 + stw, pk[x]); lds_st16(lds + L_RING + x * 16384 + 8192 + stw, pv[x]); }
                if (p + 1 < nstep) {
#pragma unroll
                    for (int x = 0; x < 3; ++x) { int jb = 3 * p + 4 + x; jb = jb < jlast ? jb : jlast; pk[x] = *(const u32x4*)(ksb + (size_t)jb * 8192 + goff); pv[x] = *(const u32x4*)(vsb + (size_t)jb * 8192 + goff); } }
                __syncthreads();
                const int np = __builtin_amdgcn_readfirstlane((int)NJ[p]); const int nch = (np + 3) >> 2;
                const int c1 = (wid + 8 - (p & 7)) & 7;
#pragma unroll 1
                for (int c = c1; c < nch; c = (c < 8 ? 15 - c : 16)) {
                    const int ix = 4 * c + (r >> 2); const bool valid = ix < np;
                    const unsigned ent = LISTP[p * 64 + (valid ? ix : 0)];
                    const int tok = (int)(ent & 63u); const unsigned mk = valid ? (ent >> 8) : 0u;
                    const int qrow = tok * 4 + (r & 3);
                    bf16x8 yy[2];
#pragma unroll
                    for (int s2 = 0; s2 < 2; ++s2) yy[s2] = lds_ld16(lds + L_Q + lds_off(qrow, 4 * s2 + q));
                    float mref = MS[qrow];
                    LAS float* orow = (LAS float*)(lds + L_OST) + qrow * OSS + 4 * q;
                    f32x4 o[4]; float lacc = 0.f, asc = 1.f;
#pragma unroll
                    for (int d = 0; d < 4; ++d) o[d] = *(LAS f32x4*)(orow + 16 * d);
#pragma unroll
                    for (int x = 0; x < 3; ++x) {
                        const bool sel = ((mk >> x) & 1u) != 0u;
                        if (__builtin_amdgcn_ballot_w64(sel) == 0ull) continue;
                        lds_t* kslot = lds + L_RING + x * 16384;
                        QKFrag kf; lds_kfrag(kf, kslot, r, q);
                        VFrag vf; lds_vfrag(vf, kslot + 8192, r, q);
                        f32x4 st[4];
                        const f32x4 cin = sel ? (f32x4){-mref, -mref, -mref, -mref} : NEGBIG;
                        qk_tile_c(st, kf, yy, cin);
                        const float mxl = max16(st);
                        if (__builtin_amdgcn_ballot_w64(mxl > SM_THR) != 0ull) {
                            const float mx = rowq_max(mxl); const float sh = (mx > SM_THR) ? mx : 0.f; const float a = fexp2(-sh);
                            mref += sh; asc *= a; lacc *= a;
#pragma unroll
                            for (int d = 0; d < 4; ++d) o[d] = o[d] * a;
#pragma unroll
                            for (int nt = 0; nt < 4; ++nt)
#pragma unroll
                                for (int cc = 0; cc < 4; ++cc) st[nt][cc] -= sh;
                        }
                        float ps = 0.f;
#pragma unroll
                        for (int nt = 0; nt < 4; ++nt)
#pragma unroll
                            for (int cc = 0; cc < 4; ++cc) { const float pp = fexp2(st[nt][cc]); st[nt][cc] = pp; ps += pp; }
                        lacc += ps;
                        pv_tile(o, vf, st);
                    }
                    lacc = rowq_sum(lacc);
                    if (valid) {
#pragma unroll
                        for (int d = 0; d < 4; ++d) *(LAS f32x4*)(orow + 16 * d) = o[d];
                        if (q == 0) { LS[qrow] = LS[qrow] * asc + lacc; MS[qrow] = mref; } }
                }
                __syncthreads();
            }
            }
#pragma unroll
            for (int h = 0; h < 2; ++h) { const int qrow = 32 * wid + 16 * h + r; const int tok = qrow >> 2;
                const float l = LS[qrow]; const float il = l > 0.f ? NSA_GATE(h, 1) / l : 0.f;
                const LAS float* orow = (LAS float*)(lds + L_OST) + qrow * OSS + 4 * q;
                bf16_t* yp = Y + (size_t)(b * SEQ + t0 + tok) * 1024 + 512 + (kvh * 4 + (r & 3)) * 64 + 4 * q;
#pragma unroll
                for (int d = 0; d < 4; ++d) { const u32x2 w = *(const u32x2*)(yp + 16 * d); f32x4 v = *(const LAS f32x4*)(orow + 16 * d) * il; v[0] += bflo(w.x); v[1] += bfhi(w.x); v[2] += bflo(w.y); v[3] += bfhi(w.y); *(u32x2*)(yp + 16 * d) = pk4(v); } }
        }
        __syncthreads();
    }
#ifdef STEP_BENCH
    {
        const int tid = threadIdx.x; const unsigned goff = (unsigned)tid * 16u;
        const unsigned char* ksb = ws + WS_KS + (size_t)(blockIdx.x & 7) * 1048576;
        const int stw = lds_off(tid >> 3, tid & 7);
        u32x4 pkA = *(const u32x4*)(ksb + goff), pvA = *(const u32x4*)(ksb + 8192 + goff);
        int slot_c = 0;
        for (int j = 0; j < STEP_BENCH; ++j) {
            const int slot_n = (slot_c == 2) ? 0 : slot_c + 1;
            lds_st16(lds + L_RING + slot_n * 16384 + stw, pkA); lds_st16(lds + L_RING + slot_n * 16384 + 8192 + stw, pvA);
            pkA = *(const u32x4*)(ksb + (size_t)((j + 2) & 127) * 8192 + goff); pvA = *(const u32x4*)(ksb + (size_t)((j + 3) & 127) * 8192 + goff);
            __syncthreads();
            slot_c = slot_n;
        }
        if (pkA.x == 0x12345678u && pvA.y == 0x9abcdef0u) ((unsigned*)(ws + WS_CTL))[100] = 1;
        __syncthreads();
    }
#endif
    __builtin_amdgcn_s_setprio(0);
#undef NSA_LANE_VARS
#undef NSA_TID
#undef NSA_GATE
}

__device__ __forceinline__ float wave_sum(float v) {
    v += dpp_f<0xB1>(v); v += dpp_f<0x4E>(v); v += dpp_f<0x141>(v); v += dpp_f<0x140>(v);
    return red32_sum(red16_sum(v));
}
__device__ __forceinline__ void ln_row(f32x4 (&v)[4], const f32x4 (&g)[4], const f32x4 (&bt)[4]) {
    float s = 0.f;
#pragma unroll
    for (int j = 0; j < 4; ++j) s += (v[j][0] + v[j][1]) + (v[j][2] + v[j][3]);
    const float mean = wave_sum(s) * (1.f / 1024.f);
    float ss = 0.f;
#pragma unroll
    for (int j = 0; j < 4; ++j) { v[j] = v[j] - mean; ss += (v[j][0] * v[j][0] + v[j][1] * v[j][1]) + (v[j][2] * v[j][2] + v[j][3] * v[j][3]); }
    const float rstd = rsqrtf(wave_sum(ss) * (1.f / 1024.f) + LN_EPS);
#pragma unroll
    for (int j = 0; j < 4; ++j) v[j] = v[j] * rstd * g[j] + bt[j];
}
__device__ __forceinline__ void split_store(bf16_t* hi, bf16_t* lo, f32x4 h) {
    const u32x2 ph = pk4(h);
    f32x4 res; res[0] = h[0] - bflo(ph.x); res[1] = h[1] - bfhi(ph.x); res[2] = h[2] - bflo(ph.y); res[3] = h[3] - bfhi(ph.y);
    *(u32x2*)hi = ph; *(u32x2*)lo = pk4(res);
}
__device__ __forceinline__ f32x4 split_load(const bf16_t* hi, const bf16_t* lo) {
    const u32x2 a = *(const u32x2*)hi, b = *(const u32x2*)lo;
    return (f32x4){bflo(a.x) + bflo(b.x), bfhi(a.x) + bfhi(b.x), bflo(a.y) + bflo(b.y), bfhi(a.y) + bfhi(b.y)};
}

__device__ __forceinline__ void panel_ln_stats(const f32x4 (&val)[8][4], int mt, int ct, unsigned* cnt, unsigned long long* xch, lds_t* scr, int wr, int wc, int r, int q) {
    LAS f32x2* Pp = (LAS f32x2*)scr;
    LAS f32x2* Ss = (LAS f32x2*)(scr + 8192);
    LAS unsigned* flag = (LAS unsigned*)(scr + 8192 + 2048);
    const int tid = threadIdx.x;
#pragma unroll
    for (int i = 0; i < 8; ++i) {
        float sacc = 0.f, sq = 0.f;
#pragma unroll
        for (int j = 0; j < 4; ++j) { const f32x4 v = val[i][j]; sacc += (v[0] + v[1]) + (v[2] + v[3]); sq += (v[0] * v[0] + v[1] * v[1]) + (v[2] * v[2] + v[3] * v[3]); }
        sacc = rowq_sum(sacc); sq = rowq_sum(sq);
        const float mw = sacc * (1.f / 64.f);
        if (q == 0) Pp[(wr * 128 + i * 16 + r) * 4 + wc] = (f32x2){mw, fmaxf(sq - sacc * mw, 0.f)};
        asm volatile("" ::: "memory");
    }
    __syncthreads();
    if (tid < 256) {
        const f32x2 a = Pp[tid * 4 + 0], b = Pp[tid * 4 + 1], c = Pp[tid * 4 + 2], d = Pp[tid * 4 + 3];
        const float m4 = (a.x + b.x + c.x + d.x) * 0.25f;
        const float da = a.x - m4, db = b.x - m4, dc = c.x - m4, dd = d.x - m4;
        const float m2 = (a.y + b.y) + (c.y + d.y) + 64.0f * ((da * da + db * db) + (dc * dc + dd * dd));
        __hip_atomic_store(xch + ((size_t)(mt * 256 + tid) * 4 + ct), ((unsigned long long)__float_as_uint(m2) << 32) | __float_as_uint(m4), __ATOMIC_RELAXED, __HIP_MEMORY_SCOPE_AGENT);
    }
    asm volatile("s_waitcnt vmcnt(0)" ::: "memory");
    __syncthreads();
    if (tid < 64) {
        if (tid == 0) __hip_atomic_fetch_add(cnt + 64 * mt, 1u, __ATOMIC_RELAXED, __HIP_MEMORY_SCOPE_AGENT);
        unsigned spins = 0;
        while ((unsigned)__builtin_amdgcn_readfirstlane(__hip_atomic_load(cnt + 64 * mt, __ATOMIC_RELAXED, __HIP_MEMORY_SCOPE_AGENT)) < 4u) { __builtin_amdgcn_s_sleep(2); if (++spins > (1u << 22)) break; }
        __builtin_amdgcn_fence(__ATOMIC_ACQUIRE, "agent");
        if (tid == 0) flag[0] = 1u;
    }
    asm volatile("s_waitcnt vmcnt(0) lgkmcnt(0)" ::: "memory");
    __syncthreads();
    if (tid < 256) {
        const unsigned long long* sl = xch + (size_t)(mt * 256 + tid) * 4; float mm[4], m2[4], ms = 0.f;
#pragma unroll
        for (int t = 0; t < 4; ++t) { const unsigned long long w = __hip_atomic_load(sl + t, __ATOMIC_RELAXED, __HIP_MEMORY_SCOPE_AGENT); mm[t] = __uint_as_float((unsigned)w); m2[t] = __uint_as_float((unsigned)(w >> 32)); ms += mm[t]; }
        const float mean = ms * 0.25f; float qq = 0.f;
#pragma unroll
        for (int t = 0; t < 4; ++t) { const float dm = mm[t] - mean; qq += m2[t] + 256.0f * dm * dm; }
        Ss[tid] = (f32x2){mean, rsqrtf(qq * (1.f / 1024.f) + LN_EPS)};
    }
    __syncthreads();
}

__device__ __forceinline__ void panel_ln_stats8(const g8::Acc& v, int mt, int ct, unsigned* cnt, unsigned long long* xch, lds_t* scr, int wr, int wc, int fr, int fq) {
    LAS f32x2* Pp = (LAS f32x2*)scr;
    LAS f32x2* Ss = (LAS f32x2*)(scr + 8192);
    const int tid = threadIdx.x;
#pragma unroll
    for (int ai = 0; ai < 2; ++ai)
#pragma unroll
        for (int m = 0; m < 4; ++m) {
            float sacc = 0.f;
#pragma unroll
            for (int bj = 0; bj < 2; ++bj)
#pragma unroll
                for (int n = 0; n < 2; ++n) { const f32x4 x = v[ai][bj][m][n]; sacc += (x[0] + x[1]) + (x[2] + x[3]); }
            sacc = rowq_sum(sacc);
            const float mw = sacc * (1.f / 64.f); float sq = 0.f;
#pragma unroll
            for (int bj = 0; bj < 2; ++bj)
#pragma unroll
                for (int n = 0; n < 2; ++n) { const f32x4 d = v[ai][bj][m][n] - mw; sq += (d[0] * d[0] + d[1] * d[1]) + (d[2] * d[2] + d[3] * d[3]); }
            sq = rowq_sum(sq);
            if (fq == 0) Pp[(ai * 128 + wr * 64 + m * 16 + fr) * 4 + wc] = (f32x2){mw, sq};
        }
    __syncthreads();
    if (tid < 256) {
        const f32x2 a = Pp[tid * 4 + 0], b = Pp[tid * 4 + 1], c = Pp[tid * 4 + 2], d = Pp[tid * 4 + 3];
        const float m4 = (a.x + b.x + c.x + d.x) * 0.25f;
        const float da = a.x - m4, db = b.x - m4, dc = c.x - m4, dd = d.x - m4;
        const float m2 = (a.y + b.y) + (c.y + d.y) + 64.0f * ((da * da + db * db) + (dc * dc + dd * dd));
        __hip_atomic_store(xch + ((size_t)(mt * 256 + tid) * 4 + ct), ((unsigned long long)__float_as_uint(m2) << 32) | __float_as_uint(m4), __ATOMIC_RELAXED, __HIP_MEMORY_SCOPE_AGENT);
    }
    asm volatile("s_waitcnt vmcnt(0)" ::: "memory");
    __syncthreads();
    if (tid < 64) {
        if (tid == 0) __hip_atomic_fetch_add(cnt + 64 * mt, 1u, __ATOMIC_RELAXED, __HIP_MEMORY_SCOPE_AGENT);
        unsigned spins = 0;
        while ((unsigned)__builtin_amdgcn_readfirstlane(__hip_atomic_load(cnt + 64 * mt, __ATOMIC_RELAXED, __HIP_MEMORY_SCOPE_AGENT)) < 4u) { __builtin_amdgcn_s_sleep(2); if (++spins > (1u << 22)) break; }
        __builtin_amdgcn_fence(__ATOMIC_ACQUIRE, "agent");
    }
    asm volatile("s_waitcnt vmcnt(0) lgkmcnt(0)" ::: "memory");
    __syncthreads();
    if (tid < 256) {
        const unsigned long long* sl = xch + (size_t)(mt * 256 + tid) * 4; float mm[4], m2[4], ms = 0.f;
#pragma unroll
        for (int t = 0; t < 4; ++t) { const unsigned long long w = __hip_atomic_load(sl + t, __ATOMIC_RELAXED, __HIP_MEMORY_SCOPE_AGENT); mm[t] = __uint_as_float((unsigned)w); m2[t] = __uint_as_float((unsigned)(w >> 32)); ms += mm[t]; }
        const float mean = ms * 0.25f; float qq = 0.f;
#pragma unroll
        for (int t = 0; t < 4; ++t) { const float dm = mm[t] - mean; qq += m2[t] + 256.0f * dm * dm; }
        Ss[tid] = (f32x2){mean, rsqrtf(qq * (1.f / 1024.f) + LN_EPS)};
    }
    __syncthreads();
}
__device__ __forceinline__ int ln_tile(int it) { const int G = gridDim.x, bid = blockIdx.x;
    if (G & 31) return bid + it * G;
    return it * G + (((bid & 7) + 8 * (bid >> 5)) << 2) + ((bid >> 3) & 3); }
struct SchedOne {
    const bf16_t* A; const bf16_t* W; int K, tile;
    __device__ __forceinline__ bool next(int i, g8::Unit& u) const { if (i > 0 || tile >= 128 * 4) return false; u.pm = tile >> 2; u.pn = tile & 3; return true; }
    __device__ __forceinline__ const char* a_base(const g8::Unit& u) const { return (const char*)(A + (size_t)u.pm * 256 * K); }
    __device__ __forceinline__ const char* b_base(const g8::Unit& u, int h) const { return (const char*)(W + (size_t)(u.pn * 256 + h * 128) * K); }
    __device__ __forceinline__ void a_offsets(const g8::Unit&, unsigned (&v)[2][2], int tid) const { g8::natural_offsets(v, K, tid); }
};

struct EpiOutLn1 {
    static constexpr bool AFTER_DRAIN = true;
    const bf16_t* xb; const float* gam; const float* bet; unsigned char* ws; lds_t* lds;
    __device__ __forceinline__ void init(g8::Acc& acc, const g8::Unit& u, int wr, int wc, int fr, int fq) const {
        const bf16_t* xp = xb + (size_t)(u.pm * 256 + wr * 64 + fr) * 1024 + u.pn * 256 + wc * 32 + 8 * fq;
#pragma unroll
        for (int ai = 0; ai < 2; ++ai)
#pragma unroll
            for (int m = 0; m < 4; ++m)
#pragma unroll
                for (int bj = 0; bj < 2; ++bj) acc[ai][bj][m][0] = __builtin_bit_cast(f32x4, *(const u32x4*)(xp + (size_t)(ai * 128 + m * 16) * 1024 + bj * 128));
    }
    __device__ __forceinline__ void post_prologue(g8::Acc& acc) const {
#pragma unroll
        for (int ai = 0; ai < 2; ++ai)
#pragma unroll
            for (int bj = 0; bj < 2; ++bj)
#pragma unroll
                for (int m = 0; m < 4; ++m) { const u32x4 w = __builtin_bit_cast(u32x4, acc[ai][bj][m][0]);
                    acc[ai][bj][m][0] = (f32x4){bflo(w.x), bfhi(w.x), bflo(w.y), bfhi(w.y)} * ALPHA; acc[ai][bj][m][1] = (f32x4){bflo(w.z), bfhi(w.z), bflo(w.w), bfhi(w.w)} * ALPHA; }
    }
    __device__ __forceinline__ void operator()(g8::Acc& acc, const g8::Unit& u, int wr, int wc, int fr, int fq) const {
        panel_ln_stats8(acc, u.pm, u.pn, (unsigned*)(ws + WS_CTL) + 8192, (unsigned long long*)(ws + WS_XCH1), lds, wr, wc, fr, fq);
        const LAS f32x2* Ss = (const LAS f32x2*)(lds + 8192);
        bf16_t* H1b = (bf16_t*)(ws + WS_H1B); bf16_t* H1lo = (bf16_t*)(ws + WS_H1LO);
        const int col0 = u.pn * 256 + wc * 32 + 8 * fq;
        f32x4 gg[2][2], bb[2][2];
#pragma unroll
        for (int bj = 0; bj < 2; ++bj)
#pragma unroll
            for (int n = 0; n < 2; ++n) { gg[bj][n] = *(const f32x4*)(gam + col0 + bj * 128 + 4 * n); bb[bj][n] = *(const f32x4*)(bet + col0 + bj * 128 + 4 * n); }
#pragma unroll
        for (int ai = 0; ai < 2; ++ai)
#pragma unroll
            for (int m = 0; m < 4; ++m) { const int rl = ai * 128 + wr * 64 + m * 16 + fr; const f32x2 st_ = Ss[rl]; const size_t ro = (size_t)(u.pm * 256 + rl) * 1024 + col0;
#pragma unroll
                for (int bj = 0; bj < 2; ++bj) {
                    const f32x4 h0 = (acc[ai][bj][m][0] - st_.x) * st_.y * gg[bj][0] + bb[bj][0], h1 = (acc[ai][bj][m][1] - st_.x) * st_.y * gg[bj][1] + bb[bj][1];
                    const u32x4 ph = pk8(h0, h1);
                    f32x4 r0, r1; r0[0] = h0[0] - bflo(ph.x); r0[1] = h0[1] - bfhi(ph.x); r0[2] = h0[2] - bflo(ph.y); r0[3] = h0[3] - bfhi(ph.y);
                    r1[0] = h1[0] - bflo(ph.z); r1[1] = h1[1] - bfhi(ph.z); r1[2] = h1[2] - bflo(ph.w); r1[3] = h1[3] - bfhi(ph.w);
                    *(u32x4*)(H1b + ro + bj * 128) = ph; *(u32x4*)(H1lo + ro + bj * 128) = pk8(r0, r1);
                    *(u32x2*)(ws + WS_RB + ro + bj * 128) = pk8_f8(h0, h1); } }
    }
};
__device__ __forceinline__ void phase_outproj_gemm(const Params& P, lds_t* lds) {
    for (int it = 0; ln_tile(it) < 128 * 4; ++it) { const int tile = ln_tile(it);
        SchedOne S{(const bf16_t*)(P.ws + WS_RA), (const bf16_t*)(P.ws + WS_WOUT), 1024, tile};
        EpiOutLn1 E{(const bf16_t*)(P.ws + WS_H1LO), P.in[11], P.in[12], P.ws, lds};
        g8::gemm_phase(lds, 1024, S, E);
        __syncthreads();
    }
}

constexpr int L4_LG = 98304;
constexpr int L4_LCNT = 131072;
constexpr int L4_GB = 131200;
constexpr int L4_AE = 131328;
constexpr int L4_AR = 132352;
constexpr int L4_AW = 133376;

__device__ __forceinline__ void phase_ln1_router(const Params& P, lds_t* lds) {
    unsigned char* ws = P.ws;
    int tid = threadIdx.x; asm volatile("" : "+v"(tid));
    const int lane = tid & 63, wid = __builtin_amdgcn_readfirstlane(tid >> 6), r = lane & 15, q = lane >> 4, sc = tid & 7, sr = tid >> 3;
    const bf16_t* Y = (const bf16_t*)(ws + WS_RA); const bf16_t* wt = (const bf16_t*)(ws + WS_WOUT);
    const float* x = P.in[0]; float* out = P.out; bf16_t* H1b = (bf16_t*)(ws + WS_H1B); bf16_t* H1lo = (bf16_t*)(ws + WS_H1LO);
    const bf16_t* WRB = (const bf16_t*)(ws + WS_WRB);
    int* gcount = (int*)(ws + WS_CTL);
    LAS float* LG = (LAS float*)(lds + L4_LG); LAS int* LCNT = (LAS int*)(lds + L4_LCNT); LAS int* GB = (LAS int*)(lds + L4_GB);
    LAS int* AE = (LAS int*)(lds + L4_AE); LAS int* AR = (LAS int*)(lds + L4_AR); LAS float* AW = (LAS float*)(lds + L4_AW);
    for (int panel = blockIdx.x; panel < 256; panel += gridDim.x) {
        const int row0 = panel * 128;
        if (tid < 32) LCNT[tid] = 0;
        __syncthreads();
        {
            f32x4 hacc[2][4];
            { const bf16_t* ap[2]; const bf16_t* bp[2];
#pragma unroll
              for (int i = 0; i < 2; ++i) ap[i] = H1b + (size_t)(row0 + sr + 64 * i) * 1024 + sc * 8;
              bp[0] = WRB + (size_t)sr * 3072 + sc * 8; bp[1] = WRB + (size_t)sr * 3072 + 1024 + sc * 8;
              gemm_mainloop<128, 128, 32, 64>(lds, ap, 64, bp, 16, hacc); }
            const int wm = wid >> 1, wn = wid & 1;
            if (wn == 0) {
#pragma unroll
                for (int i = 0; i < 2; ++i)
#pragma unroll
                    for (int j = 0; j < 4; ++j) *(LAS f32x4*)(LG + (wm * 32 + i * 16 + r) * 64 + j * 16 + 4 * q) = hacc[i][j]; }
            __syncthreads();
            if (wn == 1) {
#pragma unroll
                for (int i = 0; i < 2; ++i)
#pragma unroll
                    for (int j = 0; j < 4; ++j) { LAS f32x4* d_ = (LAS f32x4*)(LG + (wm * 32 + i * 16 + r) * 64 + j * 16 + 4 * q); *d_ = *d_ + hacc[i][j]; } }
            f32x4 racc[2][2];
            { const bf16_t* ap[2]; const bf16_t* bp[1];
#pragma unroll
              for (int i = 0; i < 2; ++i) ap[i] = H1lo + (size_t)(row0 + sr + 64 * i) * 1024 + sc * 8;
              bp[0] = WRB + (size_t)sr * 3072 + sc * 8;
              gemm_mainloop<128, 64, 32, 32>(lds, ap, 64, bp, 16, racc); }
#pragma unroll
            for (int i = 0; i < 2; ++i)
#pragma unroll
                for (int j = 0; j < 2; ++j) { LAS f32x4* d_ = (LAS f32x4*)(LG + (wm * 32 + i * 16 + r) * 64 + wn * 32 + j * 16 + 4 * q); *d_ = *d_ + racc[i][j]; }
        }
        __syncthreads();
        if (tid < 128) {
            const LAS float* lp = LG + tid * 64;
            const float* brg = P.in[14]; const float* bre = P.in[16];
            float g0 = lp[0] + brg[0]; int gs = 0; float gsum;
            { float gv[4]; gv[0] = g0;
#pragma unroll
              for (int i = 1; i < 4; ++i) { gv[i] = lp[i] + brg[i]; if (gv[i] > g0) { g0 = gv[i]; gs = i; } }
              gsum = 0.f;
#pragma unroll
              for (int i = 0; i < 4; ++i) gsum += __expf(gv[i] - g0); }
            const float gp = 1.f / gsum;
            float ev[8];
#pragma unroll
            for (int i = 0; i < 8; ++i) ev[i] = lp[4 + gs * 8 + i] + bre[gs * 8 + i];
            int i1 = 0; float e1 = ev[0];
#pragma unroll
            for (int i = 1; i < 8; ++i) if (ev[i] > e1) { e1 = ev[i]; i1 = i; }
            int i2 = -1; float e2 = -3.0e38f;
#pragma unroll
            for (int i = 0; i < 8; ++i) if (i != i1 && ev[i] > e2) { e2 = ev[i]; i2 = i; }
            const float x2 = __expf(e2 - e1); const float w1 = gp / (1.f + x2), w2 = gp * x2 / (1.f + x2);
            const int ea = gs * 8 + i1, eb = gs * 8 + i2;
            AE[tid * 2] = ea; AE[tid * 2 + 1] = eb; AW[tid * 2] = w1; AW[tid * 2 + 1] = w2;
            AR[tid * 2] = lds_addi(&LCNT[ea], 1); AR[tid * 2 + 1] = lds_addi(&LCNT[eb], 1);
        }
        __syncthreads();
        if (tid < 32) GB[tid] = atomicAdd(&gcount[tid], LCNT[tid]);
        __syncthreads();
        if (tid < 256) { const int row = tid >> 1, kk = tid & 1, e = AE[row * 2 + kk], slot = GB[e] + AR[row * 2 + kk]; const int tok = row0 + row;
            ((int*)(ws + WS_TOKL))[(size_t)e * 65536 + slot] = tok;
            ((int*)(ws + WS_ASGE))[tok * 2 + kk] = e; ((int*)(ws + WS_ASGS))[tok * 2 + kk] = slot; ((float*)(ws + WS_ASGW))[tok * 2 + kk] = AW[row * 2 + kk]; }
        __syncthreads();
    }
}

constexpr int L5_CNT = 131072;
constexpr int L5_RB = 131200;
constexpr int L5_TB = 131456;

__device__ __forceinline__ void moe_setup(const Params& P, lds_t* lds, int ncol) {
    LAS int* CNT = (LAS int*)(lds + L5_CNT); LAS int* RB = (LAS int*)(lds + L5_RB); LAS int* TB = (LAS int*)(lds + L5_TB);
    const int* gcount = (const int*)(P.ws + WS_CTL);
    int tid = threadIdx.x; asm volatile("" : "+v"(tid));
    if (tid < 32) CNT[tid] = gcount[tid];
    __syncthreads();
    if (tid == 0) { int rb = 0, tb = 0; for (int e = 0; e < 32; ++e) { RB[e] = rb; TB[e] = tb; rb += CNT[e]; tb += ((CNT[e] + 255) >> 8) * ncol; } RB[32] = rb; TB[32] = tb; }
    __syncthreads();
}

struct EpiPark {
    static constexpr bool AFTER_DRAIN = false;
    bf16_t* PLS;
    __device__ __forceinline__ void init(g8::Acc& acc, const g8::Unit&, int, int, int, int) const { g8::acc_zero(acc); }
    __device__ __forceinline__ void post_prologue(g8::Acc&) const {}
    __device__ __forceinline__ void operator()(g8::Acc& acc, const g8::Unit& u, int wr, int wc, int fr, int fq) const {
#pragma unroll
        for (int ai = 0; ai < 2; ++ai)
#pragma unroll
            for (int m = 0; m < 4; ++m) { const size_t ro = (size_t)(u.pm * 256 + ai * 128 + wr * 64 + m * 16 + fr) * 1024 + u.pn * 256 + wc * 32 + 8 * fq;
#pragma unroll
                for (int bj = 0; bj < 2; ++bj) *(u32x4*)(PLS + ro + bj * 128) = pk8(acc[ai][bj][m][0], acc[ai][bj][m][1]); }
    }
};
constexpr int PLE_CTR_WORD = 4096;
constexpr int L_PLEQ = 157200;
struct SchedPleRun {
    const bf16_t* A; const bf16_t* W; int t0, n;
    __device__ __forceinline__ bool next(int i, g8::Unit& u) const { const int tile = t0 + i; if (i >= n || tile >= 128 * 4) return false; u.pm = tile >> 2; u.pn = tile & 3; return true; }
    __device__ __forceinline__ const char* a_base(const g8::Unit& u) const { return (const char*)(A + (size_t)u.pm * 256 * 256); }
    __device__ __forceinline__ const char* b_base(const g8::Unit& u, int h) const { return (const char*)(W + (size_t)(u.pn * 256 + h * 128) * 256); }
    __device__ __forceinline__ void a_offsets(const g8::Unit&, unsigned (&v)[2][2], int tid) const { g8::natural_offsets(v, 256, tid); }
};
__device__ __forceinline__ void ple_fill(const Params& P, lds_t* lds, int n) {
    unsigned* ctr = (unsigned*)(P.ws + WS_CTL) + PLE_CTR_WORD;
    volatile LAS unsigned* qw = (volatile LAS unsigned*)(lds + L_PLEQ);
    int tid = threadIdx.x; asm volatile("" : "+v"(tid));
    if (tid == 0) qw[0] = atomicAdd(ctr, (unsigned)n);
    __syncthreads();
    const unsigned t = qw[0];
    __syncthreads();
    if (t >= 512u) return;
    SchedPleRun S{(const bf16_t*)(P.ws + WS_PB), (const bf16_t*)(P.ws + WS_WPLE), (int)t, n};
    EpiPark E{(bf16_t*)(P.ws + WS_H1LO)};
    g8::gemm_phase(lds, 256, S, E);
    __syncthreads();
}
constexpr int L5_UNIT = 131712;
constexpr int L5_TOKU = 132608;
constexpr int MAXU = 24;
__device__ __forceinline__ int moe_tile(int i, int ntile) { const int G = gridDim.x, bid = blockIdx.x;
    if ((G & 7) || i >= ntile / G) return bid + i * G;
    return (i * 8 + (bid & 7)) * (G >> 3) + (bid >> 3); }
__device__ __forceinline__ int moe_units(const Params& P, lds_t* lds, int first, bool want_tok) {
    LAS int* CNT = (LAS int*)(lds + L5_CNT); LAS int* RB = (LAS int*)(lds + L5_RB); LAS int* TB = (LAS int*)(lds + L5_TB);
    LAS int* UN = (LAS int*)(lds + L5_UNIT); LAS int* TOKU = (LAS int*)(lds + L5_TOKU);
    int tid = threadIdx.x; asm volatile("" : "+v"(tid));
    const int G = gridDim.x, bid = blockIdx.x;
    const int ntile = TB[32];
    int mine = 0; while (mine < 64 && moe_tile(mine, ntile) < ntile) ++mine;
    int nu = mine - first; nu = nu < 0 ? 0 : (nu > MAXU ? MAXU : nu);
    if (tid < nu) { const int tile = moe_tile(first + tid, ntile); int e = 0; while (TB[e + 1] <= tile) ++e;
        const int ne = CNT[e], MT = (ne + 255) >> 8, loc = tile - TB[e];
        UN[tid * 8 + 0] = e; UN[tid * 8 + 1] = loc / MT; UN[tid * 8 + 2] = loc % MT; UN[tid * 8 + 3] = ne; UN[tid * 8 + 4] = RB[e]; }
    __syncthreads();
    if (want_tok) { const int* TOKL = (const int*)(P.ws + WS_TOKL);
        for (int idx = tid; idx < nu * 256; idx += NTHREADS) { const int ui = idx >> 8, r = idx & 255; const int e = UN[ui * 8], mt = UN[ui * 8 + 2], ne = UN[ui * 8 + 3];
            int ix = mt * 256 + r; if (ix >= ne) ix = ne - 1; TOKU[idx] = TOKL[(size_t)e * 65536 + ix]; } }
    __syncthreads();
    return nu;
}
__device__ __forceinline__ bool moe_idle_last_round(lds_t* lds) {
    const int ntile = ((LAS int*)(lds + L5_TB))[32]; const int G = gridDim.x;
    const int rounds = (ntile + G - 1) / G;
    return rounds > 0 && moe_tile(rounds - 1, ntile) >= ntile;
}
template <bool DOWN> struct SchedMoeF8 {
    lds_t* lds; const unsigned char* A; const unsigned char* W; int nu;
    __device__ __forceinline__ bool next(int i, g8::Unit& u) const { if (i >= nu) return false; const LAS int* UN = (const LAS int*)(lds + L5_UNIT) + i * 8;
        u.e = __builtin_amdgcn_readfirstlane(UN[0]); u.pn = __builtin_amdgcn_readfirstlane(UN[1]); u.pm = __builtin_amdgcn_readfirstlane(UN[2]);
        u.ne = __builtin_amdgcn_readfirstlane(UN[3]); u.rb = __builtin_amdgcn_readfirstlane(UN[4]); u.idx = i; return true; }
    __device__ __forceinline__ const char* a_base(const g8::Unit&) const { return (const char*)A; }
    __device__ __forceinline__ const char* b_base(const g8::Unit& u, int h) const {
        if (DOWN) return (const char*)(W + (size_t)u.e * 1024 * 512 + (size_t)(u.pn * 256 + h * 128) * 512);
        return (const char*)(W + (size_t)u.e * 1024 * 1024 + (size_t)((h ? 512 : 0) + u.pn * 128) * 1024); }
    __device__ __forceinline__ void a_offsets(const g8::Unit& u, unsigned (&v)[2][2], int tid) const {
#pragma unroll
        for (int i = 0; i < 2; ++i) { int R, Cb; g8::f8_rc(tid, i, R, Cb);
#pragma unroll
            for (int h = 0; h < 2; ++h) {
                if (DOWN) { int ix = u.pm * 256 + h * 128 + R; if (ix >= u.ne) ix = u.ne - 1; v[h][i] = (unsigned)((u.rb + ix) * 512 + Cb); }
                else { const int tok = ((const LAS int*)(lds + L5_TOKU))[u.idx * 256 + h * 128 + R]; v[h][i] = (unsigned)(tok * 1024 + Cb); } } }
    }
};
template <bool DOWN> struct SchedMoe {
    lds_t* lds; const bf16_t* A; const bf16_t* W; int nu;
    __device__ __forceinline__ bool next(int i, g8::Unit& u) const { if (i >= nu) return false; const LAS int* UN = (const LAS int*)(lds + L5_UNIT) + i * 8;
        u.e = __builtin_amdgcn_readfirstlane(UN[0]); u.pn = __builtin_amdgcn_readfirstlane(UN[1]); u.pm = __builtin_amdgcn_readfirstlane(UN[2]);
        u.ne = __builtin_amdgcn_readfirstlane(UN[3]); u.rb = __builtin_amdgcn_readfirstlane(UN[4]); u.idx = i; return true; }
    __device__ __forceinline__ const char* a_base(const g8::Unit&) const { return (const char*)A; }
    __device__ __forceinline__ const char* b_base(const g8::Unit& u, int h) const {
        if (DOWN) return (const char*)(W + (size_t)u.e * 1024 * 512 + (size_t)(u.pn * 256 + h * 128) * 512);
        return (const char*)(W + (size_t)u.e * 1024 * 1024 + (size_t)((h ? 512 : 0) + u.pn * 128) * 1024); }
    __device__ __forceinline__ void a_offsets(const g8::Unit& u, unsigned (&v)[2][2], int tid) const {
#pragma unroll
        for (int i = 0; i < 2; ++i) { int R, C; g8::stage_rc(tid * 16 + i * 8192, R, C);
#pragma unroll
            for (int h = 0; h < 2; ++h) {
                if (DOWN) { int ix = u.pm * 256 + h * 128 + R; if (ix >= u.ne) ix = u.ne - 1; v[h][i] = (unsigned)((u.rb + ix) * 512 + C) * 2u; }
                else { const int tok = ((const LAS int*)(lds + L5_TOKU))[u.idx * 256 + h * 128 + R]; v[h][i] = (unsigned)(tok * 1024 + C) * 2u; } } }
    }
};
struct EpiMoeUp {
    static constexpr bool AFTER_DRAIN = false;
    bf16_t* HID;
    __device__ __forceinline__ void init(g8::Acc& acc, const g8::Unit&, int, int, int, int) const { g8::acc_zero(acc); }
    __device__ __forceinline__ void post_prologue(g8::Acc&) const {}
    __device__ __forceinline__ void operator()(g8::Acc& acc, const g8::Unit& u, int wr, int wc, int fr, int fq) const {
#pragma unroll
        for (int ai = 0; ai < 2; ++ai)
#pragma unroll
            for (int m = 0; m < 4; ++m) { const int ix = u.pm * 256 + ai * 128 + wr * 64 + m * 16 + fr;
                if (ix < u.ne) { f32x4 h0, h1;
#pragma unroll
                    for (int c = 0; c < 4; ++c) { const float g0 = acc[ai][0][m][0][c], g1 = acc[ai][0][m][1][c];
                        h0[c] = g0 * sigmoidf_(g0) * acc[ai][1][m][0][c]; h1[c] = g1 * sigmoidf_(g1) * acc[ai][1][m][1][c]; }
                    *(u32x2*)((unsigned char*)HID + (size_t)(u.rb + ix) * 512 + u.pn * 128 + wc * 32 + 8 * fq) = pk8_f8(h0, h1); } }
    }
};
struct EpiMoeDown {
    static constexpr bool AFTER_DRAIN = false;
    bf16_t* OA;
    __device__ __forceinline__ void init(g8::Acc& acc, const g8::Unit&, int, int, int, int) const { g8::acc_zero(acc); }
    __device__ __forceinline__ void post_prologue(g8::Acc&) const {}
    __device__ __forceinline__ void operator()(g8::Acc& acc, const g8::Unit& u, int wr, int wc, int fr, int fq) const {
#pragma unroll
        for (int ai = 0; ai < 2; ++ai)
#pragma unroll
            for (int m = 0; m < 4; ++m) { const int ix = u.pm * 256 + ai * 128 + wr * 64 + m * 16 + fr;
                if (ix < u.ne) {
#pragma unroll
                    for (int bj = 0; bj < 2; ++bj) *(u32x2*)((unsigned char*)OA + (size_t)(u.rb + ix) * 1024 + u.pn * 256 + bj * 128 + wc * 32 + 8 * fq) = pk8_f8(acc[ai][bj][m][0] * 4.f, acc[ai][bj][m][1] * 4.f); } }
    }
};

__device__ __forceinline__ void phase_moe1(const Params& P, lds_t* lds) {
    moe_setup(P, lds, 4);
    for (int first = 0;; first += MAXU) {
        const int nu = moe_units(P, lds, first, true);
        if (nu == 0) break;
        SchedMoeF8<false> S{lds, P.ws + WS_RB, P.ws + WS_WEIN, nu};
        EpiMoeUp E{(bf16_t*)(P.ws + WS_RA)};
        g8::gemm_phase_f8<123>(lds, 1024, S, E);
        __syncthreads();
    }
    if (moe_idle_last_round(lds)) ple_fill(P, lds, 2);
}

__device__ __forceinline__ void phase_moe2(const Params& P, lds_t* lds) {
    moe_setup(P, lds, 4);
    for (int first = 0;; first += MAXU) {
        const int nu = moe_units(P, lds, first, false);
        if (nu == 0) break;
        SchedMoeF8<true> S{lds, P.ws + WS_RA, P.ws + WS_WEOUT, nu};
        EpiMoeDown E{(bf16_t*)(P.ws + WS_RB)};
        g8::gemm_phase_f8<123>(lds, 512, S, E);
        __syncthreads();
    }
    if (moe_idle_last_round(lds)) ple_fill(P, lds, 1);
}

__device__ __forceinline__ void phase_ln2(const Params& P, lds_t* lds) {
    unsigned char* ws = P.ws;
    int tid = threadIdx.x; asm volatile("" : "+v"(tid));
    const int lane = tid & 63, wid = __builtin_amdgcn_readfirstlane(tid >> 6);
    LAS int* RB = (LAS int*)(lds + L5_RB);
    moe_setup(P, lds, 4);
    const bf16_t* OA = (const bf16_t*)(ws + WS_RB); bf16_t* H2b = (bf16_t*)(ws + WS_RA);
    const bf16_t* H1b = (const bf16_t*)(ws + WS_H1B); bf16_t* HLO = (bf16_t*)(ws + WS_H1LO);
    const int* ASGE = (const int*)(ws + WS_ASGE); const int* ASGS = (const int*)(ws + WS_ASGS); const float* ASGW = (const float*)(ws + WS_ASGW);
    f32x4 g[4], bt[4];
#pragma unroll
    for (int j = 0; j < 4; ++j) { g[j] = *(const f32x4*)(P.in[19] + 4 * lane + 256 * j); bt[j] = *(const f32x4*)(P.in[20] + 4 * lane + 256 * j); }
    for (int panel = blockIdx.x; panel < 256; panel += gridDim.x) {
        const int row0 = panel * 128;
        unsigned myo0 = 0, myo1 = 0; float myw0 = 0.f, myw1 = 0.f;
        if (lane < 16) { const int trow = row0 + 16 * wid + lane;
            const int e0 = ASGE[trow * 2], e1 = ASGE[trow * 2 + 1];
            myo0 = (unsigned)(RB[e0] + ASGS[trow * 2]) * 1024u; myo1 = (unsigned)(RB[e1] + ASGS[trow * 2 + 1]) * 1024u;
            myw0 = ASGW[trow * 2] * 0.25f; myw1 = ASGW[trow * 2 + 1] * 0.25f; }
#pragma unroll 2
        for (int rr = 0; rr < 16; ++rr) {
            const int trow = row0 + 16 * wid + rr;
            const size_t ro = (size_t)trow * 1024 + 4 * lane;
            const unsigned q0 = (unsigned)__shfl((int)myo0, rr), q1 = (unsigned)__shfl((int)myo1, rr);
            const float w0 = __shfl(myw0, rr), w1 = __shfl(myw1, rr);
            const unsigned char* o0 = (const unsigned char*)OA + (size_t)q0 + 4 * lane; const unsigned char* o1 = (const unsigned char*)OA + (size_t)q1 + 4 * lane;
            f32x4 v[4];
#pragma unroll
            for (int j = 0; j < 4; ++j) { const u32x2 hw = *(const u32x2*)(H1b + ro + 256 * j); const f32x4 h = (f32x4){bflo(hw.x), bfhi(hw.x), bflo(hw.y), bfhi(hw.y)}; const int a = *(const int*)(o0 + 256 * j), bq = *(const int*)(o1 + 256 * j);
                const f32x2 a01 = __builtin_amdgcn_cvt_pk_f32_fp8(a, false), a23 = __builtin_amdgcn_cvt_pk_f32_fp8(a, true), b01 = __builtin_amdgcn_cvt_pk_f32_fp8(bq, false), b23 = __builtin_amdgcn_cvt_pk_f32_fp8(bq, true);
                f32x4 f; f[0] = w0 * a01[0] + w1 * b01[0]; f[1] = w0 * a01[1] + w1 * b01[1]; f[2] = w0 * a23[0] + w1 * b23[0]; f[3] = w0 * a23[1] + w1 * b23[1];
                v[j] = h * ALPHA + f; }
            ln_row(v, g, bt);
#pragma unroll
            for (int j = 0; j < 4; ++j) *(u32x2*)(H2b + ro + 256 * j) = pk4(v[j]);
        }
    }
}

struct SchedPle {
    const bf16_t* A; const bf16_t* W; int G, c;
    __device__ __forceinline__ bool next(int i, g8::Unit& u) const { const int tile = c + i * G; if (tile >= 128 * 4) return false; u.pm = tile >> 2; u.pn = tile & 3; return true; }
    __device__ __forceinline__ const char* a_base(const g8::Unit& u) const { return (const char*)(A + (size_t)u.pm * 256 * 256); }
    __device__ __forceinline__ const char* b_base(const g8::Unit& u, int h) const { return (const char*)(W + (size_t)(u.pn * 256 + h * 128) * 256); }
    __device__ __forceinline__ void a_offsets(const g8::Unit&, unsigned (&v)[2][2], int tid) const { g8::natural_offsets(v, 256, tid); }
};
struct EpiGateLn3 {
    static constexpr bool AFTER_DRAIN = true;
    const bf16_t* H2b; const bf16_t* PLS; const float* bg; const float* gam; const float* bet; float* out; unsigned char* ws; lds_t* lds;
    __device__ __forceinline__ void init(g8::Acc& acc, const g8::Unit&, int, int, int, int) const { g8::acc_zero(acc); }
    __device__ __forceinline__ void post_prologue(g8::Acc&) const {}
    __device__ __forceinline__ void operator()(g8::Acc& acc, const g8::Unit& u, int wr, int wc, int fr, int fq) const {
        const int col0 = u.pn * 256 + wc * 32 + 8 * fq;
        {
            f32x4 bv[2][2];
#pragma unroll
            for (int bj = 0; bj < 2; ++bj)
#pragma unroll
                for (int n = 0; n < 2; ++n) bv[bj][n] = *(const f32x4*)(bg + col0 + bj * 128 + 4 * n);
#pragma unroll
            for (int ai = 0; ai < 2; ++ai)
#pragma unroll
                for (int m = 0; m < 4; ++m) { const size_t ro = (size_t)(u.pm * 256 + ai * 128 + wr * 64 + m * 16 + fr) * 1024 + col0;
#pragma unroll
                    for (int bj = 0; bj < 2; ++bj) {
                        const u32x4 hw = *(const u32x4*)(H2b + ro + bj * 128); const u32x4 pl = *(const u32x4*)(PLS + ro + bj * 128);
                        const f32x4 g0 = acc[ai][bj][m][0] + bv[bj][0], g1 = acc[ai][bj][m][1] + bv[bj][1];
                        f32x4 o0, o1;
                        o0[0] = bflo(hw.x) * ALPHA + bflo(pl.x) * sigmoidf_(g0[0]); o0[1] = bfhi(hw.x) * ALPHA + bfhi(pl.x) * sigmoidf_(g0[1]); o0[2] = bflo(hw.y) * ALPHA + bflo(pl.y) * sigmoidf_(g0[2]); o0[3] = bfhi(hw.y) * ALPHA + bfhi(pl.y) * sigmoidf_(g0[3]);
                        o1[0] = bflo(hw.z) * ALPHA + bflo(pl.z) * sigmoidf_(g1[0]); o1[1] = bfhi(hw.z) * ALPHA + bfhi(pl.z) * sigmoidf_(g1[1]); o1[2] = bflo(hw.w) * ALPHA + bflo(pl.w) * sigmoidf_(g1[2]); o1[3] = bfhi(hw.w) * ALPHA + bfhi(pl.w) * sigmoidf_(g1[3]);
                        acc[ai][bj][m][0] = o0; acc[ai][bj][m][1] = o1; }
                    asm volatile("" : "+v"(acc[ai][0][m][0]), "+v"(acc[ai][0][m][1]), "+v"(acc[ai][1][m][0]), "+v"(acc[ai][1][m][1]));
                    asm volatile("" ::: "memory"); }
        }
        panel_ln_stats8(acc, u.pm, u.pn, (unsigned*)(ws + WS_CTL) + 20480, (unsigned long long*)(ws + WS_XCH3), lds, wr, wc, fr, fq);
        const LAS f32x2* Ss = (const LAS f32x2*)(lds + 8192);
        f32x4 gg[2][2], bb[2][2];
#pragma unroll
        for (int bj = 0; bj < 2; ++bj)
#pragma unroll
            for (int n = 0; n < 2; ++n) { gg[bj][n] = *(const f32x4*)(gam + col0 + bj * 128 + 4 * n); bb[bj][n] = *(const f32x4*)(bet + col0 + bj * 128 + 4 * n); }
#pragma unroll
        for (int ai = 0; ai < 2; ++ai)
#pragma unroll
            for (int m = 0; m < 4; ++m) { const int rl = ai * 128 + wr * 64 + m * 16 + fr; const f32x2 st_ = Ss[rl]; float* op = out + (size_t)(u.pm * 256 + rl) * 1024 + col0;
#pragma unroll
                for (int bj = 0; bj < 2; ++bj)
#pragma unroll
                    for (int n = 0; n < 2; ++n) *(f32x4*)(op + bj * 128 + 4 * n) = (acc[ai][bj][m][n] - st_.x) * st_.y * gg[bj][n] + bb[bj][n]; }
    }
};
__device__ __forceinline__ void phase_ple_gemm(const Params& P, lds_t* lds) {
    unsigned char* ws = P.ws;
    {
        const unsigned cv = ((const unsigned*)(ws + WS_CTL))[PLE_CTR_WORD]; const int done = cv < 512u ? (int)cv : 512;
        SchedPle S{(const bf16_t*)(ws + WS_PB), (const bf16_t*)(ws + WS_WPLE), (int)gridDim.x, done + (int)blockIdx.x};
        EpiPark E{(bf16_t*)(ws + WS_H1LO)};
        g8::gemm_phase(lds, 256, S, E);
        __syncthreads();
    }
    for (int it = 0; ln_tile(it) < 128 * 4; ++it) { const int tile = ln_tile(it);
        SchedOne S{(const bf16_t*)(ws + WS_RA), (const bf16_t*)(ws + WS_WPG), 1024, tile};
        EpiGateLn3 E{(const bf16_t*)(ws + WS_RA), (const bf16_t*)(ws + WS_H1LO), P.in[23], P.in[24], P.in[25], P.out, ws, lds};
        g8::gemm_phase(lds, 1024, S, E);
        __syncthreads();
    }
}

__device__ __forceinline__ void phase_ln3(const Params& P, lds_t* lds) {
    int tid = threadIdx.x; asm volatile("" : "+v"(tid));
    const int lane = tid & 63, wid = __builtin_amdgcn_readfirstlane(tid >> 6);
    float* out = P.out;
    f32x4 g[4], bt[4];
#pragma unroll
    for (int j = 0; j < 4; ++j) { g[j] = *(const f32x4*)(P.in[24] + 4 * lane + 256 * j); bt[j] = *(const f32x4*)(P.in[25] + 4 * lane + 256 * j); }
    for (int panel = blockIdx.x; panel < 256; panel += gridDim.x) {
        const int row0 = panel * 128;
#pragma unroll 1
        for (int rr = 0; rr < 16; ++rr) {
            const size_t ro = (size_t)(row0 + 16 * wid + rr) * 1024 + 4 * lane;
            f32x4 v[4];
#pragma unroll
            for (int j = 0; j < 4; ++j) v[j] = *(const f32x4*)(out + ro + 256 * j);
            ln_row(v, g, bt);
#pragma unroll
            for (int j = 0; j < 4; ++j) *(f32x4*)(out + ro + 256 * j) = v[j];
        }
    }
}

#define XB_TMO      128
#define XB_XCNT(j)  (256  + 64 * (j))
#define XB_XSUB(j)  (1280 + 64 * (j))
#define XB_XGEN(j)  (2304 + 64 * (j))
#define XB_TOP      3328
#define XB_TOPGEN   3392
#define XCD_BAR_WORDS 3456
#define XB_SPIN_CAP (1u << 18)

__device__ __forceinline__ unsigned xb_ld(unsigned* p)              { return __hip_atomic_load(p, __ATOMIC_RELAXED, __HIP_MEMORY_SCOPE_AGENT); }
__device__ __forceinline__ unsigned xb_add(unsigned* p, unsigned v) { return __hip_atomic_fetch_add(p, v, __ATOMIC_RELAXED, __HIP_MEMORY_SCOPE_AGENT); }
__device__ __forceinline__ unsigned xb_xcc_id() { return (unsigned)__builtin_amdgcn_s_getreg((3 << 11) | 20) & 0xFu; }
#define XB_SPIN(cond, bar) do { unsigned _sp = 0; while (cond) { __builtin_amdgcn_s_sleep(1); \
    if ((++_sp & 255u) == 0u) { if (xb_ld(&(bar)[XB_TMO])) break; if (_sp > XB_SPIN_CAP) { atomicAdd(&(bar)[XB_TMO], 1u); break; } } } } while (0)

struct XcdBarrier {
    unsigned* bar; unsigned x;
    volatile LAS unsigned* st;
};

__device__ __forceinline__ XcdBarrier xcd_barrier_post(unsigned* bar, volatile LAS unsigned* st) {
    XcdBarrier b; b.bar = bar; b.x = xb_xcc_id(); b.st = st;
    if (threadIdx.x == 0) (void)xb_add(&bar[XB_XCNT(b.x)], 1u);
    return b;
}
__device__ __forceinline__ void xcd_barrier_complete(unsigned* bar, unsigned x, unsigned& nloc, unsigned& nx) {
    const unsigned G = gridDim.x * gridDim.y * gridDim.z;
    unsigned sum, cnt, mine, sp = 0u;
    for (;;) {
        sum = 0u; cnt = 0u; mine = 0u;
#pragma unroll
        for (unsigned j = 0; j < 16; ++j) { const unsigned c = xb_ld(&bar[XB_XCNT(j)]); sum += c; cnt += (c > 0u) ? 1u : 0u; mine = (j == x) ? c : mine; }
        if (sum == G) break;
        __builtin_amdgcn_s_sleep(1);
        if ((++sp & 255u) == 0u) { if (xb_ld(&bar[XB_TMO])) break; if (sp > XB_SPIN_CAP) { atomicAdd(&bar[XB_TMO], 1u); break; } }
    }
    nloc = mine > 0u ? mine : 1u; nx = cnt > 0u ? cnt : 1u;
}

__device__ __forceinline__ void xcd_barrier(const XcdBarrier& b) {
    asm volatile("s_waitcnt vmcnt(0)" ::: "memory");
    __syncthreads();
    if (threadIdx.x == 0) {
        unsigned* bar = b.bar;
        __builtin_amdgcn_s_waitcnt(0);
        unsigned nloc = b.st[0], nx = b.st[1];
        if (nloc == 0u) { xcd_barrier_complete(bar, b.x, nloc, nx); b.st[0] = nloc; b.st[1] = nx; }
        const unsigned old = xb_add(&bar[XB_XSUB(b.x)], 1u);
        const unsigned gen = old / nloc;
        if (old + 1u == (gen + 1u) * nloc) {
            __builtin_amdgcn_fence(__ATOMIC_RELEASE, "agent");
            asm volatile("s_waitcnt vmcnt(0)" ::: "memory");
            const unsigned og = xb_add(&bar[XB_TOP], 1u);
            const unsigned tg = og / nx;
            if (og + 1u == (tg + 1u) * nx) xb_add(&bar[XB_TOPGEN], 1u);
            else XB_SPIN(xb_ld(&bar[XB_TOPGEN]) == tg, bar);
            __builtin_amdgcn_fence(__ATOMIC_ACQUIRE, "agent");
            xb_add(&bar[XB_XGEN(b.x)], 1u);
            asm volatile("s_waitcnt vmcnt(0)" ::: "memory");
        } else {
            XB_SPIN(xb_ld(&bar[XB_XGEN(b.x)]) == gen, bar);
            __builtin_amdgcn_fence(__ATOMIC_ACQUIRE, "agent");
            asm volatile("s_waitcnt vmcnt(0)" ::: "memory");
        }
    }
    __syncthreads();
}

#ifndef USE_CG_SYNC
#define USE_CG_SYNC 0
#endif
constexpr size_t WS_BAR = 65536;
constexpr size_t CTL_ZERO_BYTES = 131072;
__global__ void __launch_bounds__(NTHREADS) fwd_kernel(Params P) {
    extern __shared__ __attribute__((aligned(16))) unsigned char smem[];
    lds_t* lds = (lds_t*)smem;
    const int lo = P.ph_lo, hi = P.ph_hi;
#if !USE_CG_SYNC
    volatile LAS unsigned* bst = (volatile LAS unsigned*)(lds + LDS_BYTES - 16);
    if (threadIdx.x < 2) bst[threadIdx.x] = 0u;
    __syncthreads();
    XcdBarrier bar; bar.bar = (unsigned*)(P.ws + WS_BAR); bar.x = 0; bar.st = nullptr;
    if (hi - lo > 1) bar = xcd_barrier_post((unsigned*)(P.ws + WS_BAR), bst);
#define GRID_SYNC() xcd_barrier(bar)
#else
#define GRID_SYNC() cg::this_grid().sync()
#endif
#ifndef ONLY_PHASE
#define ONLY_PHASE -1
#endif
#ifndef REPEAT_PHASE
#define REPEAT_PHASE -1
#endif
#define PHASE(k, fn) if ((ONLY_PHASE < 0 || ONLY_PHASE == (k)) && lo <= (k) && (k) < hi) { int nrep_ = (REPEAT_PHASE == (k)) ? 2 : 1; asm volatile("" : "+s"(nrep_)); for (int rep_ = 0; rep_ < nrep_; ++rep_) { fn(P, lds); __syncthreads(); } if ((k) + 1 < hi) { GRID_SYNC(); } }
    PHASE(0, phase_prep)
    PHASE(1, phase_inproj)
    PHASE(2, phase_conv_compress)
    PHASE(3, phase_nsa)
    PHASE(4, phase_outproj_gemm)
    PHASE(5, phase_ln1_router)
    PHASE(6, phase_moe1)
    PHASE(7, phase_moe2)
    PHASE(8, phase_ln2)
    PHASE(9, phase_ple_gemm)
#undef PHASE
}

extern "C" void kernel_launch(void* const* d_in, const int* in_sizes, int n_in, void* d_out, int out_size, void* d_ws, size_t ws_size, hipStream_t stream) {
    static int grid = 0;
    if (grid == 0) {
        if (n_in != 26 || ws_size < WS_END) { fprintf(stderr, "kernel_launch: unexpected n_in %d or ws_size %zu (< %zu)\n", n_in, ws_size, (size_t)WS_END); grid = -1; return; }
        int dev = 0, cus = 0, per_cu = 0;
        (void)hipGetDevice(&dev);
        (void)hipDeviceGetAttribute(&cus, hipDeviceAttributeMultiprocessorCount, dev);
        (void)hipFuncSetAttribute((const void*)fwd_kernel, hipFuncAttributeMaxDynamicSharedMemorySize, LDS_BYTES);
        (void)hipOccupancyMaxActiveBlocksPerMultiprocessor(&per_cu, (const void*)fwd_kernel, NTHREADS, LDS_BYTES);
        if (per_cu < 1) { fprintf(stderr, "kernel_launch: occupancy query says %d blocks per CU\n", per_cu); per_cu = 1; }
        grid = cus & ~3;
        (void)hipGetLastError();
    }
    if (grid < 0) return;
    Params p{};
    for (int i = 0; i < 26; ++i) p.in[i] = (const float*)d_in[i];
    p.out = (float*)d_out; p.ws = (unsigned char*)d_ws;
#if N_LAUNCH_SPLIT
    for (int ph = 0; ph < 10; ++ph) { p.ph_lo = ph; p.ph_hi = ph + 1; hipLaunchKernelGGL(fwd_kernel, dim3(grid), dim3(NTHREADS), LDS_BYTES, stream, p); }
#else
    p.ph_lo = 0; p.ph_hi = 10;
#if USE_CG_SYNC
    void* args[] = {&p};
    hipError_t e = hipLaunchCooperativeKernel((const void*)fwd_kernel, dim3(grid), dim3(NTHREADS), args, LDS_BYTES, stream);
    if (e != hipSuccess) fprintf(stderr, "cooperative launch failed: %s (grid %d)\n", hipGetErrorString(e), grid);
#else
    if (hipMemsetAsync((char*)d_ws + WS_CTL, 0, CTL_ZERO_BYTES, stream) != hipSuccess) { fprintf(stderr, "kernel_launch: hipMemsetAsync failed\n"); return; }
    hipLaunchKernelGGL(fwd_kernel, dim3(grid), dim3(NTHREADS), LDS_BYTES, stream, p);
#endif
#endif
}
```
